# Optimizing an MI355X kernel written in HIP

```python
import math
import jax, jax.numpy as jnp
from jax import lax
import numpy as np

D_MODEL = 1024
BATCH = 2
SEQ = 8192
DEPTH = 1

HEAD_DIM = 64
NSA_HEADS = (D_MODEL // 2) // HEAD_DIM
NSA_KV_HEADS = 2
NSA_REP = NSA_HEADS // NSA_KV_HEADS
CMP_BLOCK = 32
CMP_STRIDE = 16
SEL_BLOCK = 64
SEL_TOPK = 16
WINDOW = 512
DIFF_HEADS = (D_MODEL // 2) // (2 * HEAD_DIM)
DIFF_V_DIM = 2 * HEAD_DIM
DIFF_Q_BLOCK = 128
N_EXPERTS = 256
TOP_K = 8
N_GROUPS = 8
TOPK_GROUPS = 4
EXPERT_DIM = 256
SHARED_DIM = 256
ROUTED_SCALE = 2.5
EXPERT_CHUNK = 128
RMS_EPS = 1e-6
NEG_INF = -1e30
FORCE_BONUS = 1e4

NSA_Q_W = NSA_HEADS * HEAD_DIM
NSA_KV_W = NSA_KV_HEADS * HEAD_DIM
NSA_GATE_W = 3 * NSA_HEADS
DIFF_QK_W = DIFF_HEADS * 2 * HEAD_DIM
DIFF_V_W = DIFF_HEADS * DIFF_V_DIM
IN_SPLITS = (NSA_Q_W,) + (NSA_KV_W,) * 6 + (NSA_GATE_W, DIFF_QK_W, DIFF_QK_W, DIFF_V_W)
IN_WIDTH = sum(IN_SPLITS)
MIX_WIDTH = NSA_Q_W + DIFF_V_W

kernel_name = 'hybrid_nsa_diffattn_moe_block'


def rms_norm(x, g):
    xf = x.astype(jnp.float32)
    y = xf * lax.rsqrt(jnp.mean(xf * xf, axis=-1, keepdims=True) + RMS_EPS)
    return (y * g.astype(jnp.float32)).astype(x.dtype)


def alibi_slopes(n):
    return 2.0 ** (-8.0 * jnp.arange(1, n + 1, dtype=jnp.float32) / n)


def masked_softmax(s, mask):
    s = jnp.where(mask, s, NEG_INF)
    m = jnp.max(s, axis=-1, keepdims=True)
    e = jnp.where(mask, jnp.exp(s - m), 0.0)
    return e / jnp.maximum(jnp.sum(e, axis=-1, keepdims=True), 1e-30)


def compress_blocks(k, w1, w2, pe):
    b, s, g, dk = k.shape
    n_sub = CMP_BLOCK // CMP_STRIDE
    chunks = k.reshape(b, s // CMP_STRIDE, CMP_STRIDE, g, dk)
    n_cmp = s // CMP_STRIDE - n_sub + 1
    blocks = jnp.concatenate([chunks[:, i:i + n_cmp] for i in range(n_sub)], axis=2)
    blocks = blocks + pe[None, None, :, None, :]
    flat = jnp.transpose(blocks, (0, 1, 3, 2, 4)).reshape(b, n_cmp, g, CMP_BLOCK * dk)
    return jax.nn.gelu(flat @ w1) @ w2


def nsa_attention(q, k_cmp, v_cmp, k_sel, v_sel, k_win, v_win, gates, w_cmp1, w_cmp2, pe_cmp):
    b, s, h, dk = q.shape
    g, r = NSA_KV_HEADS, NSA_REP
    scale = dk ** -0.5
    slopes = alibi_slopes(NSA_HEADS).reshape(g, r)
    q = q.reshape(b, s, g, r, dk)
    gates = jax.nn.sigmoid(gates.astype(jnp.float32)).reshape(b, s, g, r, 3)
    kc = compress_blocks(k_cmp, w_cmp1[0], w_cmp2[0], pe_cmp[0])
    vc = compress_blocks(v_cmp, w_cmp1[1], w_cmp2[1], pe_cmp[1])
    n_cmp = kc.shape[1]
    cmp_start = jnp.arange(n_cmp) * CMP_STRIDE
    cmp_end = cmp_start + CMP_BLOCK - 1
    n_blk = s // SEL_BLOCK
    blk_start = jnp.arange(n_blk) * SEL_BLOCK
    overlap = jnp.clip(jnp.minimum(cmp_start[:, None] + CMP_BLOCK, blk_start[None, :] + SEL_BLOCK)
                       - jnp.maximum(cmp_start[:, None], blk_start[None, :]), 0, None).astype(jnp.float32) / CMP_BLOCK
    n_sel = min(SEL_TOPK, n_blk)
    ks_blk = k_sel.reshape(b, n_blk, SEL_BLOCK, g, dk).transpose(0, 3, 1, 2, 4)
    vs_blk = v_sel.reshape(b, n_blk, SEL_BLOCK, g, dk).transpose(0, 3, 1, 2, 4)
    kw_pad = jnp.pad(k_win, ((0, 0), (WINDOW, 0), (0, 0), (0, 0)))
    vw_pad = jnp.pad(v_win, ((0, 0), (WINDOW, 0), (0, 0), (0, 0)))
    b_idx = jnp.arange(b)[:, None, None, None]
    g_idx = jnp.arange(g)[None, :, None, None]
    in_blk = jnp.arange(SEL_BLOCK)
    win_len = WINDOW + SEL_BLOCK
    blk_ids = jnp.arange(n_blk)

    def query_block(qb):
        s0 = qb * SEL_BLOCK
        qt = lax.dynamic_slice_in_dim(q, s0, SEL_BLOCK, axis=1)
        t = s0 + in_blk
        sc = jnp.einsum('bqgrd,bngd->bgrqn', qt, kc).astype(jnp.float32) * scale
        sc = sc - slopes[:, :, None, None] * (t[:, None] - cmp_end[None, :]).astype(jnp.float32)
        p_c = masked_softmax(sc, cmp_end[None, :] <= t[:, None])
        o_c = jnp.einsum('bgrqn,bngd->bqgrd', p_c.astype(vc.dtype), vc)
        imp = jnp.einsum('bgrqn,nj->bgqj', p_c, overlap)
        forced = (blk_ids == 0) | (blk_ids == qb) | (blk_ids == qb - 1)
        imp = jnp.where(blk_ids <= qb, imp + jnp.where(forced, FORCE_BONUS, 0.0), NEG_INF)
        _, sel = lax.top_k(imp, n_sel)
        kg = ks_blk[b_idx, g_idx, sel].reshape(b, g, SEL_BLOCK, n_sel * SEL_BLOCK, dk)
        vg = vs_blk[b_idx, g_idx, sel].reshape(b, g, SEL_BLOCK, n_sel * SEL_BLOCK, dk)
        pos_s = (sel[..., None] * SEL_BLOCK + in_blk).reshape(b, g, SEL_BLOCK, n_sel * SEL_BLOCK)
        dist_s = (t[:, None] - pos_s)
        ss = jnp.einsum('bqgrd,bgqmd->bgrqm', qt, kg).astype(jnp.float32) * scale
        ss = ss - slopes[None, :, :, None, None] * dist_s[:, :, None].astype(jnp.float32)
        p_s = masked_softmax(ss, (dist_s >= 0)[:, :, None])
        o_s = jnp.einsum('bgrqm,bgqmd->bqgrd', p_s.astype(vg.dtype), vg)
        kw = lax.dynamic_slice_in_dim(kw_pad, s0, win_len, axis=1)
        vw = lax.dynamic_slice_in_dim(vw_pad, s0, win_len, axis=1)
        pos_w = s0 - WINDOW + jnp.arange(win_len)
        dist_w = t[:, None] - pos_w[None, :]
        mask_w = (dist_w >= 0) & (dist_w < WINDOW) & (pos_w[None, :] >= 0)
        sw = jnp.einsum('bqgrd,bkgd->bgrqk', qt, kw).astype(jnp.float32) * scale
        sw = sw - slopes[:, :, None, None] * dist_w.astype(jnp.float32)
        p_w = masked_softmax(sw, mask_w)
        o_w = jnp.einsum('bgrqk,bkgd->bqgrd', p_w.astype(vw.dtype), vw)
        gt = lax.dynamic_slice_in_dim(gates, s0, SEL_BLOCK, axis=1)
        o = gt[..., 0:1] * o_c + gt[..., 1:2] * o_s + gt[..., 2:3] * o_w
        return o.astype(q.dtype)

    out = lax.map(query_block, jnp.arange(s // SEL_BLOCK))
    return out.transpose(1, 0, 2, 3, 4, 5).reshape(b, s, h * dk)


def diff_attention(q, k, v, lam_params, subln_g, layer):
    b, s, h, _, dk = q.shape
    scale = dk ** -0.5
    lam_init = 0.8 - 0.6 * math.exp(-0.3 * layer)
    lp = lam_params.astype(jnp.float32)
    lam = jnp.exp(jnp.sum(lp[0] * lp[1])) - jnp.exp(jnp.sum(lp[2] * lp[3])) + lam_init
    slopes = alibi_slopes(h)
    kpos = jnp.arange(s)

    def query_block(qb):
        s0 = qb * DIFF_Q_BLOCK
        qt = lax.dynamic_slice_in_dim(q, s0, DIFF_Q_BLOCK, axis=1)
        t = s0 + jnp.arange(DIFF_Q_BLOCK)
        dist = t[:, None] - kpos[None, :]
        sc = jnp.einsum('bqhmd,bkhmd->bhmqk', qt, k).astype(jnp.float32) * scale
        sc = sc - slopes[:, None, None, None] * dist.astype(jnp.float32)
        p = masked_softmax(sc, dist >= 0)
        a = p[:, :, 0] - lam * p[:, :, 1]
        return jnp.einsum('bhqk,bkhd->bqhd', a.astype(v.dtype), v)

    o = lax.map(query_block, jnp.arange(s // DIFF_Q_BLOCK))
    o = o.transpose(1, 0, 2, 3, 4).reshape(b, s, h, DIFF_V_DIM)
    o = rms_norm(o, subln_g) * (1.0 - lam_init)
    return o.reshape(b, s, h * DIFF_V_DIM)


def swiglu(x, w_gu, w_down):
    a, gt = jnp.split(x @ w_gu, 2, axis=-1)
    return (jax.nn.silu(a) * gt) @ w_down


def moe_ffn(h, w_router, router_bias, w_gate_up, w_down, ws_gate_up, ws_down):
    b, s, d = h.shape
    n_tok = b * s
    x = h.reshape(n_tok, d)
    aff = jax.nn.sigmoid(jnp.dot(x.astype(jnp.float32), w_router.astype(jnp.float32)))
    choice = aff + router_bias.astype(jnp.float32)
    per_grp = N_EXPERTS // N_GROUPS
    grp_score = jnp.sum(lax.top_k(choice.reshape(n_tok, N_GROUPS, per_grp), 2)[0], axis=-1)
    _, grp_idx = lax.top_k(grp_score, TOPK_GROUPS)
    grp_mask = jnp.any(grp_idx[..., None] == jnp.arange(N_GROUPS), axis=-2)
    choice = jnp.where(jnp.repeat(grp_mask, per_grp, axis=-1), choice, NEG_INF)
    _, top_idx = lax.top_k(choice, TOP_K)
    top_w = jnp.take_along_axis(aff, top_idx, axis=-1)
    top_w = top_w / jnp.sum(top_w, axis=-1, keepdims=True) * ROUTED_SCALE
    n_asg = n_tok * TOP_K
    e_flat = top_idx.reshape(-1)
    tok_flat = jnp.arange(n_asg, dtype=jnp.int32) // TOP_K
    w_flat = top_w.reshape(-1)
    counts = jnp.bincount(e_flat, length=N_EXPERTS)
    padded = (counts + EXPERT_CHUNK - 1) // EXPERT_CHUNK * EXPERT_CHUNK
    start = jnp.cumsum(counts) - counts
    pend = jnp.cumsum(padded)
    pstart = pend - padded
    order = jnp.argsort(e_flat)
    e_sorted = e_flat[order]
    dest = pstart[e_sorted] + jnp.arange(n_asg) - start[e_sorted]
    n_chunks = (n_asg + N_EXPERTS * (EXPERT_CHUNK - 1) + EXPERT_CHUNK - 1) // EXPERT_CHUNK
    n_rows = n_chunks * EXPERT_CHUNK
    row_tok = jnp.full((n_rows,), n_tok, jnp.int32).at[dest].set(tok_flat[order])
    row_w = jnp.zeros((n_rows,), jnp.float32).at[dest].set(w_flat[order])
    chunk_e = jnp.minimum(jnp.searchsorted(pend, jnp.arange(n_chunks) * EXPERT_CHUNK, side='right'),
                          N_EXPERTS - 1)
    x_pad = jnp.concatenate([x, jnp.zeros((1, d), x.dtype)], axis=0)

    def expert_chunk(args):
        tok, wt, e = args
        y = swiglu(x_pad[tok], w_gate_up[e], w_down[e])
        return (y * wt[:, None]).astype(x.dtype)

    y_rows = lax.map(expert_chunk, (row_tok.reshape(n_chunks, EXPERT_CHUNK),
                                    row_w.reshape(n_chunks, EXPERT_CHUNK), chunk_e))
    routed = jax.ops.segment_sum(y_rows.reshape(n_rows, d), row_tok, num_segments=n_tok + 1)[:n_tok]
    shared = swiglu(x, ws_gate_up, ws_down)
    return (routed + shared).reshape(b, s, d)


def setup_inputs(seed: int = 0) -> dict:
    key = jax.random.key(seed)
    ks = jax.random.split(key, 18)

    def nrm(k, shape, scale):
        return jax.random.normal(k, shape, jnp.float32) * scale

    n_cmp_in = CMP_BLOCK * HEAD_DIM
    return {
        'x': nrm(ks[0], (BATCH, SEQ, D_MODEL), 1.0),
        'c': nrm(ks[1], (BATCH, D_MODEL), 1.0),
        'w_ada': nrm(ks[2], (DEPTH, D_MODEL, 6 * D_MODEL), 0.5 * D_MODEL ** -0.5),
        'b_ada': nrm(ks[3], (DEPTH, 6 * D_MODEL), 0.02),
        'norm_g': 1.0 + nrm(ks[4], (DEPTH, 4, D_MODEL), 0.05),
        'w_in': nrm(ks[5], (DEPTH, D_MODEL, IN_WIDTH), D_MODEL ** -0.5),
        'w_cmp1': nrm(ks[6], (DEPTH, 2, n_cmp_in, HEAD_DIM), n_cmp_in ** -0.5),
        'w_cmp2': nrm(ks[7], (DEPTH, 2, HEAD_DIM, HEAD_DIM), HEAD_DIM ** -0.5),
        'pe_cmp': nrm(ks[8], (DEPTH, 2, CMP_BLOCK, HEAD_DIM), 0.1),
        'diff_lambda': nrm(ks[9], (DEPTH, 4, HEAD_DIM), 0.1),
        'diff_subln': 1.0 + nrm(ks[10], (DEPTH, DIFF_V_DIM), 0.05),
        'w_out': nrm(ks[11], (DEPTH, MIX_WIDTH, D_MODEL), MIX_WIDTH ** -0.5),
        'w_router': nrm(ks[12], (DEPTH, D_MODEL, N_EXPERTS), D_MODEL ** -0.5),
        'router_bias': nrm(ks[13], (DEPTH, N_EXPERTS), 0.01),
        'w_gate_up': nrm(ks[14], (DEPTH, N_EXPERTS, D_MODEL, 2 * EXPERT_DIM), D_MODEL ** -0.5),
        'w_down': nrm(ks[15], (DEPTH, N_EXPERTS, EXPERT_DIM, D_MODEL), EXPERT_DIM ** -0.5),
        'ws_gate_up': nrm(ks[16], (DEPTH, D_MODEL, 2 * SHARED_DIM), D_MODEL ** -0.5),
        'ws_down': nrm(ks[17], (DEPTH, SHARED_DIM, D_MODEL), SHARED_DIM ** -0.5),
    }


def reference(x, c, w_ada, b_ada, norm_g, w_in, w_cmp1, w_cmp2, pe_cmp, diff_lambda, diff_subln,
              w_out, w_router, router_bias, w_gate_up, w_down, ws_gate_up, ws_down):
    b, s, d = x.shape
    split_at = np.cumsum(IN_SPLITS)[:-1].tolist()
    for layer in range(DEPTH):
        mod = jax.nn.silu(c) @ w_ada[layer] + b_ada[layer]
        sh1, sc1, g1, sh2, sc2, g2 = [m[:, None, :] for m in jnp.split(mod, 6, axis=-1)]
        hmix = rms_norm(x, norm_g[layer, 0]) * (1.0 + sc1) + sh1
        proj = hmix @ w_in[layer]
        nq, kc, vc, ksel, vsel, kwin, vwin, ngate, dq, dkk, dv = jnp.split(proj, split_at, axis=-1)
        kv_shape = (b, s, NSA_KV_HEADS, HEAD_DIM)
        o_nsa = nsa_attention(nq.reshape(b, s, NSA_HEADS, HEAD_DIM),
                              kc.reshape(kv_shape), vc.reshape(kv_shape),
                              ksel.reshape(kv_shape), vsel.reshape(kv_shape),
                              kwin.reshape(kv_shape), vwin.reshape(kv_shape),
                              ngate.reshape(b, s, NSA_HEADS, 3),
                              w_cmp1[layer], w_cmp2[layer], pe_cmp[layer])
        o_diff = diff_attention(dq.reshape(b, s, DIFF_HEADS, 2, HEAD_DIM),
                                dkk.reshape(b, s, DIFF_HEADS, 2, HEAD_DIM),
                                dv.reshape(b, s, DIFF_HEADS, DIFF_V_DIM),
                                diff_lambda[layer], diff_subln[layer], layer)
        y = jnp.concatenate([o_nsa, o_diff], axis=-1) @ w_out[layer]
        x = x + g1 * rms_norm(y, norm_g[layer, 1])
        hffn = rms_norm(x, norm_g[layer, 2]) * (1.0 + sc2) + sh2
        y = moe_ffn(hffn, w_router[layer], router_bias[layer], w_gate_up[layer], w_down[layer],
                    ws_gate_up[layer], ws_down[layer])
        x = x + g2 * rms_norm(y, norm_g[layer, 3])
    return x
```

```cpp
#include <hip/hip_runtime.h>
#include <stdint.h>
#include <stdio.h>

typedef unsigned short bf16_t;
typedef short bf16x8 __attribute__((ext_vector_type(8)));
typedef short bf16x4 __attribute__((ext_vector_type(4)));
typedef float f32x4 __attribute__((ext_vector_type(4)));
typedef float f32x16 __attribute__((ext_vector_type(16)));
typedef unsigned u32x4 __attribute__((ext_vector_type(4)));
typedef unsigned u32x2 __attribute__((ext_vector_type(2)));

#define DEV __device__ __forceinline__

constexpr int T_TOK = 16384, SEQ = 8192, DM = 1024;
constexpr int LD = 2944;
constexpr int QOFF = 0, KCOFF = 512, VCOFF = 640, KSOFF = 768, VSOFF = 896, KWOFF = 1024, VWOFF = 1152,
              DQOFF = 1280, DKOFF = 1792, DVOFF = 2304, GTOFF = 2816;
constexpr int NEXP = 256, CAP = 16384;
constexpr float LOG2E = 1.4426950408889634f;
constexpr float RMS_EPS = 1e-6f;
constexpr int KSTR = 144;

typedef __bf16 bf16v2_t __attribute__((ext_vector_type(2)));
DEV unsigned cvt_pk_bf16(float lo, float hi) { bf16v2_t v; v[0] = (__bf16)lo; v[1] = (__bf16)hi; return __builtin_bit_cast(unsigned, v); }
DEV bf16_t f2bf(float f) { unsigned u = __float_as_uint(f); u += 0x7FFFu + ((u >> 16) & 1u); return (bf16_t)(u >> 16); }
DEV float bf2f(bf16_t b) { return __uint_as_float(((unsigned)b) << 16); }
DEV float bflo(unsigned w) { return __uint_as_float(w << 16); }
DEV float bfhi(unsigned w) { return __uint_as_float(w & 0xffff0000u); }
DEV float fexp2(float x) { return __builtin_amdgcn_exp2f(x); }
DEV float sigmoidf_(float x) { return 1.0f / (1.0f + __expf(-x)); }
DEV int crow(int r, int hi) { return (r & 3) + 8 * (r >> 2) + 4 * hi; }
DEV float wave_sum(float v) {
#pragma unroll
    for (int o = 32; o >= 1; o >>= 1) v += __shfl_xor(v, o);
    return v;
}

#define XB_TMO      128
#define XB_XCNT(j)  (256  + 64 * (j))
#define XB_XSUB(j)  (1280 + 64 * (j))
#define XB_XGEN(j)  (2304 + 64 * (j))
#define XB_TOP      3328
#define XB_TOPGEN   3392
#define XCD_BAR_WORDS 3456
#define XB_SPIN_CAP (1u << 20)
#define LAS __attribute__((address_space(3)))

__device__ __forceinline__ unsigned xb_ld(unsigned* p)              { return __hip_atomic_load(p, __ATOMIC_RELAXED, __HIP_MEMORY_SCOPE_AGENT); }
__device__ __forceinline__ unsigned xb_add(unsigned* p, unsigned v) { return __hip_atomic_fetch_add(p, v, __ATOMIC_RELAXED, __HIP_MEMORY_SCOPE_AGENT); }
__device__ __forceinline__ unsigned xb_xcc_id() { return (unsigned)__builtin_amdgcn_s_getreg((3 << 11) | 20) & 0xFu; }
#define XB_SPIN(cond, bar) do { unsigned _sp = 0; while (cond) { __builtin_amdgcn_s_sleep(1); \
    if ((++_sp & 255u) == 0u) { if (xb_ld(&(bar)[XB_TMO])) break; if (_sp > XB_SPIN_CAP) { atomicAdd(&(bar)[XB_TMO], 1u); break; } } } } while (0)

struct XcdBarrier {
    unsigned* bar; unsigned x;
    volatile LAS unsigned* st;
};
__device__ __forceinline__ XcdBarrier xcd_barrier_post(unsigned* bar, volatile LAS unsigned* st) {
    XcdBarrier b; b.bar = bar; b.x = xb_xcc_id(); b.st = st;
    if (threadIdx.x == 0) (void)xb_add(&bar[XB_XCNT(b.x)], 1u);
    return b;
}
__device__ __forceinline__ void xcd_barrier_complete(unsigned* bar, unsigned x, unsigned& nloc, unsigned& nx) {
    const unsigned G = gridDim.x * gridDim.y * gridDim.z;
    unsigned sum, cnt, mine, sp = 0u;
    for (;;) {
        sum = 0u; cnt = 0u; mine = 0u;
#pragma unroll
        for (unsigned j = 0; j < 16; ++j) { const unsigned c = xb_ld(&bar[XB_XCNT(j)]); sum += c; cnt += (c > 0u) ? 1u : 0u; mine = (j == x) ? c : mine; }
        if (sum == G) break;
        __builtin_amdgcn_s_sleep(1);
        if ((++sp & 255u) == 0u) { if (xb_ld(&bar[XB_TMO])) break; if (sp > XB_SPIN_CAP) { atomicAdd(&bar[XB_TMO], 1u); break; } }
    }
    nloc = mine > 0u ? mine : 1u; nx = cnt > 0u ? cnt : 1u;
}
__device__ __forceinline__ void xcd_barrier(const XcdBarrier& b) {
    asm volatile("s_waitcnt vmcnt(0)" ::: "memory");
    __syncthreads();
    if (threadIdx.x == 0) {
        unsigned* bar = b.bar;
        __builtin_amdgcn_s_waitcnt(0);
        unsigned nloc = b.st[0], nx = b.st[1];
        if (nloc == 0u) { xcd_barrier_complete(bar, b.x, nloc, nx); b.st[0] = nloc; b.st[1] = nx; }
        const unsigned old = xb_add(&bar[XB_XSUB(b.x)], 1u);
        const unsigned gen = old / nloc;
        if (old + 1u == (gen + 1u) * nloc) {
            __builtin_amdgcn_fence(__ATOMIC_RELEASE, "agent");
            asm volatile("s_waitcnt vmcnt(0)" ::: "memory");
            const unsigned og = xb_add(&bar[XB_TOP], 1u);
            const unsigned tg = og / nx;
            if (og + 1u == (tg + 1u) * nx) xb_add(&bar[XB_TOPGEN], 1u);
            else XB_SPIN(xb_ld(&bar[XB_TOPGEN]) == tg, bar);
            __builtin_amdgcn_fence(__ATOMIC_ACQUIRE, "agent");
            xb_add(&bar[XB_XGEN(b.x)], 1u);
            asm volatile("s_waitcnt vmcnt(0)" ::: "memory");
        } else {
            XB_SPIN(xb_ld(&bar[XB_XGEN(b.x)]) == gen, bar);
            __builtin_amdgcn_fence(__ATOMIC_ACQUIRE, "agent");
            asm volatile("s_waitcnt vmcnt(0)" ::: "memory");
        }
    }
    __syncthreads();
}

struct Params {
    const float *x, *c, *w_ada, *b_ada, *norm_g, *w_in, *w_cmp1, *w_cmp2, *pe_cmp, *diff_lambda, *diff_subln,
                *w_out, *w_router, *router_bias, *w_gate_up, *w_down, *ws_gate_up, *ws_down;
    float* out;
    unsigned* ctrl;
    float* mod;
    float* misc;
    bf16_t* hmix;
    bf16_t* proj;
    bf16_t* vselT;
    bf16_t* vwinT;
    bf16_t* dvT;
    bf16_t* kc;
    bf16_t* vcT;
    bf16_t* ocat;
    float* y;
    bf16_t* hhi;
    bf16_t* hlo;
    float* logits;
    uint2* bucket;
    bf16_t* H;
    bf16_t* yslot;
};
constexpr int CT_Q = 4096;
constexpr int CT_CNT = 8192;
constexpr int CT_WORDS = 16384;

constexpr int L_CTRL = 0;
constexpr int L_MAIN = 64;
constexpr int LDS_BYTES = 64 + 52736 + 65536;

template <bool TRANS, class AL, class BL, class EP>
DEV void gemm_tile(char* lds, int nk, const AL& al, const BL& bl, const EP& ep) {
    const int tid = threadIdx.x, lane = tid & 63, w = tid >> 6, wm = w >> 2, wn = w & 3, c = lane & 15, q = lane >> 4;
    char* As = lds; char* Bs = lds + 128 * KSTR;
    const int ar0 = tid >> 3, akc = tid & 7, bn4 = tid & 31, bkq = tid >> 5;
    u32x4 ra0, ra1; f32x4 rb[4];
    f32x4 acc[4][2];
#pragma unroll
    for (int mi = 0; mi < 4; ++mi)
#pragma unroll
        for (int ni = 0; ni < 2; ++ni) acc[mi][ni] = (f32x4){0.f, 0.f, 0.f, 0.f};
    ra0 = al.ld(0, 0); ra1 = al.ld(1, 0);
#pragma unroll
    for (int i = 0; i < 4; ++i) rb[i] = bl.ld(4 * bkq + i, 4 * bn4);
    for (int ks = 0; ks < nk; ++ks) {
        __syncthreads();
        *(u32x4*)(As + ar0 * KSTR + akc * 16) = ra0;
        *(u32x4*)(As + (ar0 + 64) * KSTR + akc * 16) = ra1;
#pragma unroll
        for (int cc = 0; cc < 4; ++cc) {
            u32x2 v; v.x = cvt_pk_bf16(rb[0][cc], rb[1][cc]); v.y = cvt_pk_bf16(rb[2][cc], rb[3][cc]);
            *(u32x2*)(Bs + (4 * bn4 + cc) * KSTR + bkq * 8) = v;
        }
        __syncthreads();
        if (ks + 1 < nk) {
            ra0 = al.ld(0, ks + 1); ra1 = al.ld(1, ks + 1);
#pragma unroll
            for (int i = 0; i < 4; ++i) rb[i] = bl.ld((ks + 1) * 64 + 4 * bkq + i, 4 * bn4);
        }
#pragma unroll
        for (int kk = 0; kk < 2; ++kk) {
            bf16x8 af[4], bfr[2];
#pragma unroll
            for (int mi = 0; mi < 4; ++mi) af[mi] = *(const bf16x8*)(As + (64 * wm + 16 * mi + c) * KSTR + (32 * kk + 8 * q) * 2);
#pragma unroll
            for (int ni = 0; ni < 2; ++ni) bfr[ni] = *(const bf16x8*)(Bs + (32 * wn + 16 * ni + c) * KSTR + (32 * kk + 8 * q) * 2);
#pragma unroll
            for (int mi = 0; mi < 4; ++mi)
#pragma unroll
                for (int ni = 0; ni < 2; ++ni)
                    acc[mi][ni] = TRANS ? __builtin_amdgcn_mfma_f32_16x16x32_bf16(bfr[ni], af[mi], acc[mi][ni], 0, 0, 0)
                                        : __builtin_amdgcn_mfma_f32_16x16x32_bf16(af[mi], bfr[ni], acc[mi][ni], 0, 0, 0);
        }
    }
    ep(acc, wm, wn, c, q);
}

struct ALoadPlain {
    const bf16_t* p0; const bf16_t* p1;
    DEV u32x4 ld(int i, int ks) const { return *(const u32x4*)((i ? p1 : p0) + ks * 64); }
};
struct ALoadRouter {
    const bf16_t *h0, *h1, *l0, *l1;
    DEV u32x4 ld(int i, int ks) const {
        const int seg = ks >> 4, kk = ks & 15;
        const bf16_t* p = (seg == 1) ? (i ? l1 : l0) : (i ? h1 : h0);
        return *(const u32x4*)(p + kk * 64);
    }
};
struct ALoadGather {
    const bf16_t* p0; const bf16_t* p1;
    DEV u32x4 ld(int i, int ks) const {
        const bf16_t* p = i ? p1 : p0;
        if (p) return *(const u32x4*)(p + ks * 64);
        return (u32x4){0u, 0u, 0u, 0u};
    }
};

DEV f32x16 qk32(const char* Ks, int kt, const bf16x8 (&qf)[4], int r, int hi) {
    f32x16 a;
#pragma unroll
    for (int i = 0; i < 16; ++i) a[i] = 0.f;
#pragma unroll
    for (int s = 0; s < 4; ++s) {
        const bf16x8 kf = *(const bf16x8*)(Ks + (32 * kt + r) * KSTR + (16 * s + 8 * hi) * 2);
        a = __builtin_amdgcn_mfma_f32_32x32x16_bf16(kf, qf[s], a, 0, 0, 0);
    }
    return a;
}
template <int NDT>
DEV void pv32(const char* Vs, int kt, const bf16x8 (&pf)[2], f32x16 (&O)[NDT], int r, int hi) {
#pragma unroll
    for (int s2 = 0; s2 < 2; ++s2)
#pragma unroll
        for (int dt = 0; dt < NDT; ++dt) {
            const char* p = Vs + (32 * dt + r) * KSTR + (32 * kt + 16 * s2 + 4 * hi) * 2;
            const bf16x4 lo = *(const bf16x4*)p, hi4 = *(const bf16x4*)(p + 16);
            bf16x8 vf; vf[0] = lo[0]; vf[1] = lo[1]; vf[2] = lo[2]; vf[3] = lo[3]; vf[4] = hi4[0]; vf[5] = hi4[1]; vf[6] = hi4[2]; vf[7] = hi4[3];
            O[dt] = __builtin_amdgcn_mfma_f32_32x32x16_bf16(vf, pf[s2], O[dt], 0, 0, 0);
        }
}
DEV void pack_p(const float (&pv)[16], bf16x8 (&pf)[2]) {
#pragma unroll
    for (int s2 = 0; s2 < 2; ++s2) {
        u32x4 u;
        u.x = cvt_pk_bf16(pv[8 * s2 + 0], pv[8 * s2 + 1]); u.y = cvt_pk_bf16(pv[8 * s2 + 2], pv[8 * s2 + 3]);
        u.z = cvt_pk_bf16(pv[8 * s2 + 4], pv[8 * s2 + 5]); u.w = cvt_pk_bf16(pv[8 * s2 + 6], pv[8 * s2 + 7]);
        pf[s2] = __builtin_bit_cast(bf16x8, u);
    }
}
template <int NDT>
DEV void osm_update(float (&s)[16], float& m, float& l, f32x16 (&O)[NDT]) {
    float mx = s[0];
#pragma unroll
    for (int i = 1; i < 16; ++i) mx = fmaxf(mx, s[i]);
    mx = fmaxf(mx, __shfl_xor(mx, 32));
    const float mn = fmaxf(m, mx);
    const float alpha = fexp2(m - mn);
    float sum = 0.f;
#pragma unroll
    for (int i = 0; i < 16; ++i) { s[i] = fexp2(s[i] - mn); sum += s[i]; }
    l = l * alpha + sum; m = mn;
    if (__any(alpha != 1.0f)) {
#pragma unroll
        for (int dt = 0; dt < NDT; ++dt)
#pragma unroll
            for (int i = 0; i < 16; ++i) O[dt][i] *= alpha;
    }
}
DEV int first_bit4(unsigned a, unsigned b, unsigned c, unsigned d, int from) {
    if (from < 32)  { const unsigned v = a & (0xffffffffu << from); if (v) return __builtin_ctz(v); from = 32; }
    if (from < 64)  { const unsigned v = b & (0xffffffffu << (from - 32)); if (v) return 32 + __builtin_ctz(v); from = 64; }
    if (from < 96)  { const unsigned v = c & (0xffffffffu << (from - 64)); if (v) return 64 + __builtin_ctz(v); from = 96; }
    if (from < 128) { const unsigned v = d & (0xffffffffu << (from - 96)); if (v) return 96 + __builtin_ctz(v); }
    return -1;
}
DEV unsigned range_mask32(int lo, int hi, int base) {
    int a = lo - base, b = hi - base; if (a < 0) a = 0; if (b > 31) b = 31; if (a > b) return 0u;
    const unsigned up = (b == 31) ? 0xffffffffu : ((1u << (b + 1)) - 1u);
    return up & (0xffffffffu << a);
}

template <int MODE>
DEV void nsa_branch(char* Ks, char* Vs, float* imp, const bf16_t* kbase, int kld, const bf16_t* vbase, int vld,
                    unsigned tm0, unsigned tm1, unsigned tm2, unsigned tm3, unsigned mk0, unsigned mk1, unsigned mk2, unsigned mk3,
                    const bf16x8 (&qf)[4], int t, int tl, float slope2, float& m, float& l, float inv, f32x16 (&O)[2]) {
    const int tid = threadIdx.x, lane = tid & 63, r = lane & 31, hi = lane >> 5, krow = tid >> 3, kch = tid & 7;
    const float sc2 = 0.125f * LOG2E;
    int j = first_bit4(tm0, tm1, tm2, tm3, 0);
    u32x4 rk = (u32x4){0u, 0u, 0u, 0u}, rv = (u32x4){0u, 0u, 0u, 0u};
    if (j >= 0) {
        rk = *(const u32x4*)(kbase + (size_t)(64 * j + krow) * kld + kch * 8);
        if (MODE != 0) rv = *(const u32x4*)(vbase + (size_t)krow * vld + 64 * j + kch * 8);
    }
    while (j >= 0) {
        __syncthreads();
        *(u32x4*)(Ks + krow * KSTR + kch * 16) = rk;
        if (MODE != 0) *(u32x4*)(Vs + krow * KSTR + kch * 16) = rv;
        __syncthreads();
        const int jn = first_bit4(tm0, tm1, tm2, tm3, j + 1);
        if (jn >= 0) {
            rk = *(const u32x4*)(kbase + (size_t)(64 * jn + krow) * kld + kch * 8);
            if (MODE != 0) rv = *(const u32x4*)(vbase + (size_t)krow * vld + 64 * jn + kch * 8);
        }
        bool selb = true;
        if (MODE == 2) { const unsigned wsel = (j < 32) ? mk0 : (j < 64) ? mk1 : (j < 96) ? mk2 : mk3; selb = (wsel >> (j & 31)) & 1u; }
#pragma unroll
        for (int kt = 0; kt < 2; ++kt) {
            const f32x16 a = qk32(Ks, kt, qf, r, hi);
            float s[16];
#pragma unroll
            for (int i = 0; i < 16; ++i) {
                const int key = 64 * j + 32 * kt + crow(i, hi);
                int dist; bool valid;
                if (MODE <= 1) { dist = t - (16 * key + 31); valid = dist >= 0; }
                else if (MODE == 2) { dist = t - key; valid = selb && dist >= 0; }
                else { dist = t - key; valid = dist >= 0 && dist < 512; }
                s[i] = valid ? (a[i] * sc2 - slope2 * (float)dist) : -INFINITY;
            }
            if (MODE == 0) {
                float mx = s[0];
#pragma unroll
                for (int i = 1; i < 16; ++i) mx = fmaxf(mx, s[i]);
                mx = fmaxf(mx, __shfl_xor(mx, 32));
                const float mn = fmaxf(m, mx); float sum = 0.f;
#pragma unroll
                for (int i = 0; i < 16; ++i) sum += fexp2(s[i] - mn);
                l = l * fexp2(m - mn) + sum; m = mn;
            } else if (MODE == 1) {
#pragma unroll
                for (int i = 0; i < 16; ++i) s[i] = fexp2(s[i] - m) * inv;
#pragma unroll
                for (int gi = 0; gi < 4; ++gi) {
                    const int jb = 16 * j + 8 * kt + 2 * gi + hi;
                    const float hb = 0.5f * s[4 * gi + 3];
                    const float av = s[4 * gi] + s[4 * gi + 1] + s[4 * gi + 2] + hb;
                    if (av != 0.f) atomicAdd(&imp[tl * 129 + jb], av);
                    if (hb != 0.f) atomicAdd(&imp[tl * 129 + jb + 1], hb);
                }
                bf16x8 pf[2]; pack_p(s, pf); pv32<2>(Vs, kt, pf, O, r, hi);
            } else {
                osm_update<2>(s, m, l, O);
                bf16x8 pf[2]; pack_p(s, pf); pv32<2>(Vs, kt, pf, O, r, hi);
            }
        }
        j = jn;
    }
}

constexpr int N_KS = 0, N_VS = 9216, N_IMP = 18432, N_SEL = N_IMP + 64 * 129 * 4  , N_UNI = N_SEL + 1024, N_OUT = 52736;

DEV void nsa_unit(const Params& p, char* lm, int b, int g, int qb) {
    const int tid = threadIdx.x, lane = tid & 63, w = tid >> 6, r = lane & 31, hi = lane >> 5, hh = w >> 1, th = w & 1;
    const int head = g * 4 + hh, tl = 32 * th + r, t = 64 * qb + tl;
    const size_t row = (size_t)b * SEQ + t;
    const float slope2 = LOG2E / (float)(2 << head);
    char* Ks = lm + N_KS; char* Vs = lm + N_VS; float* imp = (float*)(lm + N_IMP);
    unsigned* selm = (unsigned*)(lm + N_SEL); unsigned* uni = (unsigned*)(lm + N_UNI);
    __syncthreads();
    for (int i = tid; i < 64 * 129; i += 512) imp[i] = 0.f;
    if (tid < 4) uni[tid] = 0u;
    const bf16_t* prow = p.proj + row * LD;
    bf16x8 qf[4];
#pragma unroll
    for (int s = 0; s < 4; ++s) qf[s] = *(const bf16x8*)(prow + QOFF + head * 64 + 16 * s + 8 * hi);
    float gt[3];
#pragma unroll
    for (int c3 = 0; c3 < 3; ++c3) gt[c3] = sigmoidf_(bf2f(prow[GTOFF + head * 3 + c3]));
    float* outl = (float*)(lm + N_OUT) + tid;
    f32x16 O[2];
#pragma unroll
    for (int dt = 0; dt < 2; ++dt)
#pragma unroll
        for (int i = 0; i < 16; ++i) O[dt][i] = 0.f;

    {
        int ncmp = 4 * qb + 3; if (ncmp > 511) ncmp = 511;
        const int ntc = (ncmp + 63) >> 6;
        const unsigned tm0 = (1u << ntc) - 1u;
        const bf16_t* kb = p.kc + (size_t)((b * 2 + g) * 512) * 64;
        const bf16_t* vb = p.vcT + (size_t)((b * 2 + g) * 64) * 512;
        float m = -1e30f, l = 0.f;
        nsa_branch<0>(Ks, Vs, imp, kb, 64, vb, 512, tm0, 0u, 0u, 0u, 0u, 0u, 0u, 0u, qf, t, tl, slope2, m, l, 0.f, O);
        const float lt = l + __shfl_xor(l, 32);
        const float inv = 1.0f / fmaxf(lt, 1e-30f);
        nsa_branch<1>(Ks, Vs, imp, kb, 64, vb, 512, tm0, 0u, 0u, 0u, 0u, 0u, 0u, 0u, qf, t, tl, slope2, m, l, inv, O);
#pragma unroll
        for (int dt = 0; dt < 2; ++dt)
#pragma unroll
            for (int i = 0; i < 16; ++i) { outl[(16 * dt + i) * 512] = gt[0] * O[dt][i]; O[dt][i] = 0.f; }
    }
    __syncthreads();
    for (int tt = 0; tt < 8; ++tt) {
        const int tok = 8 * w + tt;
        unsigned s0 = 0u, s1 = 0u, s2 = 0u, s3 = 0u;
        if (qb + 1 <= 16) {
            s0 = range_mask32(0, qb, 0);
        } else {
            float v0 = -INFINITY, v1 = -INFINITY;
            if (lane <= qb) v0 = imp[tok * 129 + lane] + ((lane == 0 || lane == qb || lane == qb - 1) ? 1e4f : 0.f);
            if (lane + 64 <= qb) v1 = imp[tok * 129 + 64 + lane] + ((lane + 64 == qb || lane + 64 == qb - 1) ? 1e4f : 0.f);
            for (int it = 0; it < 16; ++it) {
                float bv = v0; int bi = lane;
                if (v1 > bv) { bv = v1; bi = lane + 64; }
#pragma unroll
                for (int o = 32; o >= 1; o >>= 1) {
                    const float ov = __shfl_xor(bv, o); const int oi = __shfl_xor(bi, o);
                    if (ov > bv || (ov == bv && oi < bi)) { bv = ov; bi = oi; }
                }
                bi = __builtin_amdgcn_readfirstlane(bi);
                if (bi == lane) v0 = -INFINITY;
                if (bi == lane + 64) v1 = -INFINITY;
                const unsigned bit = 1u << (bi & 31);
                if (bi < 32) s0 |= bit; else if (bi < 64) s1 |= bit; else if (bi < 96) s2 |= bit; else s3 |= bit;
            }
        }
        if (lane == 0) {
            selm[tok * 4 + 0] = s0; selm[tok * 4 + 1] = s1; selm[tok * 4 + 2] = s2; selm[tok * 4 + 3] = s3;
            atomicOr(&uni[0], s0); atomicOr(&uni[1], s1); atomicOr(&uni[2], s2); atomicOr(&uni[3], s3);
        }
    }
    __syncthreads();
    {
        const unsigned u0 = uni[0], u1 = uni[1], u2 = uni[2], u3 = uni[3];
        const unsigned mk0 = selm[tl * 4 + 0], mk1 = selm[tl * 4 + 1], mk2 = selm[tl * 4 + 2], mk3 = selm[tl * 4 + 3];
        const bf16_t* kb = p.proj + (size_t)b * SEQ * LD + KSOFF + g * 64;
        const bf16_t* vb = p.vselT + (size_t)(b * 128 + g * 64) * SEQ;
        float m = -1e30f, l = 0.f;
        nsa_branch<2>(Ks, Vs, imp, kb, LD, vb, SEQ, u0, u1, u2, u3, mk0, mk1, mk2, mk3, qf, t, tl, slope2, m, l, 0.f, O);
        const float lt = l + __shfl_xor(l, 32);
        const float sc = gt[1] / fmaxf(lt, 1e-30f);
#pragma unroll
        for (int dt = 0; dt < 2; ++dt)
#pragma unroll
            for (int i = 0; i < 16; ++i) { outl[(16 * dt + i) * 512] += sc * O[dt][i]; O[dt][i] = 0.f; }
    }
    {
        const int jlo = qb - 8 < 0 ? 0 : qb - 8;
        const unsigned w0 = range_mask32(jlo, qb, 0), w1 = range_mask32(jlo, qb, 32), w2 = range_mask32(jlo, qb, 64), w3 = range_mask32(jlo, qb, 96);
        const bf16_t* kb = p.proj + (size_t)b * SEQ * LD + KWOFF + g * 64;
        const bf16_t* vb = p.vwinT + (size_t)(b * 128 + g * 64) * SEQ;
        float m = -1e30f, l = 0.f;
        nsa_branch<3>(Ks, Vs, imp, kb, LD, vb, SEQ, w0, w1, w2, w3, 0u, 0u, 0u, 0u, qf, t, tl, slope2, m, l, 0.f, O);
        const float lt = l + __shfl_xor(l, 32);
        const float sc = gt[2] / fmaxf(lt, 1e-30f);
#pragma unroll
        for (int dt = 0; dt < 2; ++dt)
#pragma unroll
            for (int i = 0; i < 16; ++i) O[dt][i] = outl[(16 * dt + i) * 512] + sc * O[dt][i];
    }
    bf16_t* orow = p.ocat + row * DM + head * 64;
#pragma unroll
    for (int dt = 0; dt < 2; ++dt)
#pragma unroll
        for (int gi = 0; gi < 4; ++gi) {
            u32x2 v; v.x = cvt_pk_bf16(O[dt][4 * gi], O[dt][4 * gi + 1]); v.y = cvt_pk_bf16(O[dt][4 * gi + 2], O[dt][4 * gi + 3]);
            *(u32x2*)(orow + 32 * dt + 8 * gi + 4 * hi) = v;
        }
}

constexpr int D_K1 = 0, D_K2 = 9216, D_VS = 18432, D_XS = 132;
DEV void diff_unit(const Params& p, char* lm, int b, int h, int qblk) {
    const int tid = threadIdx.x, lane = tid & 63, w = tid >> 6, r = lane & 31, hi = lane >> 5, mp = w >> 2, qs = w & 3;
    const int krow = tid >> 3, kch = tid & 7;
    const int ql = 32 * qs + r, t = 128 * qblk + ql;
    const size_t row = (size_t)b * SEQ + t;
    const float slope2 = LOG2E / (float)(1 << (2 * (h + 1)));
    const float sc2 = 0.125f * LOG2E;
    char* K1s = lm + D_K1; char* K2s = lm + D_K2; char* Vs = lm + D_VS;
    const char* myK = mp ? K2s : K1s;
    const bf16_t* prow = p.proj + row * LD;
    bf16x8 qf[4];
#pragma unroll
    for (int s = 0; s < 4; ++s) qf[s] = *(const bf16x8*)(prow + DQOFF + h * 128 + mp * 64 + 16 * s + 8 * hi);
    f32x16 O[4];
#pragma unroll
    for (int dt = 0; dt < 4; ++dt)
#pragma unroll
        for (int i = 0; i < 16; ++i) O[dt][i] = 0.f;
    float m = -1e30f, l = 0.f;
    const bf16_t* kb = p.proj + (size_t)b * SEQ * LD + DKOFF + h * 128;
    const bf16_t* vb = p.dvT + (size_t)(b * 512 + h * 128) * SEQ;
    const int ntl = 2 * qblk + 2;
    u32x4 r1, r2, rv0, rv1;
    r1 = *(const u32x4*)(kb + (size_t)krow * LD + kch * 8);
    r2 = *(const u32x4*)(kb + (size_t)krow * LD + 64 + kch * 8);
    rv0 = *(const u32x4*)(vb + (size_t)krow * SEQ + kch * 8);
    rv1 = *(const u32x4*)(vb + (size_t)(krow + 64) * SEQ + kch * 8);
    for (int j = 0; j < ntl; ++j) {
        __syncthreads();
        *(u32x4*)(K1s + krow * KSTR + kch * 16) = r1;
        *(u32x4*)(K2s + krow * KSTR + kch * 16) = r2;
        *(u32x4*)(Vs + krow * KSTR + kch * 16) = rv0;
        *(u32x4*)(Vs + (krow + 64) * KSTR + kch * 16) = rv1;
        __syncthreads();
        if (j + 1 < ntl) {
            const int k0 = 64 * (j + 1);
            r1 = *(const u32x4*)(kb + (size_t)(k0 + krow) * LD + kch * 8);
            r2 = *(const u32x4*)(kb + (size_t)(k0 + krow) * LD + 64 + kch * 8);
            rv0 = *(const u32x4*)(vb + (size_t)krow * SEQ + k0 + kch * 8);
            rv1 = *(const u32x4*)(vb + (size_t)(krow + 64) * SEQ + k0 + kch * 8);
        }
#pragma unroll
        for (int kt = 0; kt < 2; ++kt) {
            const f32x16 a = qk32(myK, kt, qf, r, hi);
            float s[16];
#pragma unroll
            for (int i = 0; i < 16; ++i) {
                const int dist = t - (64 * j + 32 * kt + crow(i, hi));
                s[i] = dist >= 0 ? (a[i] * sc2 - slope2 * (float)dist) : -INFINITY;
            }
            osm_update<4>(s, m, l, O);
            bf16x8 pf[2]; pack_p(s, pf); pv32<4>(Vs, kt, pf, O, r, hi);
        }
    }
    const float lt = l + __shfl_xor(l, 32);
    const float inv = 1.0f / fmaxf(lt, 1e-30f);
    __syncthreads();
    float* X = (float*)lm;
    if (mp == 1) {
#pragma unroll
        for (int dt = 0; dt < 4; ++dt)
#pragma unroll
            for (int i = 0; i < 16; ++i) X[ql * D_XS + 32 * dt + crow(i, hi)] = O[dt][i] * inv;
    }
    __syncthreads();
    if (mp == 0) {
        const float lam = p.misc[0];
        float ss = 0.f;
#pragma unroll
        for (int dt = 0; dt < 4; ++dt)
#pragma unroll
            for (int i = 0; i < 16; ++i) { const float o = O[dt][i] * inv - lam * X[ql * D_XS + 32 * dt + crow(i, hi)]; O[dt][i] = o; ss += o * o; }
        ss += __shfl_xor(ss, 32);
        const float rs = rsqrtf(ss * (1.0f / 128.0f) + RMS_EPS) * 0.8f;
        bf16_t* orow = p.ocat + row * DM + 512 + h * 128;
#pragma unroll
        for (int dt = 0; dt < 4; ++dt)
#pragma unroll
            for (int gi = 0; gi < 4; ++gi) {
                const int d0 = 32 * dt + 8 * gi + 4 * hi;
                const f32x4 gv = *(const f32x4*)(p.diff_subln + d0);
                u32x2 v; v.x = cvt_pk_bf16(O[dt][4 * gi] * rs * gv[0], O[dt][4 * gi + 1] * rs * gv[1]);
                v.y = cvt_pk_bf16(O[dt][4 * gi + 2] * rs * gv[2], O[dt][4 * gi + 3] * rs * gv[3]);
                *(u32x2*)(orow + d0) = v;
            }
    }
    __syncthreads();
}

struct BLoadIn {
    const float* w; int n0;
    DEV f32x4 ld(int k, int n) const {
        const int cp = n0 + n; int cg;
        if (cp < 1280) cg = cp; else if (cp < 2816) cg = cp + 24; else if (cp < 2840) cg = cp - 2816 + 1280; else return (f32x4){0.f, 0.f, 0.f, 0.f};
        return *(const f32x4*)(w + (size_t)k * 2840 + cg);
    }
};
struct BLoadPlain { const float* w; int ldb; DEV f32x4 ld(int k, int n) const { return *(const f32x4*)(w + (size_t)k * ldb + n); } };
struct BLoadRouter {
    const float* w;
    DEV f32x4 ld(int k, int n) const {
        const int seg = k >> 10, kk = k & 1023;
        f32x4 v = *(const f32x4*)(w + (size_t)kk * 256 + n);
        if (seg == 2) {
#pragma unroll
            for (int i = 0; i < 4; ++i) v[i] = v[i] - bf2f(f2bf(v[i]));
        }
        return v;
    }
};
struct BLoadGU {
    const float* w; int nt;
    DEV f32x4 ld(int k, int n) const {
        const int col = ((n & 31) >> 4) * 256 + 64 * nt + 16 * (n >> 5) + (n & 15);
        return *(const f32x4*)(w + (size_t)k * 512 + col);
    }
};

struct EpiProj {
    bf16_t* o; int row0, col0;
    DEV void operator()(const f32x4 (&acc)[4][2], int wm, int wn, int c, int q) const {
#pragma unroll
        for (int mi = 0; mi < 4; ++mi)
#pragma unroll
            for (int ni = 0; ni < 2; ++ni) {
                const f32x4 v = acc[mi][ni]; u32x2 u; u.x = cvt_pk_bf16(v[0], v[1]); u.y = cvt_pk_bf16(v[2], v[3]);
                *(u32x2*)(o + (size_t)(row0 + 64 * wm + 16 * mi + c) * LD + col0 + 32 * wn + 16 * ni + 4 * q) = u;
            }
    }
};
struct EpiVT {
    bf16_t* vt; int vrow0, t0, vlim;
    DEV void operator()(const f32x4 (&acc)[4][2], int wm, int wn, int c, int q) const {
#pragma unroll
        for (int mi = 0; mi < 4; ++mi)
#pragma unroll
            for (int ni = 0; ni < 2; ++ni) {
                const f32x4 v = acc[mi][ni]; u32x2 u; u.x = cvt_pk_bf16(v[0], v[1]); u.y = cvt_pk_bf16(v[2], v[3]);
                { const int vr = vrow0 + 32 * wn + 16 * ni + c, tt = t0 + 64 * wm + 16 * mi + 4 * q;
                  if (vr >= 0 && vr < vlim && tt >= 0 && tt + 3 < SEQ) *(u32x2*)(vt + (size_t)vr * SEQ + tt) = u; }
            }
    }
};
struct EpiF32 {
    float* o; int ldo, row0, col0;
    DEV void operator()(const f32x4 (&acc)[4][2], int wm, int wn, int c, int q) const {
#pragma unroll
        for (int mi = 0; mi < 4; ++mi)
#pragma unroll
            for (int ni = 0; ni < 2; ++ni)
                *(f32x4*)(o + (size_t)(row0 + 64 * wm + 16 * mi + c) * ldo + col0 + 32 * wn + 16 * ni + 4 * q) = acc[mi][ni];
    }
};
struct EpiSwiglu {
    bf16_t* H; const int* rslot; const float* rwt; int nt;
    DEV void operator()(const f32x4 (&acc)[4][2], int wm, int wn, int c, int q) const {
#pragma unroll
        for (int mi = 0; mi < 4; ++mi) {
            const int rr = 64 * wm + 16 * mi + c; const int slot = rslot[rr];
            if (slot >= 0) {
                const float wt = rwt[rr]; const f32x4 a = acc[mi][0], g = acc[mi][1]; float hv[4];
#pragma unroll
                for (int i = 0; i < 4; ++i) hv[i] = a[i] / (1.0f + __expf(-a[i])) * g[i] * wt;
                u32x2 u; u.x = cvt_pk_bf16(hv[0], hv[1]); u.y = cvt_pk_bf16(hv[2], hv[3]);
                *(u32x2*)(H + (size_t)slot * 256 + 64 * nt + 16 * wn + 4 * q) = u;
            }
        }
    }
};
struct EpiSlot {
    bf16_t* Y; const int* rslot; int nt;
    DEV void operator()(const f32x4 (&acc)[4][2], int wm, int wn, int c, int q) const {
#pragma unroll
        for (int mi = 0; mi < 4; ++mi) {
            const int rr = 64 * wm + 16 * mi + c; const int slot = rslot[rr];
            if (slot >= 0) {
#pragma unroll
                for (int ni = 0; ni < 2; ++ni) {
                    const f32x4 v = acc[mi][ni]; u32x2 u; u.x = cvt_pk_bf16(v[0], v[1]); u.y = cvt_pk_bf16(v[2], v[3]);
                    *(u32x2*)(Y + (size_t)slot * 1024 + 128 * nt + 32 * wn + 16 * ni + 4 * q) = u;
                }
            }
        }
    }
};

DEV int entry_cnt(const unsigned* cnt, int e) { if (e >= 256) return 2048; const unsigned n = cnt[e]; return n > (unsigned)CAP ? CAP : (int)n; }

template <int STAGE>
DEV void moe_phase(const Params& p, char* lds, unsigned xcc) {
    char* lm = lds + L_MAIN;
    int* pre = (int*)(lm + 40960);
    int* rslot = (int*)(lm + 40960 + 2048);
    float* rwt = (float*)(lm + 40960 + 2048 + 512);
    int* bc = (int*)(lds + L_CTRL + 16);
    const unsigned* cnt = p.ctrl + CT_CNT;
    const int tid = threadIdx.x;
    constexpr int NT = (STAGE == 1) ? 4 : 8;
    __syncthreads();
    if (tid < 8) {
        int s = 0;
        for (int k = 0; k < 33; ++k) { pre[tid * 34 + k] = s; const int n = entry_cnt(cnt, tid + 8 * k); s += ((n + 127) >> 7) * NT; }
        pre[tid * 34 + 33] = s;
    }
    __syncthreads();
    for (int xo = 0; xo < 8; ++xo) {
        const int x = (int)((xcc + xo) & 7u);
        unsigned* qc = p.ctrl + CT_Q + 64 * ((STAGE == 1 ? 16 : 32) + x);
        const int total = pre[x * 34 + 33];
        for (;;) {
            __syncthreads();
            if (tid == 0) {
                const int u = (int)atomicAdd(qc, 1u);
                int k = -1;
                if (u < total) { k = 0; while (pre[x * 34 + k + 1] <= u) ++k; }
                bc[0] = u; bc[1] = k;
            }
            __syncthreads();
            const int u = bc[0], k = bc[1];
            if (k < 0) break;
            const int e = x + 8 * k, local = u - pre[x * 34 + k];
            const int mt = local / NT, nt = local % NT;
            const int n_e = entry_cnt(cnt, e);
            if (tid < 128) {
                const int idx = mt * 128 + tid; int slot = -1; float wt = 0.f;
                if (idx < n_e) {
                    if (e < 256) { const uint2 en = p.bucket[(size_t)e * CAP + idx]; slot = (int)en.x; wt = __uint_as_float(en.y); if ((unsigned)slot >= (unsigned)(T_TOK * 9)) slot = -1; }
                    else { slot = ((e - 256) * 2048 + idx) * 9 + 8; wt = 1.0f; }
                }
                rslot[tid] = slot; rwt[tid] = wt;
            }
            __syncthreads();
            const int s0 = rslot[tid >> 3], s1 = rslot[(tid >> 3) + 64];
            if (STAGE == 1) {
                ALoadGather al;
                al.p0 = s0 >= 0 ? p.hhi + (size_t)(s0 / 9) * 1024 + (tid & 7) * 8 : nullptr;
                al.p1 = s1 >= 0 ? p.hhi + (size_t)(s1 / 9) * 1024 + (tid & 7) * 8 : nullptr;
                BLoadGU bl; bl.w = e < 256 ? p.w_gate_up + (size_t)e * 1024 * 512 : p.ws_gate_up; bl.nt = nt;
                EpiSwiglu ep; ep.H = p.H; ep.rslot = rslot; ep.rwt = rwt; ep.nt = nt;
                gemm_tile<true>(lm, 16, al, bl, ep);
            } else {
                ALoadGather al;
                al.p0 = s0 >= 0 ? p.H + (size_t)s0 * 256 + (tid & 7) * 8 : nullptr;
                al.p1 = s1 >= 0 ? p.H + (size_t)s1 * 256 + (tid & 7) * 8 : nullptr;
                BLoadPlain bl; bl.w = (e < 256 ? p.w_down + (size_t)e * 256 * 1024 : p.ws_down) + 128 * nt; bl.ldb = 1024;
                EpiSlot ep; ep.Y = p.yslot; ep.rslot = rslot; ep.nt = nt;
                gemm_tile<true>(lm, 4, al, bl, ep);
            }
        }
    }
}

#ifndef STOP_AFTER
#define STOP_AFTER 99
#endif
DEV void dump_out(const Params& p, int k) {
    const size_t n = (size_t)T_TOK * DM;
    for (size_t i = (size_t)blockIdx.x * 512 + threadIdx.x; i < n; i += (size_t)gridDim.x * 512) {
        float v = 0.f;
        if (k == 1) v = bf2f(p.hmix[i]);
        else if (k == 0) v = i < 12288 ? p.mod[i] : i < 12288 + 192 ? p.misc[i - 12288] : 0.f;
        else if (k == 2) v = (i % 2944 < 896 || (i % 2944 >= 1024 && i % 2944 < 1152) || (i % 2944 >= 1280 && i % 2944 < 2304) || i % 2944 >= 2816) ? bf2f(p.proj[i]) : 0.f;
        else if (k == 3) v = i < 131072 ? bf2f(p.kc[i]) : i < 262144 ? bf2f(p.vcT[i - 131072]) : i < 262144 + 12582912 ? bf2f(p.vselT[i - 262144]) : 0.f;
        else if (k == 4) v = bf2f(p.ocat[i]);
        else if (k == 5) v = p.y[i];
        else if (k == 6) v = bf2f(p.hhi[i]) + 64.f * bf2f(p.hlo[i]);
        else if (k == 7) v = i < (size_t)T_TOK * 256 ? p.logits[i] : 0.f;
        else if (k == 8) v = i < 256 ? (float)p.ctrl[CT_CNT + i] : 0.f;
        else if (k == 9) v = bf2f(p.H[i]) + bf2f(p.H[i + n]);
        else if (k == 10) v = bf2f(p.yslot[i]) + bf2f(p.yslot[i + 4 * n]) + bf2f(p.yslot[i + 8 * n]);
        p.out[i] = v;
    }
}
#define STOP_AT(k) do { if (STOP_AFTER == (k)) { dump_out(p, (k)); return; } } while (0)
__global__ void __launch_bounds__(512, 2) fwd_kernel(Params p) {
    extern __shared__ __attribute__((aligned(16))) char lds[];
    const int tid = threadIdx.x, lane = tid & 63, w = tid >> 6;
    const int nb = gridDim.x, bid = blockIdx.x;
    char* lm = lds + L_MAIN;
    if (tid < 16) ((unsigned*)lds)[tid] = 0u;
    __syncthreads();
    XcdBarrier bar = xcd_barrier_post(p.ctrl, (volatile LAS unsigned*)lds);
    const unsigned xcc = bar.x & 7u;
    int* bc = (int*)(lds + L_CTRL + 16);

    {
        float* sc = (float*)lm;
        float* red = (float*)(lm + 8192);
        for (int i = tid; i < 2048; i += 512) { const float v = p.c[i]; sc[i] = v / (1.0f + __expf(-v)); }
        __syncthreads();
        for (int cb = bid; cb < 256; cb += nb) {
            if (tid < 480) {
                const int j = tid % 24, ks = tid / 24; const int col = cb * 24 + j;
                float a0 = 0.f, a1 = 0.f;
                for (int k = ks; k < 1024; k += 20) { const float wv = p.w_ada[(size_t)k * 6144 + col]; a0 += sc[k] * wv; a1 += sc[1024 + k] * wv; }
                red[(ks * 24 + j) * 2] = a0; red[(ks * 24 + j) * 2 + 1] = a1;
            }
            __syncthreads();
            if (tid < 48) {
                const int j = tid >> 1, bb = tid & 1; float s = 0.f;
                for (int ks = 0; ks < 20; ++ks) s += red[(ks * 24 + j) * 2 + bb];
                const int col = cb * 24 + j;
                p.mod[bb * 6144 + col] = s + p.b_ada[col];
            }
            __syncthreads();
        }
        for (int kv = bid; kv < 2; kv += nb) {
            const int n = tid & 63, ks = tid >> 6; float a = 0.f;
            for (int k = ks; k < 2048; k += 8) a += p.pe_cmp[kv * 2048 + k] * p.w_cmp1[((size_t)kv * 2048 + k) * 64 + n];
            red[ks * 64 + n] = a;
            __syncthreads();
            if (tid < 64) { float s = 0.f; for (int q8 = 0; q8 < 8; ++q8) s += red[q8 * 64 + tid]; p.misc[64 + kv * 64 + tid] = s; }
            __syncthreads();
        }
        if (bid == (2 % nb) && tid == 0) {
            float s01 = 0.f, s23 = 0.f;
            for (int i = 0; i < 64; ++i) { s01 += p.diff_lambda[i] * p.diff_lambda[64 + i]; s23 += p.diff_lambda[128 + i] * p.diff_lambda[192 + i]; }
            p.misc[0] = __expf(s01) - __expf(s23) + 0.2f;
        }
        if (bid == (3 % nb)) {
            for (int i = tid; i < 4 * 64; i += 512) { const int bg = i >> 6, d = i & 63; p.kc[((size_t)bg * 512 + 511) * 64 + d] = 0; p.vcT[((size_t)bg * 64 + d) * 512 + 511] = 0; }
        }
    }
    xcd_barrier(bar);
    STOP_AT(0);

    for (int row = bid * 8 + w; row < T_TOK; row += nb * 8) {
        const int bb = row >> 13; const float* xr = p.x + (size_t)row * DM;
        f32x4 v[4]; float ss = 0.f;
#pragma unroll
        for (int j = 0; j < 4; ++j) { v[j] = *(const f32x4*)(xr + lane * 4 + 256 * j); ss += v[j][0] * v[j][0] + v[j][1] * v[j][1] + v[j][2] * v[j][2] + v[j][3] * v[j][3]; }
        ss = wave_sum(ss);
        const float rs = rsqrtf(ss * (1.0f / 1024.0f) + RMS_EPS);
#pragma unroll
        for (int j = 0; j < 4; ++j) {
            const int col = lane * 4 + 256 * j;
            const f32x4 g = *(const f32x4*)(p.norm_g + col), s1 = *(const f32x4*)(p.mod + bb * 6144 + 1024 + col), h1 = *(const f32x4*)(p.mod + bb * 6144 + col);
            float o[4];
#pragma unroll
            for (int i = 0; i < 4; ++i) o[i] = v[j][i] * rs * g[i] * (1.0f + s1[i]) + h1[i];
            u32x2 u; u.x = cvt_pk_bf16(o[0], o[1]); u.y = cvt_pk_bf16(o[2], o[3]);
            *(u32x2*)(p.hmix + (size_t)row * DM + col) = u;
        }
    }
    xcd_barrier(bar);
    STOP_AT(1);

    for (int u = bid; u < 128 * 23; u += nb) {
        const int nt = u / 128, mt = u % 128;
        ALoadPlain al; al.p0 = p.hmix + (size_t)(mt * 128 + (tid >> 3)) * DM + (tid & 7) * 8; al.p1 = al.p0 + (size_t)64 * DM;
        BLoadIn bl; bl.w = p.w_in; bl.n0 = nt * 128;
        const bool vt = (nt == 7) || (nt == 9) || (nt >= 18 && nt <= 21);
        if (!vt) {
            EpiProj ep; ep.o = p.proj; ep.row0 = mt * 128; ep.col0 = nt * 128;
            gemm_tile<true>(lm, 16, al, bl, ep);
        } else {
            const int bb = mt >> 6, t0 = (mt & 63) * 128;
            EpiVT ep; ep.t0 = t0; ep.vt = p.vselT; ep.vlim = 1536;
            ep.vrow0 = (nt == 7) ? bb * 128 : (nt == 9) ? 256 + bb * 128 : 512 + bb * 512 + (nt - 18) * 128;
            gemm_tile<false>(lm, 16, al, bl, ep);
        }
    }
    xcd_barrier(bar);
    STOP_AT(2);

    for (int u = bid; u < 256; u += nb) {
        const int kv = u >> 7, bb = (u >> 6) & 1, g = (u >> 5) & 1, ch = u & 31, n0 = ch * 16;
        bf16_t* raw = (bf16_t*)lm;
        float* hid = (float*)(lm + 272 * 128);
        __syncthreads();
        for (int i = tid; i < 272 * 8; i += 512) {
            const int tk = i >> 3, chn = i & 7; const int tok = 16 * n0 + tk;
            u32x4 v = (u32x4){0u, 0u, 0u, 0u};
            if (tok < SEQ) v = *(const u32x4*)(p.proj + ((size_t)bb * SEQ + tok) * LD + (kv ? VCOFF : KCOFF) + g * 64 + chn * 8);
            *(u32x4*)(raw + tk * 64 + chn * 8) = v;
        }
        __syncthreads();
        const int rr = tid >> 5, c2 = tid & 31;
        const float* w1 = p.w_cmp1 + (size_t)kv * 2048 * 64 + 2 * c2;
        float a0 = p.misc[64 + kv * 64 + 2 * c2], a1 = p.misc[64 + kv * 64 + 2 * c2 + 1];
        for (int i = 0; i < 32; ++i) {
            const bf16_t* rp = raw + (16 * rr + i) * 64;
#pragma unroll 2
            for (int d8 = 0; d8 < 8; ++d8) {
                const u32x4 rv = *(const u32x4*)(rp + d8 * 8);
                const float av[8] = {bflo(rv.x), bfhi(rv.x), bflo(rv.y), bfhi(rv.y), bflo(rv.z), bfhi(rv.z), bflo(rv.w), bfhi(rv.w)};
#pragma unroll
                for (int e = 0; e < 8; ++e) { const float2 wv = *(const float2*)(w1 + (size_t)(i * 64 + d8 * 8 + e) * 64); a0 += av[e] * wv.x; a1 += av[e] * wv.y; }
            }
        }
        {
            const float k0 = 0.7978845608028654f, k1 = 0.044715f;
            const float t0 = tanhf(k0 * (a0 + k1 * a0 * a0 * a0)), t1 = tanhf(k0 * (a1 + k1 * a1 * a1 * a1));
            hid[rr * 64 + 2 * c2] = 0.5f * a0 * (1.0f + t0); hid[rr * 64 + 2 * c2 + 1] = 0.5f * a1 * (1.0f + t1);
        }
        __syncthreads();
        const float* w2 = p.w_cmp2 + (size_t)kv * 64 * 64 + 2 * c2;
        float o0 = 0.f, o1 = 0.f;
        for (int jx = 0; jx < 64; ++jx) { const float hv = hid[rr * 64 + jx]; const float2 wv = *(const float2*)(w2 + jx * 64); o0 += hv * wv.x; o1 += hv * wv.y; }
        const int n = n0 + rr;
        if (n < 511) {
            if (kv == 0) { *(unsigned*)(p.kc + ((size_t)(bb * 2 + g) * 512 + n) * 64 + 2 * c2) = cvt_pk_bf16(o0, o1); }
            else { p.vcT[((size_t)(bb * 2 + g) * 64 + 2 * c2) * 512 + n] = f2bf(o0); p.vcT[((size_t)(bb * 2 + g) * 64 + 2 * c2 + 1) * 512 + n] = f2bf(o1); }
        }
    }
    xcd_barrier(bar);
    STOP_AT(3);

    {
        int u;
        for (;;) {
            __syncthreads();
            if (tid == 0) bc[0] = (int)atomicAdd(p.ctrl + CT_Q, 1u);
            __syncthreads();
            u = bc[0];
            if (u >= 512) break;
            const int qk = 63 - (u >> 3), bh = u & 7;
            diff_unit(p, lm, bh >> 2, bh & 3, qk);
        }
        while (u < 1024) {
            const int v = u - 512; const int qb = 127 - (v >> 2), bg = v & 3;
            nsa_unit(p, lm, bg >> 1, bg & 1, qb);
            __syncthreads();
            if (tid == 0) bc[0] = (int)atomicAdd(p.ctrl + CT_Q, 1u);
            __syncthreads();
            u = bc[0];
        }
    }
    xcd_barrier(bar);
    STOP_AT(4);

    for (int u = bid; u < 128 * 8; u += nb) {
        const int nt = u / 128, mt = u % 128;
        ALoadPlain al; al.p0 = p.ocat + (size_t)(mt * 128 + (tid >> 3)) * DM + (tid & 7) * 8; al.p1 = al.p0 + (size_t)64 * DM;
        BLoadPlain bl; bl.w = p.w_out + nt * 128; bl.ldb = 1024;
        EpiF32 ep; ep.o = p.y; ep.ldo = 1024; ep.row0 = mt * 128; ep.col0 = nt * 128;
        gemm_tile<true>(lm, 16, al, bl, ep);
    }
    xcd_barrier(bar);
    STOP_AT(5);

    for (int row = bid * 8 + w; row < T_TOK; row += nb * 8) {
        const int bb = row >> 13; const float* md = p.mod + bb * 6144;
        f32x4 yv[4], xv[4]; float ss = 0.f;
#pragma unroll
        for (int j = 0; j < 4; ++j) { yv[j] = *(const f32x4*)(p.y + (size_t)row * DM + lane * 4 + 256 * j); ss += yv[j][0] * yv[j][0] + yv[j][1] * yv[j][1] + yv[j][2] * yv[j][2] + yv[j][3] * yv[j][3]; }
        ss = wave_sum(ss);
        const float rs = rsqrtf(ss * (1.0f / 1024.0f) + RMS_EPS);
        float ss2 = 0.f;
#pragma unroll
        for (int j = 0; j < 4; ++j) {
            const int col = lane * 4 + 256 * j;
            const f32x4 xx = *(const f32x4*)(p.x + (size_t)row * DM + col), g = *(const f32x4*)(p.norm_g + 1024 + col), g1 = *(const f32x4*)(md + 2048 + col);
#pragma unroll
            for (int i = 0; i < 4; ++i) { xv[j][i] = xx[i] + g1[i] * (yv[j][i] * rs * g[i]); ss2 += xv[j][i] * xv[j][i]; }
            *(f32x4*)(p.out + (size_t)row * DM + col) = xv[j];
        }
        ss2 = wave_sum(ss2);
        const float rs2 = rsqrtf(ss2 * (1.0f / 1024.0f) + RMS_EPS);
#pragma unroll
        for (int j = 0; j < 4; ++j) {
            const int col = lane * 4 + 256 * j;
            const f32x4 g = *(const f32x4*)(p.norm_g + 2048 + col), s2 = *(const f32x4*)(md + 4096 + col), h2 = *(const f32x4*)(md + 3072 + col);
            float hv[4], lo[4];
#pragma unroll
            for (int i = 0; i < 4; ++i) { hv[i] = xv[j][i] * rs2 * g[i] * (1.0f + s2[i]) + h2[i]; lo[i] = hv[i] - bf2f(f2bf(hv[i])); }
            u32x2 uh, ul; uh.x = cvt_pk_bf16(hv[0], hv[1]); uh.y = cvt_pk_bf16(hv[2], hv[3]); ul.x = cvt_pk_bf16(lo[0], lo[1]); ul.y = cvt_pk_bf16(lo[2], lo[3]);
            *(u32x2*)(p.hhi + (size_t)row * DM + col) = uh; *(u32x2*)(p.hlo + (size_t)row * DM + col) = ul;
        }
    }
    xcd_barrier(bar);
    STOP_AT(6);

    for (int u = bid; u < 256; u += nb) {
        const int nt = u / 128, mt = u % 128;
        ALoadRouter al; const size_t ro = (size_t)(mt * 128 + (tid >> 3)) * DM + (tid & 7) * 8;
        al.h0 = p.hhi + ro; al.h1 = al.h0 + (size_t)64 * DM; al.l0 = p.hlo + ro; al.l1 = al.l0 + (size_t)64 * DM;
        BLoadRouter bl; bl.w = p.w_router + nt * 128;
        EpiF32 ep; ep.o = p.logits; ep.ldo = 256; ep.row0 = mt * 128; ep.col0 = nt * 128;
        gemm_tile<true>(lm, 48, al, bl, ep);
    }
    xcd_barrier(bar);
    STOP_AT(7);

    for (int tok = bid * 8 + w; tok < T_TOK; tok += nb * 8) {
        const f32x4 lg = *(const f32x4*)(p.logits + (size_t)tok * 256 + lane * 4);
        const f32x4 rb = *(const f32x4*)(p.router_bias + lane * 4);
        float aff[4], ch[4];
#pragma unroll
        for (int i = 0; i < 4; ++i) { aff[i] = 1.0f / (1.0f + __expf(-lg[i])); ch[i] = aff[i] + rb[i]; }
        float m1 = fmaxf(ch[0], ch[1]), m2 = fminf(ch[0], ch[1]);
#pragma unroll
        for (int i = 2; i < 4; ++i) { const float v = ch[i]; if (v > m1) { m2 = m1; m1 = v; } else if (v > m2) m2 = v; }
#pragma unroll
        for (int o = 1; o <= 4; o <<= 1) {
            const float o1 = __shfl_xor(m1, o), o2 = __shfl_xor(m2, o);
            const float n1 = fmaxf(m1, o1), n2 = fmaxf(fminf(m1, o1), fmaxf(m2, o2));
            m1 = n1; m2 = n2;
        }
        const float gs = m1 + m2; const int grp = lane >> 3;
        int rank = 0;
#pragma unroll
        for (int g2 = 0; g2 < 8; ++g2) { const float og = __shfl(gs, g2 * 8); if (og > gs || (og == gs && g2 < grp)) ++rank; }
        const bool gsel = rank < 4;
#pragma unroll
        for (int i = 0; i < 4; ++i) if (!gsel) ch[i] = -INFINITY;
        int myidx = -1; float myaff = 0.f, asum = 0.f;
        for (int it = 0; it < 8; ++it) {
            float bv = ch[0]; int bi = lane * 4;
#pragma unroll
            for (int i = 1; i < 4; ++i) if (ch[i] > bv) { bv = ch[i]; bi = lane * 4 + i; }
#pragma unroll
            for (int o = 32; o >= 1; o >>= 1) {
                const float ov = __shfl_xor(bv, o); const int oi = __shfl_xor(bi, o);
                if (ov > bv || (ov == bv && oi < bi)) { bv = ov; bi = oi; }
            }
            bi = __builtin_amdgcn_readfirstlane(bi);
            float av = 0.f;
            if ((bi >> 2) == lane) {
#pragma unroll
                for (int i = 0; i < 4; ++i) if ((bi & 3) == i) { av = aff[i]; ch[i] = -INFINITY; }
            }
            av = __shfl(av, bi >> 2);
            asum += av;
            if (lane == it) { myidx = bi; myaff = av; }
        }
        if (lane < 8) {
            const float wt = myaff / asum * 2.5f;
            const unsigned pos = atomicAdd(p.ctrl + CT_CNT + myidx, 1u);
            uint2 en; en.x = (unsigned)(tok * 9 + lane); en.y = __float_as_uint(wt);
            if (pos < (unsigned)CAP) p.bucket[(size_t)myidx * CAP + pos] = en;
        }
    }
    xcd_barrier(bar);
    STOP_AT(8);

    moe_phase<1>(p, lds, xcc);
    xcd_barrier(bar);
    STOP_AT(9);
    moe_phase<2>(p, lds, xcc);
    xcd_barrier(bar);
    STOP_AT(10);

    for (int row = bid * 8 + w; row < T_TOK; row += nb * 8) {
        const int bb = row >> 13; const float* md = p.mod + bb * 6144;
        float acc[16];
#pragma unroll
        for (int i = 0; i < 16; ++i) acc[i] = 0.f;
        const bf16_t* sp = p.yslot + (size_t)row * 9 * 1024;
        for (int k = 0; k < 9; ++k) {
#pragma unroll
            for (int j = 0; j < 2; ++j) {
                const u32x4 v = *(const u32x4*)(sp + (size_t)k * 1024 + lane * 8 + 512 * j);
                acc[8 * j + 0] += bflo(v.x); acc[8 * j + 1] += bfhi(v.x); acc[8 * j + 2] += bflo(v.y); acc[8 * j + 3] += bfhi(v.y);
                acc[8 * j + 4] += bflo(v.z); acc[8 * j + 5] += bfhi(v.z); acc[8 * j + 6] += bflo(v.w); acc[8 * j + 7] += bfhi(v.w);
            }
        }
        float ss = 0.f;
#pragma unroll
        for (int i = 0; i < 16; ++i) ss += acc[i] * acc[i];
        ss = wave_sum(ss);
        const float rs = rsqrtf(ss * (1.0f / 1024.0f) + RMS_EPS);
#pragma unroll
        for (int j = 0; j < 2; ++j)
#pragma unroll
            for (int hf = 0; hf < 2; ++hf) {
                const int col = lane * 8 + 512 * j + 4 * hf;
                const f32x4 g = *(const f32x4*)(p.norm_g + 3072 + col), g2 = *(const f32x4*)(md + 5120 + col);
                f32x4 x1 = *(const f32x4*)(p.out + (size_t)row * DM + col);
#pragma unroll
                for (int i = 0; i < 4; ++i) x1[i] += g2[i] * (acc[8 * j + 4 * hf + i] * rs * g[i]);
                *(f32x4*)(p.out + (size_t)row * DM + col) = x1;
            }
    }
}

static inline size_t al256(size_t v) { return (v + 255) & ~(size_t)255; }

extern "C" void kernel_launch(void* const* d_in, const int* in_sizes, int n_in, void* d_out, int out_size, void* d_ws, size_t ws_size, hipStream_t stream) {
    (void)in_sizes; (void)n_in; (void)out_size;
    Params p{};
    p.x = (const float*)d_in[0]; p.c = (const float*)d_in[1]; p.w_ada = (const float*)d_in[2]; p.b_ada = (const float*)d_in[3];
    p.norm_g = (const float*)d_in[4]; p.w_in = (const float*)d_in[5]; p.w_cmp1 = (const float*)d_in[6]; p.w_cmp2 = (const float*)d_in[7];
    p.pe_cmp = (const float*)d_in[8]; p.diff_lambda = (const float*)d_in[9]; p.diff_subln = (const float*)d_in[10]; p.w_out = (const float*)d_in[11];
    p.w_router = (const float*)d_in[12]; p.router_bias = (const float*)d_in[13]; p.w_gate_up = (const float*)d_in[14]; p.w_down = (const float*)d_in[15];
    p.ws_gate_up = (const float*)d_in[16]; p.ws_down = (const float*)d_in[17];
    p.out = (float*)d_out;
    char* ws = (char*)d_ws; size_t off = 0;
    auto take = [&](size_t bytes) { char* r = ws + off; off = al256(off + bytes); return r; };
    p.ctrl = (unsigned*)take((size_t)CT_WORDS * 4);
    p.mod = (float*)take(2 * 6144 * 4);
    p.misc = (float*)take(1024 * 4);
    p.hmix = (bf16_t*)take((size_t)T_TOK * DM * 2);
    p.proj = (bf16_t*)take((size_t)T_TOK * LD * 2);
    p.vselT = (bf16_t*)take((size_t)256 * SEQ * 2);
    p.vwinT = (bf16_t*)take((size_t)256 * SEQ * 2);
    p.dvT = (bf16_t*)take((size_t)1024 * SEQ * 2);
    p.kc = (bf16_t*)take((size_t)4 * 512 * 64 * 2);
    p.vcT = (bf16_t*)take((size_t)4 * 64 * 512 * 2);
    p.ocat = (bf16_t*)take((size_t)T_TOK * DM * 2);
    p.y = (float*)take((size_t)T_TOK * DM * 4);
    p.hhi = (bf16_t*)take((size_t)T_TOK * DM * 2);
    p.hlo = (bf16_t*)take((size_t)T_TOK * DM * 2);
    p.logits = (float*)take((size_t)T_TOK * 256 * 4);
    p.bucket = (uint2*)take((size_t)NEXP * CAP * 8);
    p.H = (bf16_t*)take((size_t)T_TOK * 9 * 256 * 2);
    p.yslot = (bf16_t*)take((size_t)T_TOK * 9 * 1024 * 2);

    if (ws_size < off) { fprintf(stderr, "workspace too small: %zu < %zu\n", ws_size, off); return; }
    static int grid = 0;
    if (!grid) {
        int dev = 0, cus = 0, per_cu = 0;
        hipGetDevice(&dev);
        hipDeviceGetAttribute(&cus, hipDeviceAttributeMultiprocessorCount, dev);
        hipFuncSetAttribute((const void*)fwd_kernel, hipFuncAttributeMaxDynamicSharedMemorySize, LDS_BYTES);
        hipOccupancyMaxActiveBlocksPerMultiprocessor(&per_cu, fwd_kernel, 512, LDS_BYTES);
        if (per_cu < 1) fprintf(stderr, "occupancy query says the kernel does not fit\n");
        grid = cus > 0 ? cus : 256;
    }
    hipMemsetAsync(p.ctrl, 0, (size_t)CT_WORDS * 4, stream);
    hipLaunchKernelGGL(fwd_kernel, dim3(grid), dim3(512), LDS_BYTES, stream, p);
}
```

```cpp
#include <hip/hip_runtime.h>
#include <stdint.h>
#include <stdio.h>
#ifndef PROBE_PH
#define PROBE_PH -1
#endif
#define REPS(k) ((PROBE_PH == (k)) ? 2 : 1)

typedef unsigned short bf16_t;
typedef short bf16x8 __attribute__((ext_vector_type(8)));
typedef short bf16x4 __attribute__((ext_vector_type(4)));
typedef float f32x4 __attribute__((ext_vector_type(4)));
typedef float f32x16 __attribute__((ext_vector_type(16)));
typedef unsigned u32x4 __attribute__((ext_vector_type(4)));
typedef unsigned u32x2 __attribute__((ext_vector_type(2)));

#define DEV __device__ __forceinline__

constexpr int T_TOK = 16384, SEQ = 8192, DM = 1024;
constexpr int LD = 2944;
constexpr int QOFF = 0, KCOFF = 512, VCOFF = 640, KSOFF = 768, VSOFF = 896, KWOFF = 1024, VWOFF = 1152,
              DQOFF = 1280, DKOFF = 1792, DVOFF = 2304, GTOFF = 2816;
constexpr int NEXP = 256, CAP = 16384;
constexpr float LOG2E = 1.4426950408889634f;
constexpr float RMS_EPS = 1e-6f;
DEV int swz(int row, int chunk) { return row * 128 + ((chunk ^ ((row >> 1) & 7)) << 4); }

typedef __bf16 bf16v2_t __attribute__((ext_vector_type(2)));
DEV unsigned cvt_pk_bf16(float lo, float hi) { bf16v2_t v; v[0] = (__bf16)lo; v[1] = (__bf16)hi; return __builtin_bit_cast(unsigned, v); }
DEV bf16_t f2bf(float f) { unsigned u = __float_as_uint(f); u += 0x7FFFu + ((u >> 16) & 1u); return (bf16_t)(u >> 16); }
DEV float bf2f(bf16_t b) { return __uint_as_float(((unsigned)b) << 16); }
DEV float bflo(unsigned w) { return __uint_as_float(w << 16); }
DEV float bfhi(unsigned w) { return __uint_as_float(w & 0xffff0000u); }
DEV float fexp2(float x) { return __builtin_amdgcn_exp2f(x); }
DEV float sigmoidf_(float x) { return 1.0f / (1.0f + __expf(-x)); }
DEV int ltid() { int t = threadIdx.x; asm volatile("" : "+v"(t)); return t; }
DEV int crow(int r, int hi) { return (r & 3) + 8 * (r >> 2) + 4 * hi; }
DEV float wave_sum(float v) {
#pragma unroll
    for (int o = 32; o >= 1; o >>= 1) v += __shfl_xor(v, o);
    return v;
}

#define XB_TMO      128
#define XB_XCNT(j)  (256  + 64 * (j))
#define XB_XSUB(j)  (1280 + 64 * (j))
#define XB_XGEN(j)  (2304 + 64 * (j))
#define XB_TOP      3328
#define XB_TOPGEN   3392
#define XCD_BAR_WORDS 3456
#define XB_SPIN_CAP (1u << 20)
#define LAS __attribute__((address_space(3)))

__device__ __forceinline__ unsigned xb_ld(unsigned* p)              { return __hip_atomic_load(p, __ATOMIC_RELAXED, __HIP_MEMORY_SCOPE_AGENT); }
__device__ __forceinline__ unsigned xb_add(unsigned* p, unsigned v) { return __hip_atomic_fetch_add(p, v, __ATOMIC_RELAXED, __HIP_MEMORY_SCOPE_AGENT); }
__device__ __forceinline__ unsigned xb_xcc_id() { return (unsigned)__builtin_amdgcn_s_getreg((3 << 11) | 20) & 0xFu; }
#define XB_SPIN(cond, bar) do { unsigned _sp = 0; while (cond) { __builtin_amdgcn_s_sleep(1); \
    if ((++_sp & 255u) == 0u) { if (xb_ld(&(bar)[XB_TMO])) break; if (_sp > XB_SPIN_CAP) { atomicAdd(&(bar)[XB_TMO], 1u); break; } } } } while (0)

struct XcdBarrier {
    unsigned* bar; unsigned x;
    volatile LAS unsigned* st;
};
__device__ __forceinline__ XcdBarrier xcd_barrier_post(unsigned* bar, volatile LAS unsigned* st) {
    XcdBarrier b; b.bar = bar; b.x = xb_xcc_id(); b.st = st;
    if (threadIdx.x == 0) (void)xb_add(&bar[XB_XCNT(b.x)], 1u);
    return b;
}
__device__ __forceinline__ void xcd_barrier_complete(unsigned* bar, unsigned x, unsigned& nloc, unsigned& nx) {
    const unsigned G = gridDim.x * gridDim.y * gridDim.z;
    unsigned sum, cnt, mine, sp = 0u;
    for (;;) {
        sum = 0u; cnt = 0u; mine = 0u;
#pragma unroll
        for (unsigned j = 0; j < 16; ++j) { const unsigned c = xb_ld(&bar[XB_XCNT(j)]); sum += c; cnt += (c > 0u) ? 1u : 0u; mine = (j == x) ? c : mine; }
        if (sum == G) break;
        __builtin_amdgcn_s_sleep(1);
        if ((++sp & 255u) == 0u) { if (xb_ld(&bar[XB_TMO])) break; if (sp > XB_SPIN_CAP) { atomicAdd(&bar[XB_TMO], 1u); break; } }
    }
    nloc = mine > 0u ? mine : 1u; nx = cnt > 0u ? cnt : 1u;
}
__device__ __forceinline__ void xcd_barrier(const XcdBarrier& b) {
    asm volatile("s_waitcnt vmcnt(0)" ::: "memory");
    __syncthreads();
    if (threadIdx.x == 0) {
        unsigned* bar = b.bar;
        __builtin_amdgcn_s_waitcnt(0);
        unsigned nloc = b.st[0], nx = b.st[1];
        if (nloc == 0u) { xcd_barrier_complete(bar, b.x, nloc, nx); b.st[0] = nloc; b.st[1] = nx; }
        const unsigned old = xb_add(&bar[XB_XSUB(b.x)], 1u);
        const unsigned gen = old / nloc;
        if (old + 1u == (gen + 1u) * nloc) {
            __builtin_amdgcn_fence(__ATOMIC_RELEASE, "agent");
            asm volatile("s_waitcnt vmcnt(0)" ::: "memory");
            const unsigned og = xb_add(&bar[XB_TOP], 1u);
            const unsigned tg = og / nx;
            if (og + 1u == (tg + 1u) * nx) xb_add(&bar[XB_TOPGEN], 1u);
            else XB_SPIN(xb_ld(&bar[XB_TOPGEN]) == tg, bar);
            __builtin_amdgcn_fence(__ATOMIC_ACQUIRE, "agent");
            xb_add(&bar[XB_XGEN(b.x)], 1u);
            asm volatile("s_waitcnt vmcnt(0)" ::: "memory");
        } else {
            XB_SPIN(xb_ld(&bar[XB_XGEN(b.x)]) == gen, bar);
            __builtin_amdgcn_fence(__ATOMIC_ACQUIRE, "agent");
            asm volatile("s_waitcnt vmcnt(0)" ::: "memory");
        }
    }
    __syncthreads();
}

struct Params {
    const float *x, *c, *w_ada, *b_ada, *norm_g, *w_in, *w_cmp1, *w_cmp2, *pe_cmp, *diff_lambda, *diff_subln,
                *w_out, *w_router, *router_bias, *w_gate_up, *w_down, *ws_gate_up, *ws_down;
    float* out;
    unsigned* ctrl;
    float* mod;
    float* misc;
    bf16_t* hmix;
    bf16_t* proj;
    bf16_t* vselT;
    bf16_t* vwinT;
    bf16_t* dvT;
    bf16_t* kc;
    bf16_t* vcT;
    bf16_t* ocat;
    float* y;
    bf16_t* hhi;
    bf16_t* hlo;
    float* logits;
    uint2* bucket;
    bf16_t* H;
    bf16_t* yslot;
};
constexpr int CT_Q = 4096;
constexpr int CT_CNT = 8192;
constexpr int CT_WORDS = 16384;

constexpr int L_CTRL = 0;
constexpr int L_MAIN = 64;
constexpr int LDS_BYTES = 64 + 131072 + 18432 + 4096;

constexpr int G_AS = 0, G_ASZ = 49152, G_BS = 98304, G_BSZ = 16384, G_ROWOFF = 131072, G_RSLOT = 133120, G_RWT = 135168, G_PRE = 137216;
#ifndef PROBE_VAR
#define PROBE_VAR 0
#endif
template <int MS, bool TRANS, int PD, class AS, class BL, class EP>
DEV void gemm_big(char* lm, int nk, int nsub, const AS& as, const BL& bl, const EP& ep, int pvar = 0) {
    const int tid = ltid(), lane = tid & 63, w = tid >> 6, wm = w >> 1, wn = w & 1, c = lane & 15, q = lane >> 4;
    const int* rowoff = (const int*)(lm + G_ROWOFF);
    const int ar0 = tid >> 3, akc = tid & 7;
    const int bn4 = 8 * (w & 3) + (lane & 7), bkq = 8 * (w >> 2) + (lane >> 3);
    const int rowlim = 128 * nsub;
    u32x4 ra[PD][2 * MS]; f32x4 rb[PD][4];
    f32x4 acc[2 * MS][4];
#pragma unroll
    for (int mi = 0; mi < 2 * MS; ++mi)
#pragma unroll
        for (int ni = 0; ni < 4; ++ni) acc[mi][ni] = (f32x4){0.f, 0.f, 0.f, 0.f};
#define GB_LOAD(s_, ks_) do { \
        _Pragma("unroll") for (int i = 0; i < 2 * MS; ++i) if ((i >> 1) < nsub) ra[s_][i] = as.ld(rowoff[ar0 + 64 * i] + akc * 8, (ks_)); \
        _Pragma("unroll") for (int i = 0; i < 4; ++i) rb[s_][i] = bl.ld((ks_) * 64 + 4 * bkq + i, 4 * bn4); } while (0)
#define GB_STORE(s_, buf_) do { char* As_ = lm + G_AS + (buf_) * G_ASZ; char* Bs_ = lm + G_BS + (buf_) * G_BSZ; \
        _Pragma("unroll") for (int i = 0; i < 2 * MS; ++i) if ((i >> 1) < nsub) *(u32x4*)(As_ + swz(ar0 + 64 * i, akc)) = ra[s_][i]; \
        _Pragma("unroll") for (int cc = 0; cc < 4; ++cc) { u32x2 v; v.x = cvt_pk_bf16(rb[s_][0][cc], rb[s_][1][cc]); v.y = cvt_pk_bf16(rb[s_][2][cc], rb[s_][3][cc]); \
            *(u32x2*)(Bs_ + swz(4 * bn4 + cc, bkq >> 1) + (bkq & 1) * 8) = v; } } while (0)
#pragma unroll
    for (int s = 0; s < PD; ++s) {
#pragma unroll
        for (int i = 0; i < 2 * MS; ++i) ra[s][i] = (u32x4){0u, 0u, 0u, 0u};
#pragma unroll
        for (int i = 0; i < 4; ++i) rb[s][i] = (f32x4){0.f, 0.f, 0.f, 0.f};
        if (s < nk) GB_LOAD(s, s);
    }
    __syncthreads();
    GB_STORE(0, 0);
    if (PD < nk) GB_LOAD(0, PD);
    __syncthreads();
    for (int ks0 = 0; ks0 < nk; ks0 += PD) {
#pragma unroll
        for (int s = 0; s < PD; ++s) {
            const int ks = ks0 + s;
            if (ks < nk) {
                constexpr int dummy_ = 0; (void)dummy_;
                const int sn = (s + 1) % PD;
                if (ks + 1 < nk && pvar != 3) {
                    GB_STORE(sn, (ks + 1) & 1);
                    if (ks + 1 + PD < nk && pvar != 2) GB_LOAD(sn, ks + 1 + PD);
                }
                const char* As = lm + G_AS + (ks & 1) * G_ASZ; const char* Bs = lm + G_BS + (ks & 1) * G_BSZ;
                if (pvar != 1 && pvar != 3)
#pragma unroll
                for (int kk = 0; kk < 2; ++kk) {
                    bf16x8 bfr[4];
#pragma unroll
                    for (int ni = 0; ni < 4; ++ni) bfr[ni] = *(const bf16x8*)(Bs + swz(64 * wn + 16 * ni + c, 4 * kk + q));
#pragma unroll
                    for (int mi = 0; mi < 2 * MS; ++mi) {
                        if (32 * MS * wm + 16 * mi < rowlim) {
                            const bf16x8 af = *(const bf16x8*)(As + swz(32 * MS * wm + 16 * mi + c, 4 * kk + q));
#pragma unroll
                            for (int ni = 0; ni < 4; ++ni)
                                acc[mi][ni] = TRANS ? __builtin_amdgcn_mfma_f32_16x16x32_bf16(bfr[ni], af, acc[mi][ni], 0, 0, 0)
                                                    : __builtin_amdgcn_mfma_f32_16x16x32_bf16(af, bfr[ni], acc[mi][ni], 0, 0, 0);
                        }
                    }
                }
                __syncthreads();
            }
        }
    }
#undef GB_LOAD
#undef GB_STORE
    ep(acc, 32 * MS * wm, 64 * wn, rowlim, c, q);
}

struct ASrcPlain { const bf16_t* base; DEV u32x4 ld(int off, int ks) const { return *(const u32x4*)(base + off + ks * 64); } };
struct ASrcRouter {
    const bf16_t *hi, *lo;
    DEV u32x4 ld(int off, int ks) const { const int seg = ks >> 4, kk = ks & 15; return *(const u32x4*)(((seg == 1) ? lo : hi) + off + kk * 64); }
};

DEV f32x16 qk32(const char* Ks, int kt, const bf16x8 (&qf)[4], int r, int hi) {
    f32x16 a;
#pragma unroll
    for (int i = 0; i < 16; ++i) a[i] = 0.f;
#pragma unroll
    for (int s = 0; s < 4; ++s) {
        const bf16x8 kf = *(const bf16x8*)(Ks + swz(32 * kt + r, 2 * s + hi));
        a = __builtin_amdgcn_mfma_f32_32x32x16_bf16(kf, qf[s], a, 0, 0, 0);
    }
    return a;
}
template <int NDT>
DEV void pv32(const char* Vs, int kt, const bf16x8 (&pf)[2], f32x16 (&O)[NDT], int r, int hi) {
#pragma unroll
    for (int s2 = 0; s2 < 2; ++s2)
#pragma unroll
        for (int dt = 0; dt < NDT; ++dt) {
            const bf16x4 lo = *(const bf16x4*)(Vs + swz(32 * dt + r, 4 * kt + 2 * s2) + 8 * hi), hi4 = *(const bf16x4*)(Vs + swz(32 * dt + r, 4 * kt + 2 * s2 + 1) + 8 * hi);
            bf16x8 vf; vf[0] = lo[0]; vf[1] = lo[1]; vf[2] = lo[2]; vf[3] = lo[3]; vf[4] = hi4[0]; vf[5] = hi4[1]; vf[6] = hi4[2]; vf[7] = hi4[3];
            O[dt] = __builtin_amdgcn_mfma_f32_32x32x16_bf16(vf, pf[s2], O[dt], 0, 0, 0);
        }
}
DEV void pack_p(const float (&pv)[16], bf16x8 (&pf)[2]) {
#pragma unroll
    for (int s2 = 0; s2 < 2; ++s2) {
        u32x4 u;
        u.x = cvt_pk_bf16(pv[8 * s2 + 0], pv[8 * s2 + 1]); u.y = cvt_pk_bf16(pv[8 * s2 + 2], pv[8 * s2 + 3]);
        u.z = cvt_pk_bf16(pv[8 * s2 + 4], pv[8 * s2 + 5]); u.w = cvt_pk_bf16(pv[8 * s2 + 6], pv[8 * s2 + 7]);
        pf[s2] = __builtin_bit_cast(bf16x8, u);
    }
}
DEV float xhalf_max(float v) {
    auto rr = __builtin_amdgcn_permlane32_swap(__float_as_uint(v), __float_as_uint(v), false, false);
    return fmaxf(__uint_as_float(rr[0]), __uint_as_float(rr[1]));
}
DEV float rowmax16(const float (&s)[16]) {
    float a = fmaxf(fmaxf(s[0], s[1]), s[2]), b = fmaxf(fmaxf(s[3], s[4]), s[5]);
    a = fmaxf(fmaxf(a, s[6]), s[7]); b = fmaxf(fmaxf(b, s[8]), s[9]);
    a = fmaxf(fmaxf(a, s[10]), s[11]); b = fmaxf(fmaxf(b, s[12]), s[13]);
    a = fmaxf(fmaxf(a, s[14]), s[15]);
    return xhalf_max(fmaxf(a, b));
}
constexpr float OSM_THR = 8.0f;
template <int NDT>
DEV void osm_update(float (&s)[16], float& m, float& l, f32x16 (&O)[NDT]) {
    const float mx = rowmax16(s);
    if (__any(mx > m + OSM_THR)) {
        const float mn = fmaxf(m, mx);
        const float alpha = fexp2(m - mn);
        l *= alpha; m = mn;
#pragma unroll
        for (int dt = 0; dt < NDT; ++dt)
#pragma unroll
            for (int i = 0; i < 16; ++i) O[dt][i] *= alpha;
    }
    float sum = 0.f;
#pragma unroll
    for (int i = 0; i < 16; ++i) { s[i] = fexp2(s[i] - m); sum += s[i]; }
    l += sum;
}
template <int KS, bool WIN>
DEV void make_scores(const f32x16& a, float (&s)[16], int D0, float slope2, bool selb) {
    const float sc2 = 0.125f * LOG2E;
    const float nb0 = -slope2 * (float)D0, sk = slope2 * (float)KS;
#pragma unroll
    for (int i = 0; i < 16; ++i) s[i] = fmaf(sk, (float)((i & 3) + 8 * (i >> 2)), fmaf(a[i], sc2, nb0));
    if (__any(!selb || D0 < 27 * KS || (WIN && D0 >= 512))) {
#pragma unroll
        for (int i = 0; i < 16; ++i) {
            const int dist = D0 - KS * ((i & 3) + 8 * (i >> 2));
            const bool valid = selb && dist >= 0 && (!WIN || dist < 512);
            s[i] = valid ? s[i] : -INFINITY;
        }
    }
}
DEV int first_bit4(unsigned a, unsigned b, unsigned c, unsigned d, int from) {
    if (from < 32)  { const unsigned v = a & (0xffffffffu << from); if (v) return __builtin_ctz(v); from = 32; }
    if (from < 64)  { const unsigned v = b & (0xffffffffu << (from - 32)); if (v) return 32 + __builtin_ctz(v); from = 64; }
    if (from < 96)  { const unsigned v = c & (0xffffffffu << (from - 64)); if (v) return 64 + __builtin_ctz(v); from = 96; }
    if (from < 128) { const unsigned v = d & (0xffffffffu << (from - 96)); if (v) return 96 + __builtin_ctz(v); }
    return -1;
}
DEV unsigned range_mask32(int lo, int hi, int base) {
    int a = lo - base, b = hi - base; if (a < 0) a = 0; if (b > 31) b = 31; if (a > b) return 0u;
    const unsigned up = (b == 31) ? 0xffffffffu : ((1u << (b + 1)) - 1u);
    return up & (0xffffffffu << a);
}

template <int MODE>
DEV void nsa_tile(const char* Ks, const char* Vs, float* imp, int j, unsigned mk0, unsigned mk1, unsigned mk2, unsigned mk3,
                  const bf16x8 (&qf)[4], int t, int tl, float slope2, float& m, float& l, float inv, f32x16 (&O)[2], int r, int hi) {
    bool selb = true;
    if (MODE == 2) { const unsigned wsel = (j < 32) ? mk0 : (j < 64) ? mk1 : (j < 96) ? mk2 : mk3; selb = (wsel >> (j & 31)) & 1u; }
#pragma unroll 1
    for (int kt = 0; kt < 2; ++kt) {
        const f32x16 a = qk32(Ks, kt, qf, r, hi);
        float s[16];
        if (MODE <= 1) make_scores<16, false>(a, s, t - 31 - 16 * (64 * j + 32 * kt + 4 * hi), slope2, true);
        else if (MODE == 2) make_scores<1, false>(a, s, t - (64 * j + 32 * kt + 4 * hi), slope2, selb);
        else make_scores<1, true>(a, s, t - (64 * j + 32 * kt + 4 * hi), slope2, true);
        if (MODE == 0) {
            const float mx = rowmax16(s);
            if (__any(mx > m + OSM_THR)) { const float mn = fmaxf(m, mx); l *= fexp2(m - mn); m = mn; }
            float sum = 0.f;
#pragma unroll
            for (int i = 0; i < 16; ++i) sum += fexp2(s[i] - m);
            l += sum;
        } else if (MODE == 1) {
#pragma unroll
            for (int i = 0; i < 16; ++i) s[i] = fexp2(s[i] - m) * inv;
#pragma unroll
            for (int gi = 0; gi < 4; ++gi) {
                const int jb = 16 * j + 8 * kt + 2 * gi + hi;
                const float hb = 0.5f * s[4 * gi + 3];
                const float av = s[4 * gi] + s[4 * gi + 1] + s[4 * gi + 2] + hb;
                if (av != 0.f) atomicAdd(&imp[tl * 129 + jb], av);
                if (hb != 0.f) atomicAdd(&imp[tl * 129 + jb + 1], hb);
            }
            bf16x8 pf[2]; pack_p(s, pf); pv32<2>(Vs, kt, pf, O, r, hi);
        } else {
            osm_update<2>(s, m, l, O);
            bf16x8 pf[2]; pack_p(s, pf); pv32<2>(Vs, kt, pf, O, r, hi);
        }
    }
}

template <int MODE>
DEV void nsa_branch(char* Ks, char* Vs, float* imp, const bf16_t* kbase, int kld, const bf16_t* vbase, int vld,
                    unsigned tm0, unsigned tm1, unsigned tm2, unsigned tm3, unsigned mk0, unsigned mk1, unsigned mk2, unsigned mk3,
                    const bf16x8 (&qf)[4], int t, int tl, float slope2, float& m, float& l, float inv, f32x16 (&O)[2]) {
    const int tid = ltid(), lane = tid & 63, r = lane & 31, hi = lane >> 5, krow = tid >> 3, kch = tid & 7;
    const u32x4 z4 = (u32x4){0u, 0u, 0u, 0u};
    u32x4 rkA = z4, rvA = z4, rkB = z4, rvB = z4, rkC = z4, rvC = z4; int jA, jB, jC;
    int jn = first_bit4(tm0, tm1, tm2, tm3, 0);
#define NSA_LDT(rk, rv, jr) do { jr = jn; if (jn >= 0) { \
        rk = *(const u32x4*)(kbase + (size_t)(64 * jn + krow) * kld + kch * 8); \
        if (MODE != 0) rv = *(const u32x4*)(vbase + (size_t)krow * vld + 64 * jn + kch * 8); \
        jn = first_bit4(tm0, tm1, tm2, tm3, jn + 1); } } while (0)
#define NSA_STEP(rk, rv, jr) do { const int j = jr; \
        __syncthreads(); \
        *(u32x4*)(Ks + swz(krow, kch)) = rk; \
        if (MODE != 0) *(u32x4*)(Vs + swz(krow, kch)) = rv; \
        __syncthreads(); \
        NSA_LDT(rk, rv, jr); \
        nsa_tile<MODE>(Ks, Vs, imp, j, mk0, mk1, mk2, mk3, qf, t, tl, slope2, m, l, inv, O, r, hi); } while (0)
    NSA_LDT(rkA, rvA, jA); NSA_LDT(rkB, rvB, jB); NSA_LDT(rkC, rvC, jC);
    for (;;) {
        if (jA < 0) break; NSA_STEP(rkA, rvA, jA);
        if (jB < 0) break; NSA_STEP(rkB, rvB, jB);
        if (jC < 0) break; NSA_STEP(rkC, rvC, jC);
    }
#undef NSA_LDT
#undef NSA_STEP
}

constexpr int N_KS = 0, N_VS = 9216, N_IMP = 18432, N_SEL = N_IMP + 64 * 129 * 4  , N_UNI = N_SEL + 1024, N_OUT = 52736;

DEV void nsa_unit(const Params& p, char* lm, int b, int g, int qb) {
    const int tid = ltid(), lane = tid & 63, w = tid >> 6, r = lane & 31, hi = lane >> 5, hh = w >> 1, th = w & 1;
    const int head = g * 4 + hh, tl = 32 * th + r, t = 64 * qb + tl;
    const size_t row = (size_t)b * SEQ + t;
    const float slope2 = LOG2E / (float)(2 << head);
    char* Ks = lm + N_KS; char* Vs = lm + N_VS; float* imp = (float*)(lm + N_IMP);
    unsigned* selm = (unsigned*)(lm + N_SEL); unsigned* uni = (unsigned*)(lm + N_UNI);
    __syncthreads();
    for (int i = tid; i < 64 * 129; i += 512) imp[i] = 0.f;
    if (tid < 4) uni[tid] = 0u;
    const bf16_t* prow = p.proj + row * LD;
    bf16x8 qf[4];
#pragma unroll
    for (int s = 0; s < 4; ++s) qf[s] = *(const bf16x8*)(prow + QOFF + head * 64 + 16 * s + 8 * hi);
    float gt[3];
#pragma unroll
    for (int c3 = 0; c3 < 3; ++c3) gt[c3] = sigmoidf_(bf2f(prow[GTOFF + head * 3 + c3]));
    float* outl = (float*)(lm + N_OUT) + tid;
    f32x16 O[2];
#pragma unroll
    for (int dt = 0; dt < 2; ++dt)
#pragma unroll
        for (int i = 0; i < 16; ++i) O[dt][i] = 0.f;

    {
        int ncmp = 4 * qb + 3; if (ncmp > 511) ncmp = 511;
        const int ntc = (ncmp + 63) >> 6;
        const unsigned tm0 = (1u << ntc) - 1u;
        const bf16_t* kb = p.kc + (size_t)((b * 2 + g) * 512) * 64;
        const bf16_t* vb = p.vcT + (size_t)((b * 2 + g) * 64) * 512;
        float m = -1e30f, l = 0.f;
        nsa_branch<0>(Ks, Vs, imp, kb, 64, vb, 512, tm0, 0u, 0u, 0u, 0u, 0u, 0u, 0u, qf, t, tl, slope2, m, l, 0.f, O);
        const float lt = l + __shfl_xor(l, 32);
        const float inv = 1.0f / fmaxf(lt, 1e-30f);
        nsa_branch<1>(Ks, Vs, imp, kb, 64, vb, 512, tm0, 0u, 0u, 0u, 0u, 0u, 0u, 0u, qf, t, tl, slope2, m, l, inv, O);
#pragma unroll
        for (int dt = 0; dt < 2; ++dt)
#pragma unroll
            for (int i = 0; i < 16; ++i) { outl[(16 * dt + i) * 512] = gt[0] * O[dt][i]; O[dt][i] = 0.f; }
    }
    __syncthreads();
    if (qb + 1 <= 16) {
        if (tid < 64) { const unsigned s0 = range_mask32(0, qb, 0); selm[tid * 4 + 0] = s0; selm[tid * 4 + 1] = 0u; selm[tid * 4 + 2] = 0u; selm[tid * 4 + 3] = 0u; }
        if (tid == 0) uni[0] = range_mask32(0, qb, 0);
    } else {
        if (tid < 64) { imp[tid * 129] += 1e4f; imp[tid * 129 + qb] += 1e4f; imp[tid * 129 + qb - 1] += 1e4f; }
        if (tid < 256) selm[tid] = 0u;
        __syncthreads();
        const int tok = tid >> 3, j0 = tid & 7;
        float vj[16]; int rk[16];
#pragma unroll
        for (int jj = 0; jj < 16; ++jj) { const int j = j0 + 8 * jj; vj[jj] = (j <= qb) ? imp[tok * 129 + j] : -INFINITY; rk[jj] = 0; }
        for (int k = 0; k <= qb; ++k) {
            const float vk = imp[tok * 129 + k];
#pragma unroll
            for (int jj = 0; jj < 16; ++jj) { const int j = j0 + 8 * jj; rk[jj] += ((vk > vj[jj]) || (vk == vj[jj] && k < j)) ? 1 : 0; }
        }
        unsigned s0 = 0u, s1 = 0u, s2 = 0u, s3 = 0u;
#pragma unroll
        for (int jj = 0; jj < 16; ++jj) {
            const int j = j0 + 8 * jj;
            if (j <= qb && rk[jj] < 16) { const unsigned bit = 1u << (j & 31); if (jj < 4) s0 |= bit; else if (jj < 8) s1 |= bit; else if (jj < 12) s2 |= bit; else s3 |= bit; }
        }
        if (s0) { atomicOr(&selm[tok * 4 + 0], s0); atomicOr(&uni[0], s0); }
        if (s1) { atomicOr(&selm[tok * 4 + 1], s1); atomicOr(&uni[1], s1); }
        if (s2) { atomicOr(&selm[tok * 4 + 2], s2); atomicOr(&uni[2], s2); }
        if (s3) { atomicOr(&selm[tok * 4 + 3], s3); atomicOr(&uni[3], s3); }
    }
    __syncthreads();
    {
        const unsigned u0 = uni[0], u1 = uni[1], u2 = uni[2], u3 = uni[3];
        const unsigned mk0 = selm[tl * 4 + 0], mk1 = selm[tl * 4 + 1], mk2 = selm[tl * 4 + 2], mk3 = selm[tl * 4 + 3];
        const bf16_t* kb = p.proj + (size_t)b * SEQ * LD + KSOFF + g * 64;
        const bf16_t* vb = p.vselT + (size_t)(b * 128 + g * 64) * SEQ;
        float m = -1e30f, l = 0.f;
        nsa_branch<2>(Ks, Vs, imp, kb, LD, vb, SEQ, u0, u1, u2, u3, mk0, mk1, mk2, mk3, qf, t, tl, slope2, m, l, 0.f, O);
        const float lt = l + __shfl_xor(l, 32);
        const float sc = gt[1] / fmaxf(lt, 1e-30f);
#pragma unroll
        for (int dt = 0; dt < 2; ++dt)
#pragma unroll
            for (int i = 0; i < 16; ++i) { outl[(16 * dt + i) * 512] += sc * O[dt][i]; O[dt][i] = 0.f; }
    }
    {
        const int jlo = qb - 8 < 0 ? 0 : qb - 8;
        const unsigned w0 = range_mask32(jlo, qb, 0), w1 = range_mask32(jlo, qb, 32), w2 = range_mask32(jlo, qb, 64), w3 = range_mask32(jlo, qb, 96);
        const bf16_t* kb = p.proj + (size_t)b * SEQ * LD + KWOFF + g * 64;
        const bf16_t* vb = p.vwinT + (size_t)(b * 128 + g * 64) * SEQ;
        float m = -1e30f, l = 0.f;
        nsa_branch<3>(Ks, Vs, imp, kb, LD, vb, SEQ, w0, w1, w2, w3, 0u, 0u, 0u, 0u, qf, t, tl, slope2, m, l, 0.f, O);
        const float lt = l + __shfl_xor(l, 32);
        const float sc = gt[2] / fmaxf(lt, 1e-30f);
#pragma unroll
        for (int dt = 0; dt < 2; ++dt)
#pragma unroll
            for (int i = 0; i < 16; ++i) O[dt][i] = outl[(16 * dt + i) * 512] + sc * O[dt][i];
    }
    bf16_t* orow = p.ocat + row * DM + head * 64;
#pragma unroll
    for (int dt = 0; dt < 2; ++dt)
#pragma unroll
        for (int gi = 0; gi < 4; ++gi) {
            u32x2 v; v.x = cvt_pk_bf16(O[dt][4 * gi], O[dt][4 * gi + 1]); v.y = cvt_pk_bf16(O[dt][4 * gi + 2], O[dt][4 * gi + 3]);
            *(u32x2*)(orow + 32 * dt + 8 * gi + 4 * hi) = v;
        }
}

constexpr int D_K1 = 0, D_K2 = 9216, D_VS = 18432, D_XS = 132;
DEV void diff_unit(const Params& p, char* lm, int b, int h, int qblk) {
    const int tid = ltid(), lane = tid & 63, w = tid >> 6, r = lane & 31, hi = lane >> 5, mp = w >> 2, qs = w & 3;
    const int krow = tid >> 3, kch = tid & 7;
    const int ql = 32 * qs + r, t = 128 * qblk + ql;
    const size_t row = (size_t)b * SEQ + t;
    const float slope2 = LOG2E / (float)(1 << (2 * (h + 1)));
    const float sc2 = 0.125f * LOG2E;
    char* K1s = lm + D_K1; char* K2s = lm + D_K2; char* Vs = lm + D_VS;
    const char* myK = mp ? K2s : K1s;
    const bf16_t* prow = p.proj + row * LD;
    bf16x8 qf[4];
#pragma unroll
    for (int s = 0; s < 4; ++s) qf[s] = *(const bf16x8*)(prow + DQOFF + h * 128 + mp * 64 + 16 * s + 8 * hi);
    f32x16 O[4];
#pragma unroll
    for (int dt = 0; dt < 4; ++dt)
#pragma unroll
        for (int i = 0; i < 16; ++i) O[dt][i] = 0.f;
    float m = -1e30f, l = 0.f;
    const bf16_t* kb = p.proj + (size_t)b * SEQ * LD + DKOFF + h * 128;
    const bf16_t* vb = p.dvT + (size_t)(b * 512 + h * 128) * SEQ;
    const int ntl = 2 * qblk + 2;
    const u32x4 z4 = (u32x4){0u, 0u, 0u, 0u};
    u32x4 a1 = z4, a2 = z4, a3 = z4, a4 = z4, b1 = z4, b2 = z4, b3 = z4, b4 = z4, c1 = z4, c2 = z4, c3 = z4, c4 = z4;
#define DIFF_LDT(k1, k2, v0, v1, jj) do { if ((jj) < ntl) { const int k0_ = 64 * (jj); \
        k1 = *(const u32x4*)(kb + (size_t)(k0_ + krow) * LD + kch * 8); k2 = *(const u32x4*)(kb + (size_t)(k0_ + krow) * LD + 64 + kch * 8); \
        v0 = *(const u32x4*)(vb + (size_t)krow * SEQ + k0_ + kch * 8); v1 = *(const u32x4*)(vb + (size_t)(krow + 64) * SEQ + k0_ + kch * 8); } } while (0)
#define DIFF_STEP(k1, k2, v0, v1, jj) do { const int j_ = (jj); \
        __syncthreads(); \
        *(u32x4*)(K1s + swz(krow, kch)) = k1; *(u32x4*)(K2s + swz(krow, kch)) = k2; \
        *(u32x4*)(Vs + swz(krow, kch)) = v0; *(u32x4*)(Vs + swz(krow + 64, kch)) = v1; \
        __syncthreads(); \
        DIFF_LDT(k1, k2, v0, v1, j_ + 3); \
        _Pragma("unroll") for (int kt = 0; kt < 2; ++kt) { \
            const f32x16 a = qk32(myK, kt, qf, r, hi); float s[16]; \
            make_scores<1, false>(a, s, t - (64 * j_ + 32 * kt + 4 * hi), slope2, true); \
            osm_update<4>(s, m, l, O); bf16x8 pf[2]; pack_p(s, pf); pv32<4>(Vs, kt, pf, O, r, hi); } } while (0)
    DIFF_LDT(a1, a2, a3, a4, 0); DIFF_LDT(b1, b2, b3, b4, 1); DIFF_LDT(c1, c2, c3, c4, 2);
    for (int j = 0; j < ntl; j += 3) {
        DIFF_STEP(a1, a2, a3, a4, j);
        if (j + 1 < ntl) DIFF_STEP(b1, b2, b3, b4, j + 1);
        if (j + 2 < ntl) DIFF_STEP(c1, c2, c3, c4, j + 2);
    }
#undef DIFF_LDT
#undef DIFF_STEP
    const float lt = l + __shfl_xor(l, 32);
    const float inv = 1.0f / fmaxf(lt, 1e-30f);
    __syncthreads();
    float* X = (float*)lm;
    if (mp == 1) {
#pragma unroll
        for (int dt = 0; dt < 4; ++dt)
#pragma unroll
            for (int i = 0; i < 16; ++i) X[ql * D_XS + 32 * dt + crow(i, hi)] = O[dt][i] * inv;
    }
    __syncthreads();
    if (mp == 0) {
        const float lam = p.misc[0];
        float ss = 0.f;
#pragma unroll
        for (int dt = 0; dt < 4; ++dt)
#pragma unroll
            for (int i = 0; i < 16; ++i) { const float o = O[dt][i] * inv - lam * X[ql * D_XS + 32 * dt + crow(i, hi)]; O[dt][i] = o; ss += o * o; }
        ss += __shfl_xor(ss, 32);
        const float rs = rsqrtf(ss * (1.0f / 128.0f) + RMS_EPS) * 0.8f;
        bf16_t* orow = p.ocat + row * DM + 512 + h * 128;
#pragma unroll
        for (int dt = 0; dt < 4; ++dt)
#pragma unroll
            for (int gi = 0; gi < 4; ++gi) {
                const int d0 = 32 * dt + 8 * gi + 4 * hi;
                const f32x4 gv = *(const f32x4*)(p.diff_subln + d0);
                u32x2 v; v.x = cvt_pk_bf16(O[dt][4 * gi] * rs * gv[0], O[dt][4 * gi + 1] * rs * gv[1]);
                v.y = cvt_pk_bf16(O[dt][4 * gi + 2] * rs * gv[2], O[dt][4 * gi + 3] * rs * gv[3]);
                *(u32x2*)(orow + d0) = v;
            }
    }
    __syncthreads();
}

struct BLoadIn {
    const float* w; int n0;
    DEV f32x4 ld(int k, int n) const {
        const int cp = n0 + n; int cg;
        if (cp < 1280) cg = cp; else if (cp < 2816) cg = cp + 24; else if (cp < 2840) cg = cp - 2816 + 1280; else return (f32x4){0.f, 0.f, 0.f, 0.f};
        return *(const f32x4*)(w + (size_t)k * 2840 + cg);
    }
};
struct BLoadPlain { const float* w; int ldb; DEV f32x4 ld(int k, int n) const { return *(const f32x4*)(w + (size_t)k * ldb + n); } };
struct BLoadRouter {
    const float* w;
    DEV f32x4 ld(int k, int n) const {
        const int seg = k >> 10, kk = k & 1023;
        f32x4 v = *(const f32x4*)(w + (size_t)kk * 256 + n);
        if (seg == 2) {
#pragma unroll
            for (int i = 0; i < 4; ++i) v[i] = v[i] - bf2f(f2bf(v[i]));
        }
        return v;
    }
};
struct BLoadGU {
    const float* w; int nt;
    DEV f32x4 ld(int k, int n) const {
        const int col = ((n >> 5) & 1) * 256 + 64 * nt + 32 * (n >> 6) + 16 * ((n >> 4) & 1) + (n & 15);
        return *(const f32x4*)(w + (size_t)k * 512 + col);
    }
};

template <int NM> struct EpiProj {
    bf16_t* o; int row0, col0;
    DEV void operator()(const f32x4 (&acc)[NM][4], int r0, int c0, int rowlim, int c, int q) const {
#pragma unroll
        for (int mi = 0; mi < NM; ++mi) {
            if (r0 + 16 * mi < rowlim) {
#pragma unroll
                for (int ni = 0; ni < 4; ++ni) {
                    const f32x4 v = acc[mi][ni]; u32x2 u; u.x = cvt_pk_bf16(v[0], v[1]); u.y = cvt_pk_bf16(v[2], v[3]);
                    *(u32x2*)(o + (size_t)(row0 + r0 + 16 * mi + c) * LD + col0 + c0 + 16 * ni + 4 * q) = u;
                }
            }
        }
    }
};
template <int NM> struct EpiVT {
    bf16_t* vt; int row0, vbase, bstride;
    DEV void operator()(const f32x4 (&acc)[NM][4], int r0, int c0, int rowlim, int c, int q) const {
#pragma unroll
        for (int mi = 0; mi < NM; ++mi) {
            if (r0 + 16 * mi < rowlim) {
                const int rg = row0 + r0 + 16 * mi + 4 * q, bb = rg >> 13, tt = rg & (SEQ - 1);
#pragma unroll
                for (int ni = 0; ni < 4; ++ni) {
                    const f32x4 v = acc[mi][ni]; u32x2 u; u.x = cvt_pk_bf16(v[0], v[1]); u.y = cvt_pk_bf16(v[2], v[3]);
                    *(u32x2*)(vt + (size_t)(vbase + bb * bstride + c0 + 16 * ni + c) * SEQ + tt) = u;
                }
            }
        }
    }
};
template <int NM> struct EpiF32 {
    float* o; int ldo, row0, col0;
    DEV void operator()(const f32x4 (&acc)[NM][4], int r0, int c0, int rowlim, int c, int q) const {
#pragma unroll
        for (int mi = 0; mi < NM; ++mi) {
            if (r0 + 16 * mi < rowlim) {
#pragma unroll
                for (int ni = 0; ni < 4; ++ni)
                    *(f32x4*)(o + (size_t)(row0 + r0 + 16 * mi + c) * ldo + col0 + c0 + 16 * ni + 4 * q) = acc[mi][ni];
            }
        }
    }
};
template <int NM> struct EpiSwiglu {
    bf16_t* H; const int* rslot; const float* rwt; int nt;
    DEV void operator()(const f32x4 (&acc)[NM][4], int r0, int c0, int rowlim, int c, int q) const {
#pragma unroll
        for (int mi = 0; mi < NM; ++mi) {
            if (r0 + 16 * mi < rowlim) {
                const int rr = r0 + 16 * mi + c; const int slot = rslot[rr];
                if (slot >= 0) {
                    const float wt = rwt[rr];
#pragma unroll
                    for (int nh = 0; nh < 2; ++nh) {
                        const f32x4 a = acc[mi][nh], g = acc[mi][nh + 2]; float hv[4];
#pragma unroll
                        for (int i = 0; i < 4; ++i) hv[i] = a[i] / (1.0f + __expf(-a[i])) * g[i] * wt;
                        u32x2 u; u.x = cvt_pk_bf16(hv[0], hv[1]); u.y = cvt_pk_bf16(hv[2], hv[3]);
                        *(u32x2*)(H + (size_t)slot * 256 + 64 * nt + (c0 >> 1) + 16 * nh + 4 * q) = u;
                    }
                }
            }
        }
    }
};

DEV int entry_cnt(const unsigned* cnt, int e) { if (e >= 256) return 2048; const unsigned n = cnt[e]; return n > (unsigned)CAP ? CAP : (int)n; }

template <int STAGE>
DEV void moe_phase(const Params& p, char* lds, unsigned xcc, int rep) {
    char* lm = lds + L_MAIN;
    int* pre = (int*)(lm + G_PRE);
    int* rowoff = (int*)(lm + G_ROWOFF);
    int* rslot = (int*)(lm + G_RSLOT);
    float* rwt = (float*)(lm + G_RWT);
    int* bc = (int*)(lds + L_CTRL + 16);
    const unsigned* cnt = p.ctrl + CT_CNT;
    const int tid = ltid();
    constexpr int NT = (STAGE == 1) ? 4 : 8;
    __syncthreads();
    if (tid < 8) {
        int s = 0;
        for (int k = 0; k < 33; ++k) { pre[tid * 34 + k] = s; const int n = entry_cnt(cnt, tid + 8 * k); s += ((n + 383) / 384) * NT; }
        pre[tid * 34 + 33] = s;
    }
    __syncthreads();
    for (int xo = 0; xo < 8; ++xo) {
        const int x = (int)((xcc + xo) & 7u);
        unsigned* qc = p.ctrl + CT_Q + 64 * ((STAGE == 1 ? 16 : 32) + 8 * rep + x);
        const int total = pre[x * 34 + 33];
        for (;;) {
            __syncthreads();
            if (tid == 0) {
                const int u = (int)atomicAdd(qc, 1u);
                int k = -1;
                if (u < total) { k = 0; while (pre[x * 34 + k + 1] <= u) ++k; }
                bc[0] = u; bc[1] = k;
            }
            __syncthreads();
            const int u = bc[0], k = bc[1];
            if (k < 0) break;
            const int e = x + 8 * k, local = u - pre[x * 34 + k];
            const int n_e = entry_cnt(cnt, e);
            const int ngrp = (n_e + 383) / 384;
            const int nt = local / ngrp, mg = local % ngrp;
            int rows = n_e - mg * 384; if (rows > 384) rows = 384;
            const int nsub = (rows + 127) >> 7;
            {
                const int idx = mg * 384 + tid; int slot = -1; float wt = 0.f;
                if (tid < rows) {
                    if (e < 256) { const uint2 en = p.bucket[(size_t)e * CAP + idx]; slot = (int)en.x; wt = __uint_as_float(en.y); if ((unsigned)slot >= (unsigned)(T_TOK * 9)) slot = -1; }
                    else { slot = ((e - 256) * 2048 + idx) * 9 + 8; wt = 1.0f; }
                }
                rslot[tid] = slot; rwt[tid] = wt;
                rowoff[tid] = slot < 0 ? 0 : (STAGE == 1 ? (slot / 9) * 1024 : slot * 256);
            }
            __syncthreads();
            {
                ASrcPlain as; as.base = p.hhi;
                BLoadGU bl; bl.w = e < 256 ? p.w_gate_up + (size_t)e * 1024 * 512 : p.ws_gate_up; bl.nt = nt;
                EpiSwiglu<6> ep; ep.H = p.H; ep.rslot = rslot; ep.rwt = rwt; ep.nt = nt;
                gemm_big<3, true, 1>(lm, 16, nsub, as, bl, ep, (PROBE_PH == 9 && rep == 0) ? PROBE_VAR : 0);
            }
        }
    }
}

constexpr int DN_BS = 131072, DN_RSLOT = DN_BS + 18432, DN_PRE = DN_RSLOT + 1024;
DEV void moe_down_phase(const Params& p, char* lds, unsigned xcc, int rep) {
    char* lm = lds + L_MAIN;
    char* Bs = lm + DN_BS;
    int* rslot = (int*)(lm + DN_RSLOT);
    int* pre = (int*)(lm + DN_PRE);
    int* bc = (int*)(lds + L_CTRL + 16);
    const unsigned* cnt = p.ctrl + CT_CNT;
    const int tid = ltid(), lane = tid & 63, w = tid >> 6, wm = w >> 2, wn = w & 3, c = lane & 15, q = lane >> 4;
    const int bn4 = 8 * (w & 3) + (lane & 7), bkq = 8 * (w >> 2) + (lane >> 3);
    __syncthreads();
    if (tid < 8) {
        int sacc = 0;
        for (int k = 0; k < 33; ++k) { pre[tid * 34 + k] = sacc; const int n = entry_cnt(cnt, tid + 8 * k); sacc += (n + 255) >> 8; }
        pre[tid * 34 + 33] = sacc;
    }
    __syncthreads();
    for (int xo = 0; xo < 8; ++xo) {
        const int x = (int)((xcc + xo) & 7u);
        unsigned* qc = p.ctrl + CT_Q + 64 * (32 + 8 * rep + x);
        const int total = pre[x * 34 + 33];
        for (;;) {
            __syncthreads();
            if (tid == 0) {
                const int u = (int)atomicAdd(qc, 1u);
                int k = -1;
                if (u < total) { k = 0; while (pre[x * 34 + k + 1] <= u) ++k; }
                bc[0] = u; bc[1] = k;
            }
            __syncthreads();
            const int u = bc[0], k = bc[1];
            if (k < 0) break;
            const int e = x + 8 * k, mg = u - pre[x * 34 + k];
            const int n_e = entry_cnt(cnt, e);
            int rows = n_e - mg * 256; if (rows > 256) rows = 256;
            const int nsub = (rows + 127) >> 7;
            if (tid < 256) {
                const int idx = mg * 256 + tid; int slot = -1;
                if (tid < rows) {
                    if (e < 256) { slot = (int)p.bucket[(size_t)e * CAP + idx].x; if ((unsigned)slot >= (unsigned)(T_TOK * 9)) slot = -1; }
                    else slot = ((e - 256) * 2048 + idx) * 9 + 8;
                }
                rslot[tid] = slot;
            }
            __syncthreads();
#pragma unroll
            for (int hb = 0; hb < 2; ++hb) {
                u32x4 v[8];
#pragma unroll
                for (int i = 0; i < 8; ++i) {
                    const int id = tid + 512 * (8 * hb + i), row = id >> 5, kc = id & 31;
                    const int slot = rslot[row];
                    v[i] = *(const u32x4*)(p.H + (size_t)(slot < 0 ? 0 : slot) * 256 + kc * 8);
                }
#pragma unroll
                for (int i = 0; i < 8; ++i) {
                    const int id = tid + 512 * (8 * hb + i), row = id >> 5, kc = id & 31;
                    const int tile = (row >> 7) * 4 + (kc >> 3), rr = row & 127;
                    *(u32x4*)(lm + tile * 16384 + swz(rr, kc & 7)) = v[i];
                }
            }
            const float* wd = (e < 256 ? p.w_down + (size_t)e * 256 * 1024 : p.ws_down);
            f32x4 rb[2][4];
#pragma unroll
            for (int s2 = 0; s2 < 2; ++s2)
#pragma unroll
                for (int i = 0; i < 4; ++i) rb[s2][i] = *(const f32x4*)(wd + (size_t)(s2 * 64 + 4 * bkq + i) * 1024 + 4 * bn4);
            f32x4 acc[2][4][2];
#pragma unroll 1
            for (int nt = 0; nt < 8; ++nt) {
#pragma unroll
                for (int sb = 0; sb < 2; ++sb)
#pragma unroll
                    for (int mi = 0; mi < 4; ++mi)
#pragma unroll
                        for (int ni = 0; ni < 2; ++ni) acc[sb][mi][ni] = (f32x4){0.f, 0.f, 0.f, 0.f};
#pragma unroll 1
                for (int ksp = 0; ksp < 2; ++ksp) {
#pragma unroll
                    for (int k2 = 0; k2 < 2; ++k2) {
                        const int ks = 2 * ksp + k2;
                        __syncthreads();
#pragma unroll
                        for (int cc = 0; cc < 4; ++cc) {
                            u32x2 v; v.x = cvt_pk_bf16(rb[k2][0][cc], rb[k2][1][cc]); v.y = cvt_pk_bf16(rb[k2][2][cc], rb[k2][3][cc]);
                            *(u32x2*)(Bs + swz(4 * bn4 + cc, bkq >> 1) + (bkq & 1) * 8) = v;
                        }
                        __syncthreads();
                        {
                            const int st2 = nt * 4 + ks + 2;
                            if (st2 < 32) {
                                const int nt2 = st2 >> 2, ks2 = st2 & 3;
#pragma unroll
                                for (int i = 0; i < 4; ++i) rb[k2][i] = *(const f32x4*)(wd + (size_t)(ks2 * 64 + 4 * bkq + i) * 1024 + 128 * nt2 + 4 * bn4);
                            }
                        }
#pragma unroll
                        for (int kk = 0; kk < 2; ++kk) {
                            bf16x8 bfr[2];
#pragma unroll
                            for (int ni = 0; ni < 2; ++ni) bfr[ni] = *(const bf16x8*)(Bs + swz(32 * wn + 16 * ni + c, 4 * kk + q));
#pragma unroll
                            for (int sb = 0; sb < 2; ++sb) {
                                if (sb < nsub) {
                                    bf16x8 af[4];
#pragma unroll
                                    for (int mi = 0; mi < 4; ++mi) {
                                        const int rr = 64 * wm + 16 * mi + c;
                                        af[mi] = *(const bf16x8*)(lm + (sb * 4 + ks) * 16384 + swz(rr, 4 * kk + q));
                                    }
#pragma unroll
                                    for (int mi = 0; mi < 4; ++mi)
#pragma unroll
                                        for (int ni = 0; ni < 2; ++ni)
                                            acc[sb][mi][ni] = __builtin_amdgcn_mfma_f32_16x16x32_bf16(bfr[ni], af[mi], acc[sb][mi][ni], 0, 0, 0);
                                }
                            }
                        }
                    }
                }
#pragma unroll
                for (int sb = 0; sb < 2; ++sb) {
                    if (sb < nsub) {
#pragma unroll
                        for (int mi = 0; mi < 4; ++mi) {
                            const int slot = rslot[128 * sb + 64 * wm + 16 * mi + c];
                            if (slot >= 0) {
#pragma unroll
                                for (int ni = 0; ni < 2; ++ni) {
                                    const f32x4 v = acc[sb][mi][ni]; u32x2 uu; uu.x = cvt_pk_bf16(v[0], v[1]); uu.y = cvt_pk_bf16(v[2], v[3]);
                                    *(u32x2*)(p.yslot + (size_t)slot * 1024 + 128 * nt + 32 * wn + 16 * ni + 4 * q) = uu;
                                }
                            }
                        }
                    }
                }
            }
        }
    }
}

#ifndef STOP_AFTER
#define STOP_AFTER 99
#endif
DEV void dump_out(const Params& p, int k) {
    const size_t n = (size_t)T_TOK * DM;
    for (size_t i = (size_t)blockIdx.x * 512 + threadIdx.x; i < n; i += (size_t)gridDim.x * 512) {
        float v = 0.f;
        if (k == 1) v = bf2f(p.hmix[i]);
        else if (k == 0) v = i < 12288 ? p.mod[i] : i < 12288 + 192 ? p.misc[i - 12288] : 0.f;
        else if (k == 2) v = (i % 2944 < 896 || (i % 2944 >= 1024 && i % 2944 < 1152) || (i % 2944 >= 1280 && i % 2944 < 2304) || i % 2944 >= 2816) ? bf2f(p.proj[i]) : 0.f;
        else if (k == 3) v = i < 131072 ? bf2f(p.kc[i]) : i < 262144 ? bf2f(p.vcT[i - 131072]) : i < 262144 + 12582912 ? bf2f(p.vselT[i - 262144]) : 0.f;
        else if (k == 4) v = bf2f(p.ocat[i]);
        else if (k == 5) v = p.y[i];
        else if (k == 6) v = bf2f(p.hhi[i]) + 64.f * bf2f(p.hlo[i]);
        else if (k == 7) v = i < (size_t)T_TOK * 256 ? p.logits[i] : 0.f;
        else if (k == 8) v = i < 256 ? (float)p.ctrl[CT_CNT + i] : 0.f;
        else if (k == 9) v = bf2f(p.H[i]) + bf2f(p.H[i + n]);
        else if (k == 10) v = bf2f(p.yslot[i]) + bf2f(p.yslot[i + 4 * n]) + bf2f(p.yslot[i + 8 * n]);
        p.out[i] = v;
    }
}
#define STOP_AT(k) do { if (STOP_AFTER == (k)) { dump_out(p, (k)); return; } } while (0)
__global__ void __launch_bounds__(512, 2) fwd_kernel(Params p) {
    extern __shared__ __attribute__((aligned(16))) char lds[];
    const int tid = ltid(), lane = tid & 63, w = tid >> 6;
    const int nb = gridDim.x, bid = blockIdx.x;
    char* lm = lds + L_MAIN;
    if (tid < 16) ((unsigned*)lds)[tid] = 0u;
    __syncthreads();
    XcdBarrier bar = xcd_barrier_post(p.ctrl, (volatile LAS unsigned*)lds);
    const unsigned xcc = bar.x & 7u;
    int* bc = (int*)(lds + L_CTRL + 16);

    {
    const int tid = ltid(), lane = tid & 63, w = tid >> 6; (void)lane; (void)w;
        float* sc = (float*)lm;
        float* red = (float*)(lm + 8192);
        for (int i = tid; i < 2048; i += 512) { const float v = p.c[i]; sc[i] = v / (1.0f + __expf(-v)); }
        __syncthreads();
        for (int cb = bid; cb < 256; cb += nb) {
            if (tid < 480) {
                const int j = tid % 24, ks = tid / 24; const int col = cb * 24 + j;
                float a0 = 0.f, a1 = 0.f;
                for (int k = ks; k < 1024; k += 20) { const float wv = p.w_ada[(size_t)k * 6144 + col]; a0 += sc[k] * wv; a1 += sc[1024 + k] * wv; }
                red[(ks * 24 + j) * 2] = a0; red[(ks * 24 + j) * 2 + 1] = a1;
            }
            __syncthreads();
            if (tid < 48) {
                const int j = tid >> 1, bb = tid & 1; float s = 0.f;
                for (int ks = 0; ks < 20; ++ks) s += red[(ks * 24 + j) * 2 + bb];
                const int col = cb * 24 + j;
                p.mod[bb * 6144 + col] = s + p.b_ada[col];
            }
            __syncthreads();
        }
        for (int cb = bid; cb < 256; cb += nb) {
            if (tid < 64) {
                const int kv = cb >> 7, chunk = cb & 127; float a = 0.f;
#pragma unroll
                for (int kk = 0; kk < 16; ++kk) { const int k = chunk * 16 + kk; a += p.pe_cmp[kv * 2048 + k] * p.w_cmp1[((size_t)kv * 2048 + k) * 64 + tid]; }
                p.misc[1024 + cb * 64 + tid] = a;
            }
        }
        if (bid == (2 % nb) && tid == 0) {
            float s01 = 0.f, s23 = 0.f;
            for (int i = 0; i < 64; ++i) { s01 += p.diff_lambda[i] * p.diff_lambda[64 + i]; s23 += p.diff_lambda[128 + i] * p.diff_lambda[192 + i]; }
            p.misc[0] = __expf(s01) - __expf(s23) + 0.2f;
        }
        if (bid == (3 % nb)) {
            for (int i = tid; i < 4 * 64; i += 512) { const int bg = i >> 6, d = i & 63; p.kc[((size_t)bg * 512 + 511) * 64 + d] = 0; p.vcT[((size_t)bg * 64 + d) * 512 + 511] = 0; }
        }
    }
    xcd_barrier(bar);
    STOP_AT(0);

    for (int rep_ = 0; rep_ < REPS(1); ++rep_) {
    const int tid = ltid(), lane = tid & 63, w = tid >> 6; (void)lane; (void)w;
    for (int row = bid * 8 + w; row < T_TOK; row += nb * 8) {
        const int bb = row >> 13; const float* xr = p.x + (size_t)row * DM;
        f32x4 v[4]; float ss = 0.f;
#pragma unroll
        for (int j = 0; j < 4; ++j) { v[j] = *(const f32x4*)(xr + lane * 4 + 256 * j); ss += v[j][0] * v[j][0] + v[j][1] * v[j][1] + v[j][2] * v[j][2] + v[j][3] * v[j][3]; }
        ss = wave_sum(ss);
        const float rs = rsqrtf(ss * (1.0f / 1024.0f) + RMS_EPS);
#pragma unroll
        for (int j = 0; j < 4; ++j) {
            const int col = lane * 4 + 256 * j;
            const f32x4 g = *(const f32x4*)(p.norm_g + col), s1 = *(const f32x4*)(p.mod + bb * 6144 + 1024 + col), h1 = *(const f32x4*)(p.mod + bb * 6144 + col);
            float o[4];
#pragma unroll
            for (int i = 0; i < 4; ++i) o[i] = v[j][i] * rs * g[i] * (1.0f + s1[i]) + h1[i];
            u32x2 u; u.x = cvt_pk_bf16(o[0], o[1]); u.y = cvt_pk_bf16(o[2], o[3]);
            *(u32x2*)(p.hmix + (size_t)row * DM + col) = u;
        }
    }
    xcd_barrier(bar);
    }
    STOP_AT(1);

    for (int rep_ = 0; rep_ < REPS(2); ++rep_) {
    const int tid = ltid(), lane = tid & 63, w = tid >> 6; (void)lane; (void)w;
    for (int u = bid; u < 43 * 23; u += nb) {
        const int nt = u / 43, mg = u % 43;
        const int nsub = (mg == 42) ? 2 : 3;
        __syncthreads();
        { int r = mg * 384 + tid; if (r > T_TOK - 1) r = T_TOK - 1; ((int*)(lm + G_ROWOFF))[tid] = r * DM; }
        __syncthreads();
        ASrcPlain as; as.base = p.hmix;
        BLoadIn bl; bl.w = p.w_in; bl.n0 = nt * 128;
        const bool vt = (nt == 7) || (nt == 9) || (nt >= 18 && nt <= 21);
        if (!vt) {
            EpiProj<6> ep; ep.o = p.proj; ep.row0 = mg * 384; ep.col0 = nt * 128;
            gemm_big<3, true, 1>(lm, 16, nsub, as, bl, ep);
        } else {
            EpiVT<6> ep; ep.row0 = mg * 384; ep.vt = p.vselT;
            ep.vbase = (nt == 7) ? 0 : (nt == 9) ? 256 : 512 + (nt - 18) * 128; ep.bstride = (nt >= 18) ? 512 : 128;
            gemm_big<3, false, 1>(lm, 16, nsub, as, bl, ep);
        }
    }
    xcd_barrier(bar);
    }
    STOP_AT(2);

    for (int rep_ = 0; rep_ < REPS(3); ++rep_) {
    const int tid = ltid(), lane = tid & 63, w = tid >> 6; (void)lane; (void)w;
    for (int u = bid; u < 256; u += nb) {
        const int kv = u >> 7, bb = (u >> 6) & 1, g = (u >> 5) & 1, ch = u & 31, n0 = ch * 16;
        bf16_t* raw = (bf16_t*)lm;
        float* hid = (float*)(lm + 272 * 128);
        __syncthreads();
        for (int i = tid; i < 272 * 8; i += 512) {
            const int tk = i >> 3, chn = i & 7; const int tok = 16 * n0 + tk;
            u32x4 v = (u32x4){0u, 0u, 0u, 0u};
            if (tok < SEQ) v = *(const u32x4*)(p.proj + ((size_t)bb * SEQ + tok) * LD + (kv ? VCOFF : KCOFF) + g * 64 + chn * 8);
            *(u32x4*)(raw + tk * 64 + chn * 8) = v;
        }
        __syncthreads();
        const int rr = tid >> 5, c2 = tid & 31;
        float* wl = (float*)(lm + 272 * 128 + 4096);
        float a0 = 0.f, a1 = 0.f;
        {
            const int n = tid & 63, part = tid >> 6; float sacc = 0.f;
#pragma unroll
            for (int jq = 0; jq < 16; ++jq) sacc += p.misc[1024 + (kv * 128 + part * 16 + jq) * 64 + n];
            hid[part * 64 + n] = sacc;
            __syncthreads();
#pragma unroll
            for (int pp = 0; pp < 8; ++pp) { a0 += hid[pp * 64 + 2 * c2]; a1 += hid[pp * 64 + 2 * c2 + 1]; }
        }
        const float* w1g = p.w_cmp1 + (size_t)kv * 2048 * 64;
        for (int chk = 0; chk < 8; ++chk) {
            f32x4 wv[8];
#pragma unroll
            for (int j = 0; j < 8; ++j) wv[j] = *(const f32x4*)(w1g + (size_t)chk * 16384 + (size_t)(tid + 512 * j) * 4);
            __syncthreads();
#pragma unroll
            for (int j = 0; j < 8; ++j) *(f32x4*)(wl + (tid + 512 * j) * 4) = wv[j];
            __syncthreads();
            for (int i4 = 0; i4 < 4; ++i4) {
                const bf16_t* rp = raw + (16 * rr + chk * 4 + i4) * 64;
#pragma unroll 2
                for (int d8 = 0; d8 < 8; ++d8) {
                    const u32x4 rv = *(const u32x4*)(rp + d8 * 8);
                    const float av[8] = {bflo(rv.x), bfhi(rv.x), bflo(rv.y), bfhi(rv.y), bflo(rv.z), bfhi(rv.z), bflo(rv.w), bfhi(rv.w)};
#pragma unroll
                    for (int e = 0; e < 8; ++e) { const float2 wv2 = *(const float2*)(wl + (i4 * 64 + d8 * 8 + e) * 64 + 2 * c2); a0 += av[e] * wv2.x; a1 += av[e] * wv2.y; }
                }
            }
        }
        __syncthreads();
        {
            const float k0 = 0.7978845608028654f, k1 = 0.044715f;
            const float t0 = tanhf(k0 * (a0 + k1 * a0 * a0 * a0)), t1 = tanhf(k0 * (a1 + k1 * a1 * a1 * a1));
            hid[rr * 64 + 2 * c2] = 0.5f * a0 * (1.0f + t0); hid[rr * 64 + 2 * c2 + 1] = 0.5f * a1 * (1.0f + t1);
        }
        __syncthreads();
        const float* w2 = p.w_cmp2 + (size_t)kv * 64 * 64 + 2 * c2;
        float o0 = 0.f, o1 = 0.f;
        for (int jx = 0; jx < 64; ++jx) { const float hv = hid[rr * 64 + jx]; const float2 wv = *(const float2*)(w2 + jx * 64); o0 += hv * wv.x; o1 += hv * wv.y; }
        const int n = n0 + rr;
        if (n < 511) {
            if (kv == 0) { *(unsigned*)(p.kc + ((size_t)(bb * 2 + g) * 512 + n) * 64 + 2 * c2) = cvt_pk_bf16(o0, o1); }
            else { p.vcT[((size_t)(bb * 2 + g) * 64 + 2 * c2) * 512 + n] = f2bf(o0); p.vcT[((size_t)(bb * 2 + g) * 64 + 2 * c2 + 1) * 512 + n] = f2bf(o1); }
        }
    }
    xcd_barrier(bar);
    }
    STOP_AT(3);

    for (int rep_ = 0; rep_ < REPS(4); ++rep_) {
    const int tid = ltid(), lane = tid & 63, w = tid >> 6; (void)lane; (void)w;
    {
        int u;
        for (;;) {
            __syncthreads();
            if (tid == 0) bc[0] = (int)atomicAdd(p.ctrl + CT_Q + 64 * rep_, 1u);
            __syncthreads();
            u = bc[0];
            if (u >= 512) break;
            const int qk = 63 - (u >> 3), bh = u & 7;
            diff_unit(p, lm, bh >> 2, bh & 3, qk);
        }
        while (u < 1024) {
            const int v = u - 512; const int qb = 127 - (v >> 2), bg = v & 3;
            nsa_unit(p, lm, bg >> 1, bg & 1, qb);
            __syncthreads();
            if (tid == 0) bc[0] = (int)atomicAdd(p.ctrl + CT_Q + 64 * rep_, 1u);
            __syncthreads();
            u = bc[0];
        }
    }
    xcd_barrier(bar);
    }
    STOP_AT(4);

    for (int rep_ = 0; rep_ < REPS(5); ++rep_) {
    const int tid = ltid(), lane = tid & 63, w = tid >> 6; (void)lane; (void)w;
    for (int u = bid; u < 64 * 8; u += nb) {
        const int nt = u / 64, mg = u % 64;
        __syncthreads();
        if (tid < 256) ((int*)(lm + G_ROWOFF))[tid] = (mg * 256 + tid) * DM;
        __syncthreads();
        ASrcPlain as; as.base = p.ocat;
        BLoadPlain bl; bl.w = p.w_out + nt * 128; bl.ldb = 1024;
        EpiF32<4> ep; ep.o = p.y; ep.ldo = 1024; ep.row0 = mg * 256; ep.col0 = nt * 128;
        gemm_big<2, true, 3>(lm, 16, 2, as, bl, ep);
    }
    xcd_barrier(bar);
    }
    STOP_AT(5);

    for (int rep_ = 0; rep_ < REPS(6); ++rep_) {
    const int tid = ltid(), lane = tid & 63, w = tid >> 6; (void)lane; (void)w;
    for (int row = bid * 8 + w; row < T_TOK; row += nb * 8) {
        const int bb = row >> 13; const float* md = p.mod + bb * 6144;
        f32x4 yv[4], xv[4]; float ss = 0.f;
#pragma unroll
        for (int j = 0; j < 4; ++j) { yv[j] = *(const f32x4*)(p.y + (size_t)row * DM + lane * 4 + 256 * j); ss += yv[j][0] * yv[j][0] + yv[j][1] * yv[j][1] + yv[j][2] * yv[j][2] + yv[j][3] * yv[j][3]; }
        ss = wave_sum(ss);
        const float rs = rsqrtf(ss * (1.0f / 1024.0f) + RMS_EPS);
        float ss2 = 0.f;
#pragma unroll
        for (int j = 0; j < 4; ++j) {
            const int col = lane * 4 + 256 * j;
            const f32x4 xx = *(const f32x4*)(p.x + (size_t)row * DM + col), g = *(const f32x4*)(p.norm_g + 1024 + col), g1 = *(const f32x4*)(md + 2048 + col);
#pragma unroll
            for (int i = 0; i < 4; ++i) { xv[j][i] = xx[i] + g1[i] * (yv[j][i] * rs * g[i]); ss2 += xv[j][i] * xv[j][i]; }
            *(f32x4*)(p.out + (size_t)row * DM + col) = xv[j];
        }
        ss2 = wave_sum(ss2);
        const float rs2 = rsqrtf(ss2 * (1.0f / 1024.0f) + RMS_EPS);
#pragma unroll
        for (int j = 0; j < 4; ++j) {
            const int col = lane * 4 + 256 * j;
            const f32x4 g = *(const f32x4*)(p.norm_g + 2048 + col), s2 = *(const f32x4*)(md + 4096 + col), h2 = *(const f32x4*)(md + 3072 + col);
            float hv[4], lo[4];
#pragma unroll
            for (int i = 0; i < 4; ++i) { hv[i] = xv[j][i] * rs2 * g[i] * (1.0f + s2[i]) + h2[i]; lo[i] = hv[i] - bf2f(f2bf(hv[i])); }
            u32x2 uh, ul; uh.x = cvt_pk_bf16(hv[0], hv[1]); uh.y = cvt_pk_bf16(hv[2], hv[3]); ul.x = cvt_pk_bf16(lo[0], lo[1]); ul.y = cvt_pk_bf16(lo[2], lo[3]);
            *(u32x2*)(p.hhi + (size_t)row * DM + col) = uh; *(u32x2*)(p.hlo + (size_t)row * DM + col) = ul;
        }
    }
    xcd_barrier(bar);
    }
    STOP_AT(6);

    for (int rep_ = 0; rep_ < REPS(7); ++rep_) {
    const int tid = ltid(), lane = tid & 63, w = tid >> 6; (void)lane; (void)w;
    for (int u = bid; u < 256; u += nb) {
        const int nt = u / 128, mt = u % 128;
        __syncthreads();
        if (tid < 128) ((int*)(lm + G_ROWOFF))[tid] = (mt * 128 + tid) * DM;
        __syncthreads();
        ASrcRouter as; as.hi = p.hhi; as.lo = p.hlo;
        BLoadRouter bl; bl.w = p.w_router + nt * 128;
        EpiF32<2> ep; ep.o = p.logits; ep.ldo = 256; ep.row0 = mt * 128; ep.col0 = nt * 128;
        gemm_big<1, true, 4>(lm, 48, 1, as, bl, ep);
    }
    xcd_barrier(bar);
    }
    STOP_AT(7);

    {
    const int tid = ltid(), lane = tid & 63, w = tid >> 6; (void)lane; (void)w;
    for (int tok = bid * 8 + w; tok < T_TOK; tok += nb * 8) {
        const f32x4 lg = *(const f32x4*)(p.logits + (size_t)tok * 256 + lane * 4);
        const f32x4 rb = *(const f32x4*)(p.router_bias + lane * 4);
        float aff[4], ch[4];
#pragma unroll
        for (int i = 0; i < 4; ++i) { aff[i] = 1.0f / (1.0f + __expf(-lg[i])); ch[i] = aff[i] + rb[i]; }
        float m1 = fmaxf(ch[0], ch[1]), m2 = fminf(ch[0], ch[1]);
#pragma unroll
        for (int i = 2; i < 4; ++i) { const float v = ch[i]; if (v > m1) { m2 = m1; m1 = v; } else if (v > m2) m2 = v; }
#pragma unroll
        for (int o = 1; o <= 4; o <<= 1) {
            const float o1 = __shfl_xor(m1, o), o2 = __shfl_xor(m2, o);
            const float n1 = fmaxf(m1, o1), n2 = fmaxf(fminf(m1, o1), fmaxf(m2, o2));
            m1 = n1; m2 = n2;
        }
        const float gs = m1 + m2; const int grp = lane >> 3;
        int rank = 0;
#pragma unroll
        for (int g2 = 0; g2 < 8; ++g2) { const float og = __shfl(gs, g2 * 8); if (og > gs || (og == gs && g2 < grp)) ++rank; }
        const bool gsel = rank < 4;
#pragma unroll
        for (int i = 0; i < 4; ++i) if (!gsel) ch[i] = -INFINITY;
        int myidx = -1; float myaff = 0.f, asum = 0.f;
        for (int it = 0; it < 8; ++it) {
            float bv = ch[0]; int bi = lane * 4;
#pragma unroll
            for (int i = 1; i < 4; ++i) if (ch[i] > bv) { bv = ch[i]; bi = lane * 4 + i; }
#pragma unroll
            for (int o = 32; o >= 1; o >>= 1) {
                const float ov = __shfl_xor(bv, o); const int oi = __shfl_xor(bi, o);
                if (ov > bv || (ov == bv && oi < bi)) { bv = ov; bi = oi; }
            }
            bi = __builtin_amdgcn_readfirstlane(bi);
            float av = 0.f;
            if ((bi >> 2) == lane) {
#pragma unroll
                for (int i = 0; i < 4; ++i) if ((bi & 3) == i) { av = aff[i]; ch[i] = -INFINITY; }
            }
            av = __shfl(av, bi >> 2);
            asum += av;
            if (lane == it) { myidx = bi; myaff = av; }
        }
        if (lane < 8) {
            const float wt = myaff / asum * 2.5f;
            const unsigned pos = atomicAdd(p.ctrl + CT_CNT + myidx, 1u);
            uint2 en; en.x = (unsigned)(tok * 9 + lane); en.y = __float_as_uint(wt);
            if (pos < (unsigned)CAP) p.bucket[(size_t)myidx * CAP + pos] = en;
        }
    }
    }
    xcd_barrier(bar);
    STOP_AT(8);

    for (int rep_ = 0; rep_ < REPS(9); ++rep_) {
    const int tid = ltid(), lane = tid & 63, w = tid >> 6; (void)lane; (void)w;
    moe_phase<1>(p, lds, xcc, rep_);
    xcd_barrier(bar);
    }
    STOP_AT(9);
    for (int rep_ = 0; rep_ < REPS(10); ++rep_) {
    moe_down_phase(p, lds, xcc, rep_);
    xcd_barrier(bar);
    }
    STOP_AT(10);

    {
    const int tid = ltid(), lane = tid & 63, w = tid >> 6; (void)lane; (void)w;
    for (int row = bid * 8 + w; row < T_TOK; row += nb * 8) {
        const int bb = row >> 13; const float* md = p.mod + bb * 6144;
        float acc[16];
#pragma unroll
        for (int i = 0; i < 16; ++i) acc[i] = 0.f;
        const bf16_t* sp = p.yslot + (size_t)row * 9 * 1024;
        for (int k = 0; k < 9; ++k) {
#pragma unroll
            for (int j = 0; j < 2; ++j) {
                const u32x4 v = *(const u32x4*)(sp + (size_t)k * 1024 + lane * 8 + 512 * j);
                acc[8 * j + 0] += bflo(v.x); acc[8 * j + 1] += bfhi(v.x); acc[8 * j + 2] += bflo(v.y); acc[8 * j + 3] += bfhi(v.y);
                acc[8 * j + 4] += bflo(v.z); acc[8 * j + 5] += bfhi(v.z); acc[8 * j + 6] += bflo(v.w); acc[8 * j + 7] += bfhi(v.w);
            }
        }
        float ss = 0.f;
#pragma unroll
        for (int i = 0; i < 16; ++i) ss += acc[i] * acc[i];
        ss = wave_sum(ss);
        const float rs = rsqrtf(ss * (1.0f / 1024.0f) + RMS_EPS);
#pragma unroll
        for (int j = 0; j < 2; ++j)
#pragma unroll
            for (int hf = 0; hf < 2; ++hf) {
                const int col = lane * 8 + 512 * j + 4 * hf;
                const f32x4 g = *(const f32x4*)(p.norm_g + 3072 + col), g2 = *(const f32x4*)(md + 5120 + col);
                f32x4 x1 = *(const f32x4*)(p.out + (size_t)row * DM + col);
#pragma unroll
                for (int i = 0; i < 4; ++i) x1[i] += g2[i] * (acc[8 * j + 4 * hf + i] * rs * g[i]);
                *(f32x4*)(p.out + (size_t)row * DM + col) = x1;
            }
    }
    }
}

static inline size_t al256(size_t v) { return (v + 255) & ~(size_t)255; }

extern "C" void kernel_launch(void* const* d_in, const int* in_sizes, int n_in, void* d_out, int out_size, void* d_ws, size_t ws_size, hipStream_t stream) {
    (void)in_sizes; (void)n_in; (void)out_size;
    Params p{};
    p.x = (const float*)d_in[0]; p.c = (const float*)d_in[1]; p.w_ada = (const float*)d_in[2]; p.b_ada = (const float*)d_in[3];
    p.norm_g = (const float*)d_in[4]; p.w_in = (const float*)d_in[5]; p.w_cmp1 = (const float*)d_in[6]; p.w_cmp2 = (const float*)d_in[7];
    p.pe_cmp = (const float*)d_in[8]; p.diff_lambda = (const float*)d_in[9]; p.diff_subln = (const float*)d_in[10]; p.w_out = (const float*)d_in[11];
    p.w_router = (const float*)d_in[12]; p.router_bias = (const float*)d_in[13]; p.w_gate_up = (const float*)d_in[14]; p.w_down = (const float*)d_in[15];
    p.ws_gate_up = (const float*)d_in[16]; p.ws_down = (const float*)d_in[17];
    p.out = (float*)d_out;
    char* ws = (char*)d_ws; size_t off = 0;
    auto take = [&](size_t bytes) { char* r = ws + off; off = al256(off + bytes); return r; };
    p.ctrl = (unsigned*)take((size_t)CT_WORDS * 4);
    p.mod = (float*)take(2 * 6144 * 4);
    p.misc = (float*)take((1024 + 256 * 64) * 4);
    p.hmix = (bf16_t*)take((size_t)T_TOK * DM * 2);
    p.proj = (bf16_t*)take((size_t)T_TOK * LD * 2);
    p.vselT = (bf16_t*)take((size_t)256 * SEQ * 2);
    p.vwinT = (bf16_t*)take((size_t)256 * SEQ * 2);
    p.dvT = (bf16_t*)take((size_t)1024 * SEQ * 2);
    p.kc = (bf16_t*)take((size_t)4 * 512 * 64 * 2);
    p.vcT = (bf16_t*)take((size_t)4 * 64 * 512 * 2);
    p.ocat = (bf16_t*)take((size_t)T_TOK * DM * 2);
    p.y = (float*)take((size_t)T_TOK * DM * 4);
    p.hhi = (bf16_t*)take((size_t)T_TOK * DM * 2);
    p.hlo = (bf16_t*)take((size_t)T_TOK * DM * 2);
    p.logits = (float*)take((size_t)T_TOK * 256 * 4);
    p.bucket = (uint2*)take((size_t)NEXP * CAP * 8);
    p.H = (bf16_t*)take((size_t)T_TOK * 9 * 256 * 2);
    p.yslot = (bf16_t*)take((size_t)T_TOK * 9 * 1024 * 2);

    if (ws_size < off) { fprintf(stderr, "workspace too small: %zu < %zu\n", ws_size, off); return; }
    static int grid = 0;
    if (!grid) {
        int dev = 0, cus = 0, per_cu = 0;
        hipGetDevice(&dev);
        hipDeviceGetAttribute(&cus, hipDeviceAttributeMultiprocessorCount, dev);
        hipFuncSetAttribute((const void*)fwd_kernel, hipFuncAttributeMaxDynamicSharedMemorySize, LDS_BYTES);
        hipOccupancyMaxActiveBlocksPerMultiprocessor(&per_cu, fwd_kernel, 512, LDS_BYTES);
        if (per_cu < 1) fprintf(stderr, "occupancy query says the kernel does not fit\n");
        grid = cus > 0 ? cus : 256;
    }
    hipMemsetAsync(p.ctrl, 0, (size_t)CT_WORDS * 4, stream);
    hipLaunchKernelGGL(fwd_kernel, dim3(grid), dim3(512), LDS_BYTES, stream, p);
}
```

```cpp
#include <hip/hip_runtime.h>
#include <stdint.h>
#include <stdio.h>
#ifndef PROBE_PH
#define PROBE_PH -1
#endif
#define REPS(k) ((PROBE_PH == (k)) ? 2 : 1)

typedef unsigned short bf16_t;
typedef short bf16x8 __attribute__((ext_vector_type(8)));
typedef short bf16x4 __attribute__((ext_vector_type(4)));
typedef float f32x4 __attribute__((ext_vector_type(4)));
typedef float f32x16 __attribute__((ext_vector_type(16)));
typedef unsigned u32x4 __attribute__((ext_vector_type(4)));
typedef unsigned u32x2 __attribute__((ext_vector_type(2)));

#define DEV __device__ __forceinline__

constexpr int T_TOK = 16384, SEQ = 8192, DM = 1024;
constexpr int LD = 2944;
constexpr int QOFF = 0, KCOFF = 512, VCOFF = 640, KSOFF = 768, VSOFF = 896, KWOFF = 1024, VWOFF = 1152,
              DQOFF = 1280, DKOFF = 1792, DVOFF = 2304, GTOFF = 2816;
constexpr int NEXP = 256, CAP = 16384;
constexpr float LOG2E = 1.4426950408889634f;
constexpr float RMS_EPS = 1e-6f;
DEV int swz(int row, int chunk) { return row * 128 + ((chunk ^ ((row >> 1) & 7)) << 4); }

typedef __bf16 bf16v2_t __attribute__((ext_vector_type(2)));
DEV unsigned cvt_pk_bf16(float lo, float hi) { bf16v2_t v; v[0] = (__bf16)lo; v[1] = (__bf16)hi; return __builtin_bit_cast(unsigned, v); }
DEV bf16_t f2bf(float f) { unsigned u = __float_as_uint(f); u += 0x7FFFu + ((u >> 16) & 1u); return (bf16_t)(u >> 16); }
DEV float bf2f(bf16_t b) { return __uint_as_float(((unsigned)b) << 16); }
DEV float bflo(unsigned w) { return __uint_as_float(w << 16); }
DEV float bfhi(unsigned w) { return __uint_as_float(w & 0xffff0000u); }
DEV float fexp2(float x) { return __builtin_amdgcn_exp2f(x); }
DEV float sigmoidf_(float x) { return 1.0f / (1.0f + __expf(-x)); }
DEV int ltid() { int t = threadIdx.x; asm volatile("" : "+v"(t)); return t; }
DEV int crow(int r, int hi) { return (r & 3) + 8 * (r >> 2) + 4 * hi; }
DEV float wave_sum(float v) {
#pragma unroll
    for (int o = 32; o >= 1; o >>= 1) v += __shfl_xor(v, o);
    return v;
}

#define XB_TMO      128
#define XB_XCNT(j)  (256  + 64 * (j))
#define XB_XSUB(j)  (1280 + 64 * (j))
#define XB_XGEN(j)  (2304 + 64 * (j))
#define XB_TOP      3328
#define XB_TOPGEN   3392
#define XCD_BAR_WORDS 3456
#define XB_SPIN_CAP (1u << 20)
#define LAS __attribute__((address_space(3)))

__device__ __forceinline__ unsigned xb_ld(unsigned* p)              { return __hip_atomic_load(p, __ATOMIC_RELAXED, __HIP_MEMORY_SCOPE_AGENT); }
__device__ __forceinline__ unsigned xb_add(unsigned* p, unsigned v) { return __hip_atomic_fetch_add(p, v, __ATOMIC_RELAXED, __HIP_MEMORY_SCOPE_AGENT); }
__device__ __forceinline__ unsigned xb_xcc_id() { return (unsigned)__builtin_amdgcn_s_getreg((3 << 11) | 20) & 0xFu; }
#define XB_SPIN(cond, bar) do { unsigned _sp = 0; while (cond) { __builtin_amdgcn_s_sleep(1); \
    if ((++_sp & 255u) == 0u) { if (xb_ld(&(bar)[XB_TMO])) break; if (_sp > XB_SPIN_CAP) { atomicAdd(&(bar)[XB_TMO], 1u); break; } } } } while (0)

struct XcdBarrier {
    unsigned* bar; unsigned x;
    volatile LAS unsigned* st;
};
__device__ __forceinline__ XcdBarrier xcd_barrier_post(unsigned* bar, volatile LAS unsigned* st) {
    XcdBarrier b; b.bar = bar; b.x = xb_xcc_id(); b.st = st;
    if (threadIdx.x == 0) (void)xb_add(&bar[XB_XCNT(b.x)], 1u);
    return b;
}
__device__ __forceinline__ void xcd_barrier_complete(unsigned* bar, unsigned x, unsigned& nloc, unsigned& nx) {
    const unsigned G = gridDim.x * gridDim.y * gridDim.z;
    unsigned sum, cnt, mine, sp = 0u;
    for (;;) {
        sum = 0u; cnt = 0u; mine = 0u;
#pragma unroll
        for (unsigned j = 0; j < 16; ++j) { const unsigned c = xb_ld(&bar[XB_XCNT(j)]); sum += c; cnt += (c > 0u) ? 1u : 0u; mine = (j == x) ? c : mine; }
        if (sum == G) break;
        __builtin_amdgcn_s_sleep(1);
        if ((++sp & 255u) == 0u) { if (xb_ld(&bar[XB_TMO])) break; if (sp > XB_SPIN_CAP) { atomicAdd(&bar[XB_TMO], 1u); break; } }
    }
    nloc = mine > 0u ? mine : 1u; nx = cnt > 0u ? cnt : 1u;
}
__device__ __forceinline__ void xcd_barrier(const XcdBarrier& b) {
    asm volatile("s_waitcnt vmcnt(0)" ::: "memory");
    __syncthreads();
    if (threadIdx.x == 0) {
        unsigned* bar = b.bar;
        __builtin_amdgcn_s_waitcnt(0);
        unsigned nloc = b.st[0], nx = b.st[1];
        if (nloc == 0u) { xcd_barrier_complete(bar, b.x, nloc, nx); b.st[0] = nloc; b.st[1] = nx; }
        const unsigned old = xb_add(&bar[XB_XSUB(b.x)], 1u);
        const unsigned gen = old / nloc;
        if (old + 1u == (gen + 1u) * nloc) {
            __builtin_amdgcn_fence(__ATOMIC_RELEASE, "agent");
            asm volatile("s_waitcnt vmcnt(0)" ::: "memory");
            const unsigned og = xb_add(&bar[XB_TOP], 1u);
            const unsigned tg = og / nx;
            if (og + 1u == (tg + 1u) * nx) xb_add(&bar[XB_TOPGEN], 1u);
            else XB_SPIN(xb_ld(&bar[XB_TOPGEN]) == tg, bar);
            __builtin_amdgcn_fence(__ATOMIC_ACQUIRE, "agent");
            xb_add(&bar[XB_XGEN(b.x)], 1u);
            asm volatile("s_waitcnt vmcnt(0)" ::: "memory");
        } else {
            XB_SPIN(xb_ld(&bar[XB_XGEN(b.x)]) == gen, bar);
            __builtin_amdgcn_fence(__ATOMIC_ACQUIRE, "agent");
            asm volatile("s_waitcnt vmcnt(0)" ::: "memory");
        }
    }
    __syncthreads();
}

struct Params {
    const float *x, *c, *w_ada, *b_ada, *norm_g, *w_in, *w_cmp1, *w_cmp2, *pe_cmp, *diff_lambda, *diff_subln,
                *w_out, *w_router, *router_bias, *w_gate_up, *w_down, *ws_gate_up, *ws_down;
    float* out;
    unsigned* ctrl;
    float* mod;
    float* misc;
    bf16_t* wT;
    bf16_t* hmix;
    bf16_t* proj;
    bf16_t* vselT;
    bf16_t* vwinT;
    bf16_t* dvT;
    bf16_t* kc;
    bf16_t* vcT;
    bf16_t* ocat;
    float* y;
    bf16_t* hhi;
    bf16_t* hlo;
    float* logits;
    uint2* bucket;
    bf16_t* H;
    bf16_t* yslot;
};
constexpr int CT_Q = 4096;
constexpr int CT_CNT = 8192;
constexpr int CT_KMAX = 12288;
constexpr int CT_WORDS = 16384;

constexpr int L_CTRL = 0;
constexpr int L_MAIN = 64;
constexpr int LDS_BYTES = 64 + 131072 + 18432 + 4096;

constexpr int G_AS = 0, G_ASZ = 49152, G_BS = 98304, G_BSZ = 16384, G_ROWOFF = 131072, G_RSLOT = 133120, G_RWT = 135168, G_PRE = 137216;
#ifndef PROBE_VAR
#define PROBE_VAR 0
#endif
template <int MS, bool TRANS, int PD, class AS, class BL, class EP, int PDB = PD, bool BF = false>
DEV void gemm_big(char* lm, int nk, int nsub, const AS& as, const BL& bl, const EP& ep, int pvar = 0) {
    static_assert(PDB % PD == 0, "the B ring depth must be a multiple of the A ring depth");
    const int tid = ltid(), lane = tid & 63, w = tid >> 6, wm = w >> 1, wn = w & 1, c = lane & 15, q = lane >> 4;
    const int* rowoff = (const int*)(lm + G_ROWOFF);
    const int ar0 = tid >> 3, akc = tid & 7;
    const int bn4 = 8 * (w & 3) + (lane & 7), bkq = 8 * (w >> 2) + (lane >> 3);
    const int rowlim = 128 * nsub;
    u32x4 ra[PD][2 * MS]; f32x4 rb[BF ? 1 : PDB][4]; u32x4 rq[BF ? PDB : 1][2];
    f32x4 acc[2 * MS][4];
#pragma unroll
    for (int mi = 0; mi < 2 * MS; ++mi)
#pragma unroll
        for (int ni = 0; ni < 4; ++ni) acc[mi][ni] = (f32x4){0.f, 0.f, 0.f, 0.f};
#define GB_LOADA(s_, ks_) do { \
        _Pragma("unroll") for (int i = 0; i < 2 * MS; ++i) if ((i >> 1) < nsub) ra[s_][i] = as.ld(rowoff[ar0 + 64 * i] + akc * 8, (ks_)); } while (0)
#define GB_LOADB(s_, ks_) do { if constexpr (BF) { rq[s_][0] = bl.ldq(ar0, (ks_), akc); rq[s_][1] = bl.ldq(ar0 + 64, (ks_), akc); } else { \
        _Pragma("unroll") for (int i = 0; i < 4; ++i) rb[s_][i] = bl.ld((ks_) * 64 + 4 * bkq + i, 4 * bn4); } } while (0)
#define GB_STORE(sa_, sb_, buf_) do { char* As_ = lm + G_AS + (buf_) * G_ASZ; char* Bs_ = lm + G_BS + (buf_) * G_BSZ; \
        _Pragma("unroll") for (int i = 0; i < 2 * MS; ++i) if ((i >> 1) < nsub) *(u32x4*)(As_ + swz(ar0 + 64 * i, akc)) = ra[sa_][i]; \
        if constexpr (BF) { *(u32x4*)(Bs_ + swz(ar0, akc)) = rq[sb_][0]; *(u32x4*)(Bs_ + swz(ar0 + 64, akc)) = rq[sb_][1]; } else { \
        _Pragma("unroll") for (int cc = 0; cc < 4; ++cc) { u32x2 v; v.x = cvt_pk_bf16(rb[sb_][0][cc], rb[sb_][1][cc]); v.y = cvt_pk_bf16(rb[sb_][2][cc], rb[sb_][3][cc]); \
            *(u32x2*)(Bs_ + swz(4 * bn4 + cc, bkq >> 1) + (bkq & 1) * 8) = v; } } } while (0)
#pragma unroll
    for (int s = 0; s < PD; ++s) {
#pragma unroll
        for (int i = 0; i < 2 * MS; ++i) ra[s][i] = (u32x4){0u, 0u, 0u, 0u};
        if (s < nk) GB_LOADA(s, s);
    }
#pragma unroll
    for (int s = 0; s < PDB; ++s) {
        if constexpr (BF) { rq[s][0] = (u32x4){0u, 0u, 0u, 0u}; rq[s][1] = (u32x4){0u, 0u, 0u, 0u}; }
        else {
#pragma unroll
            for (int i = 0; i < 4; ++i) rb[s][i] = (f32x4){0.f, 0.f, 0.f, 0.f};
        }
        if (s < nk) GB_LOADB(s, s);
    }
    __syncthreads();
    GB_STORE(0, 0, 0);
    if (PD < nk) GB_LOADA(0, PD);
    if (PDB < nk) GB_LOADB(0, PDB);
    __syncthreads();
    for (int ks0 = 0; ks0 < nk; ks0 += PDB) {
#pragma unroll
        for (int s = 0; s < PDB; ++s) {
            const int ks = ks0 + s;
            if (ks < nk) {
                const int sna = (s + 1) % PD, snb = (s + 1) % PDB;
                const char* As = lm + G_AS + (ks & 1) * G_ASZ; const char* Bs = lm + G_BS + (ks & 1) * G_BSZ;
#define GB_STAGE() do { if (ks + 1 < nk && pvar != 3) { GB_STORE(sna, snb, (ks + 1) & 1); \
                    if (pvar != 2) { if (ks + 1 + PD < nk) GB_LOADA(sna, ks + 1 + PD); if (ks + 1 + PDB < nk) GB_LOADB(snb, ks + 1 + PDB); } } } while (0)
#define GB_COMPUTE() do { if (pvar != 1 && pvar != 3) { \
                _Pragma("unroll") for (int kk = 0; kk < 2; ++kk) { \
                    bf16x8 bfr[4]; \
                    _Pragma("unroll") for (int ni = 0; ni < 4; ++ni) bfr[ni] = *(const bf16x8*)(Bs + swz(64 * wn + 16 * ni + c, 4 * kk + q)); \
                    _Pragma("unroll") for (int mi = 0; mi < 2 * MS; ++mi) { \
                        if (32 * MS * wm + 16 * mi < rowlim) { \
                            const bf16x8 af = *(const bf16x8*)(As + swz(32 * MS * wm + 16 * mi + c, 4 * kk + q)); \
                            _Pragma("unroll") for (int ni = 0; ni < 4; ++ni) \
                                acc[mi][ni] = TRANS ? __builtin_amdgcn_mfma_f32_16x16x32_bf16(bfr[ni], af, acc[mi][ni], 0, 0, 0) \
                                                    : __builtin_amdgcn_mfma_f32_16x16x32_bf16(af, bfr[ni], acc[mi][ni], 0, 0, 0); \
                        } } } } } while (0)
                if (w < 4) { GB_STAGE(); GB_COMPUTE(); } else { GB_COMPUTE(); GB_STAGE(); }
#undef GB_STAGE
#undef GB_COMPUTE
                __syncthreads();
            }
        }
    }
#undef GB_LOADA
#undef GB_LOADB
#undef GB_STORE
    ep(acc, 32 * MS * wm, 64 * wn, rowlim, c, q);
}

struct ASrcPlain { const bf16_t* base; DEV u32x4 ld(int off, int ks) const { return *(const u32x4*)(base + off + ks * 64); } };
struct ASrcRouter {
    const bf16_t *hi, *lo;
    DEV u32x4 ld(int off, int ks) const { const int seg = ks >> 4, kk = ks & 15; return *(const u32x4*)(((seg == 1) ? lo : hi) + off + kk * 64); }
};

DEV void store_vt_chunk(char* Vs, int row, int ch, const u32x4& v) {
    const int g2 = ch & ~1, e8 = (ch & 1) * 8;
    u32x2 lo; lo.x = v.x; lo.y = v.y; u32x2 hi; hi.x = v.z; hi.y = v.w;
    *(u32x2*)(Vs + swz(row, g2) + e8) = lo;
    *(u32x2*)(Vs + swz(row, g2 + 1) + e8) = hi;
}
DEV f32x16 qk32(const char* Ks, int kt, const bf16x8 (&qf)[4], int r, int hi) {
    f32x16 a;
#pragma unroll
    for (int i = 0; i < 16; ++i) a[i] = 0.f;
#pragma unroll
    for (int s = 0; s < 4; ++s) {
        const bf16x8 kf = *(const bf16x8*)(Ks + swz(32 * kt + r, 2 * s + hi));
        a = __builtin_amdgcn_mfma_f32_32x32x16_bf16(kf, qf[s], a, 0, 0, 0);
    }
    return a;
}
template <int NDT>
DEV void pv32(const char* Vs, int kt, const bf16x8 (&pf)[2], f32x16 (&O)[NDT], int r, int hi) {
#pragma unroll
    for (int s2 = 0; s2 < 2; ++s2)
#pragma unroll
        for (int dt = 0; dt < NDT; ++dt) {
            const bf16x8 vf = *(const bf16x8*)(Vs + swz(32 * dt + r, 4 * kt + 2 * s2 + hi));
            O[dt] = __builtin_amdgcn_mfma_f32_32x32x16_bf16(vf, pf[s2], O[dt], 0, 0, 0);
        }
}
DEV void pack_p(const float (&pv)[16], bf16x8 (&pf)[2]) {
#pragma unroll
    for (int s2 = 0; s2 < 2; ++s2) {
        u32x4 u;
        u.x = cvt_pk_bf16(pv[8 * s2 + 0], pv[8 * s2 + 1]); u.y = cvt_pk_bf16(pv[8 * s2 + 2], pv[8 * s2 + 3]);
        u.z = cvt_pk_bf16(pv[8 * s2 + 4], pv[8 * s2 + 5]); u.w = cvt_pk_bf16(pv[8 * s2 + 6], pv[8 * s2 + 7]);
        pf[s2] = __builtin_bit_cast(bf16x8, u);
    }
}
DEV float xhalf_max(float v) {
    auto rr = __builtin_amdgcn_permlane32_swap(__float_as_uint(v), __float_as_uint(v), false, false);
    return fmaxf(__uint_as_float(rr[0]), __uint_as_float(rr[1]));
}
DEV float rowmax16(const float (&s)[16]) {
    float a = fmaxf(fmaxf(s[0], s[1]), s[2]), b = fmaxf(fmaxf(s[3], s[4]), s[5]);
    a = fmaxf(fmaxf(a, s[6]), s[7]); b = fmaxf(fmaxf(b, s[8]), s[9]);
    a = fmaxf(fmaxf(a, s[10]), s[11]); b = fmaxf(fmaxf(b, s[12]), s[13]);
    a = fmaxf(fmaxf(a, s[14]), s[15]);
    return xhalf_max(fmaxf(a, b));
}
constexpr float OSM_THR = 8.0f;
template <int NDT>
DEV void osm_update(float (&s)[16], float& m, float& l, f32x16 (&O)[NDT]) {
    const float mx = rowmax16(s);
    if (__any(mx > m + OSM_THR)) {
        const float mn = fmaxf(m, mx);
        const float alpha = fexp2(m - mn);
        l *= alpha; m = mn;
#pragma unroll
        for (int dt = 0; dt < NDT; ++dt)
#pragma unroll
            for (int i = 0; i < 16; ++i) O[dt][i] *= alpha;
    }
    float sum = 0.f;
#pragma unroll
    for (int i = 0; i < 16; ++i) { s[i] = fexp2(s[i] - m); sum += s[i]; }
    l += sum;
}
template <int KS, bool WIN>
DEV void make_scores(const f32x16& a, float (&s)[16], int D0, float slope2, bool selb) {
    const float sc2 = 0.125f * LOG2E;
    const float nb0 = -slope2 * (float)D0, sk = slope2 * (float)KS;
#pragma unroll
    for (int i = 0; i < 16; ++i) s[i] = fmaf(sk, (float)((i & 3) + 8 * (i >> 2)), fmaf(a[i], sc2, nb0));
    if (__any(!selb || D0 < 27 * KS || (WIN && D0 >= 512))) {
#pragma unroll
        for (int i = 0; i < 16; ++i) {
            const int dist = D0 - KS * ((i & 3) + 8 * (i >> 2));
            const bool valid = selb && dist >= 0 && (!WIN || dist < 512);
            s[i] = valid ? s[i] : -INFINITY;
        }
    }
}
DEV int first_bit4(unsigned a, unsigned b, unsigned c, unsigned d, int from) {
    if (from < 32)  { const unsigned v = a & (0xffffffffu << from); if (v) return __builtin_ctz(v); from = 32; }
    if (from < 64)  { const unsigned v = b & (0xffffffffu << (from - 32)); if (v) return 32 + __builtin_ctz(v); from = 64; }
    if (from < 96)  { const unsigned v = c & (0xffffffffu << (from - 64)); if (v) return 64 + __builtin_ctz(v); from = 96; }
    if (from < 128) { const unsigned v = d & (0xffffffffu << (from - 96)); if (v) return 96 + __builtin_ctz(v); }
    return -1;
}
DEV unsigned range_mask32(int lo, int hi, int base) {
    int a = lo - base, b = hi - base; if (a < 0) a = 0; if (b > 31) b = 31; if (a > b) return 0u;
    const unsigned up = (b == 31) ? 0xffffffffu : ((1u << (b + 1)) - 1u);
    return up & (0xffffffffu << a);
}

template <int MODE>
DEV void nsa_tile(const char* Ks, const char* Vs, float* imp, int j, unsigned mk0, unsigned mk1, unsigned mk2, unsigned mk3,
                  const bf16x8 (&qf)[4], int t, int tl, float slope2, float& m, float& l, float inv, f32x16 (&O)[2], int r, int hi) {
    bool selb = true;
    if (MODE == 2) { const unsigned wsel = (j < 32) ? mk0 : (j < 64) ? mk1 : (j < 96) ? mk2 : mk3; selb = (wsel >> (j & 31)) & 1u; }
    if (MODE == 2 && !__any(selb)) return;
#pragma unroll
    for (int kt = 0; kt < 2; ++kt) {
        const f32x16 a = qk32(Ks, kt, qf, r, hi);
        float s[16];
        if (MODE <= 1) make_scores<16, false>(a, s, t - 31 - 16 * (64 * j + 32 * kt + 4 * hi), slope2, true);
        else if (MODE == 2) make_scores<1, false>(a, s, t - (64 * j + 32 * kt + 4 * hi), slope2, selb);
        else make_scores<1, true>(a, s, t - (64 * j + 32 * kt + 4 * hi), slope2, true);
        if (MODE == 0) {
            const float mx = rowmax16(s);
            if (__any(mx > m + OSM_THR)) { const float mn = fmaxf(m, mx); l *= fexp2(m - mn); m = mn; }
            float sum = 0.f;
#pragma unroll
            for (int i = 0; i < 16; ++i) sum += fexp2(s[i] - m);
            l += sum;
        } else if (MODE == 1) {
#pragma unroll
            for (int i = 0; i < 16; ++i) s[i] = fexp2(s[i] - m) * inv;
#pragma unroll
            for (int gi = 0; gi < 4; ++gi) {
                const int jb = 16 * j + 8 * kt + 2 * gi + hi;
                const float hb = 0.5f * s[4 * gi + 3];
                const float av = s[4 * gi] + s[4 * gi + 1] + s[4 * gi + 2] + hb;
                if (av != 0.f) atomicAdd(&imp[tl * 129 + jb], av);
                if (hb != 0.f) atomicAdd(&imp[tl * 129 + jb + 1], hb);
            }
            bf16x8 pf[2]; pack_p(s, pf); pv32<2>(Vs, kt, pf, O, r, hi);
        } else {
            osm_update<2>(s, m, l, O);
            bf16x8 pf[2]; pack_p(s, pf); pv32<2>(Vs, kt, pf, O, r, hi);
        }
    }
}

template <int MODE>
DEV void nsa_branch(char* Ks, char* Vs, float* imp, const bf16_t* kbase, int kld, const bf16_t* vbase, int vld,
                    unsigned tm0, unsigned tm1, unsigned tm2, unsigned tm3, unsigned mk0, unsigned mk1, unsigned mk2, unsigned mk3,
                    const bf16x8 (&qf)[4], int t, int tl, float slope2, float& m, float& l, float inv, f32x16 (&O)[2]) {
    const int tid = ltid(), lane = tid & 63, r = lane & 31, hi = lane >> 5, krow = tid >> 3, kch = tid & 7;
    const u32x4 z4 = (u32x4){0u, 0u, 0u, 0u};
    u32x4 rkA = z4, rvA = z4, rkB = z4, rvB = z4, rkC = z4, rvC = z4; int jA, jB, jC;
    int jn = first_bit4(tm0, tm1, tm2, tm3, 0);
#define NSA_LDT(rk, rv, jr) do { jr = jn; if (jn >= 0) { \
        rk = *(const u32x4*)(kbase + (size_t)(64 * jn + krow) * kld + kch * 8); \
        if (MODE != 0) rv = *(const u32x4*)(vbase + (size_t)krow * vld + 64 * jn + kch * 8); \
        jn = first_bit4(tm0, tm1, tm2, tm3, jn + 1); } } while (0)
#define NSA_STEP(rk, rv, jr) do { const int j = jr; \
        __syncthreads(); \
        *(u32x4*)(Ks + swz(krow, kch)) = rk; \
        if (MODE != 0) store_vt_chunk(Vs, krow, kch, rv); \
        __syncthreads(); \
        NSA_LDT(rk, rv, jr); \
        nsa_tile<MODE>(Ks, Vs, imp, j, mk0, mk1, mk2, mk3, qf, t, tl, slope2, m, l, inv, O, r, hi); } while (0)
    NSA_LDT(rkA, rvA, jA); NSA_LDT(rkB, rvB, jB); NSA_LDT(rkC, rvC, jC);
    for (;;) {
        if (jA < 0) break; NSA_STEP(rkA, rvA, jA);
        if (jB < 0) break; NSA_STEP(rkB, rvB, jB);
        if (jC < 0) break; NSA_STEP(rkC, rvC, jC);
    }
#undef NSA_LDT
#undef NSA_STEP
}

constexpr int N_KS = 0, N_VS = 9216, N_IMP = 18432, N_SEL = N_IMP + 64 * 129 * 4  , N_UNI = N_SEL + 1024, N_OUT = 52736;

DEV void nsa_unit(const Params& p, char* lm, int b, int g, int qb) {
    const int tid = ltid(), lane = tid & 63, w = tid >> 6, r = lane & 31, hi = lane >> 5, hh = w >> 1, th = w & 1;
    const int head = g * 4 + hh, tl = 32 * th + r, t = 64 * qb + tl;
    const size_t row = (size_t)b * SEQ + t;
    const float slope2 = LOG2E / (float)(2 << head);
    char* Ks = lm + N_KS; char* Vs = lm + N_VS; float* imp = (float*)(lm + N_IMP);
    unsigned* selm = (unsigned*)(lm + N_SEL); unsigned* uni = (unsigned*)(lm + N_UNI);
    __syncthreads();
    for (int i = tid; i < 64 * 129; i += 512) imp[i] = 0.f;
    if (tid < 4) uni[tid] = 0u;
    const bf16_t* prow = p.proj + row * LD;
    bf16x8 qf[4];
#pragma unroll
    for (int s = 0; s < 4; ++s) qf[s] = *(const bf16x8*)(prow + QOFF + head * 64 + 16 * s + 8 * hi);
    float gt[3];
#pragma unroll
    for (int c3 = 0; c3 < 3; ++c3) gt[c3] = sigmoidf_(bf2f(prow[GTOFF + head * 3 + c3]));
    float* outl = (float*)(lm + N_OUT) + tid;
    f32x16 O[2];
#pragma unroll
    for (int dt = 0; dt < 2; ++dt)
#pragma unroll
        for (int i = 0; i < 16; ++i) O[dt][i] = 0.f;

    {
        int ncmp = 4 * qb + 3; if (ncmp > 511) ncmp = 511;
        const int ntc = (ncmp + 63) >> 6;
        const unsigned tm0 = (1u << ntc) - 1u;
        const bf16_t* kb = p.kc + (size_t)((b * 2 + g) * 512) * 64;
        const bf16_t* vb = p.vcT + (size_t)((b * 2 + g) * 64) * 512;
        float m = -1e30f, l = 0.f;
        nsa_branch<0>(Ks, Vs, imp, kb, 64, vb, 512, tm0, 0u, 0u, 0u, 0u, 0u, 0u, 0u, qf, t, tl, slope2, m, l, 0.f, O);
        const float lt = l + __shfl_xor(l, 32);
        const float inv = 1.0f / fmaxf(lt, 1e-30f);
        nsa_branch<1>(Ks, Vs, imp, kb, 64, vb, 512, tm0, 0u, 0u, 0u, 0u, 0u, 0u, 0u, qf, t, tl, slope2, m, l, inv, O);
#pragma unroll
        for (int dt = 0; dt < 2; ++dt)
#pragma unroll
            for (int i = 0; i < 16; ++i) { outl[(16 * dt + i) * 512] = gt[0] * O[dt][i]; O[dt][i] = 0.f; }
    }
    __syncthreads();
    if (qb + 1 <= 16) {
        if (tid < 64) { const unsigned s0 = range_mask32(0, qb, 0); selm[tid * 4 + 0] = s0; selm[tid * 4 + 1] = 0u; selm[tid * 4 + 2] = 0u; selm[tid * 4 + 3] = 0u; }
        if (tid == 0) uni[0] = range_mask32(0, qb, 0);
    } else {
        if (tid < 64) { imp[tid * 129] += 1e4f; imp[tid * 129 + qb] += 1e4f; imp[tid * 129 + qb - 1] += 1e4f; }
        if (tid < 256) selm[tid] = 0u;
        __syncthreads();
        const int tok = tid >> 3, j0 = tid & 7;
        float vj[16]; int rk[16];
#pragma unroll
        for (int jj = 0; jj < 16; ++jj) { const int j = j0 + 8 * jj; vj[jj] = (j <= qb) ? imp[tok * 129 + j] : -INFINITY; rk[jj] = 0; }
        for (int k = 0; k <= qb; ++k) {
            const float vk = imp[tok * 129 + k];
#pragma unroll
            for (int jj = 0; jj < 16; ++jj) { const int j = j0 + 8 * jj; rk[jj] += ((vk > vj[jj]) || (vk == vj[jj] && k < j)) ? 1 : 0; }
        }
        unsigned s0 = 0u, s1 = 0u, s2 = 0u, s3 = 0u;
#pragma unroll
        for (int jj = 0; jj < 16; ++jj) {
            const int j = j0 + 8 * jj;
            if (j <= qb && rk[jj] < 16) { const unsigned bit = 1u << (j & 31); if (jj < 4) s0 |= bit; else if (jj < 8) s1 |= bit; else if (jj < 12) s2 |= bit; else s3 |= bit; }
        }
        if (s0) { atomicOr(&selm[tok * 4 + 0], s0); atomicOr(&uni[0], s0); }
        if (s1) { atomicOr(&selm[tok * 4 + 1], s1); atomicOr(&uni[1], s1); }
        if (s2) { atomicOr(&selm[tok * 4 + 2], s2); atomicOr(&uni[2], s2); }
        if (s3) { atomicOr(&selm[tok * 4 + 3], s3); atomicOr(&uni[3], s3); }
    }
    __syncthreads();
    {
        const unsigned u0 = uni[0], u1 = uni[1], u2 = uni[2], u3 = uni[3];
        const unsigned mk0 = selm[tl * 4 + 0], mk1 = selm[tl * 4 + 1], mk2 = selm[tl * 4 + 2], mk3 = selm[tl * 4 + 3];
        const bf16_t* kb = p.proj + (size_t)b * SEQ * LD + KSOFF + g * 64;
        const bf16_t* vb = p.vselT + (size_t)(b * 128 + g * 64) * SEQ;
        float m = -1e30f, l = 0.f;
        nsa_branch<2>(Ks, Vs, imp, kb, LD, vb, SEQ, u0, u1, u2, u3, mk0, mk1, mk2, mk3, qf, t, tl, slope2, m, l, 0.f, O);
        const float lt = l + __shfl_xor(l, 32);
        const float sc = gt[1] / fmaxf(lt, 1e-30f);
#pragma unroll
        for (int dt = 0; dt < 2; ++dt)
#pragma unroll
            for (int i = 0; i < 16; ++i) { outl[(16 * dt + i) * 512] += sc * O[dt][i]; O[dt][i] = 0.f; }
    }
    {
        const int jlo = qb - 8 < 0 ? 0 : qb - 8;
        const unsigned w0 = range_mask32(jlo, qb, 0), w1 = range_mask32(jlo, qb, 32), w2 = range_mask32(jlo, qb, 64), w3 = range_mask32(jlo, qb, 96);
        const bf16_t* kb = p.proj + (size_t)b * SEQ * LD + KWOFF + g * 64;
        const bf16_t* vb = p.vwinT + (size_t)(b * 128 + g * 64) * SEQ;
        float m = -1e30f, l = 0.f;
        nsa_branch<3>(Ks, Vs, imp, kb, LD, vb, SEQ, w0, w1, w2, w3, 0u, 0u, 0u, 0u, qf, t, tl, slope2, m, l, 0.f, O);
        const float lt = l + __shfl_xor(l, 32);
        const float sc = gt[2] / fmaxf(lt, 1e-30f);
#pragma unroll
        for (int dt = 0; dt < 2; ++dt)
#pragma unroll
            for (int i = 0; i < 16; ++i) O[dt][i] = outl[(16 * dt + i) * 512] + sc * O[dt][i];
    }
    bf16_t* orow = p.ocat + row * DM + head * 64;
#pragma unroll
    for (int dt = 0; dt < 2; ++dt)
#pragma unroll
        for (int gi = 0; gi < 4; ++gi) {
            u32x2 v; v.x = cvt_pk_bf16(O[dt][4 * gi], O[dt][4 * gi + 1]); v.y = cvt_pk_bf16(O[dt][4 * gi + 2], O[dt][4 * gi + 3]);
            *(u32x2*)(orow + 32 * dt + 8 * gi + 4 * hi) = v;
        }
}

constexpr int D_K1 = 0, D_K2 = 9216, D_VS = 18432, D_XS = 132;
DEV void diff_unit(const Params& p, char* lm, int b, int h, int qblk, int pv = 0) {
    const int tid = ltid(), lane = tid & 63, w = tid >> 6, r = lane & 31, hi = lane >> 5, mp = w >> 2, qs = w & 3;
    const int krow = tid >> 3, kch = tid & 7;
    const int ql = 32 * qs + r, t = 128 * qblk + ql;
    const size_t row = (size_t)b * SEQ + t;
    const float slope2 = LOG2E / (float)(1 << (2 * (h + 1)));
    const float sc2 = 0.125f * LOG2E;
    char* K1s = lm + D_K1; char* K2s = lm + D_K2; char* Vs = lm + D_VS;
    const char* myK = mp ? K2s : K1s;
    const bf16_t* prow = p.proj + row * LD;
    bf16x8 qf[4];
#pragma unroll
    for (int s = 0; s < 4; ++s) qf[s] = *(const bf16x8*)(prow + DQOFF + h * 128 + mp * 64 + 16 * s + 8 * hi);
    f32x16 O[4];
#pragma unroll
    for (int dt = 0; dt < 4; ++dt)
#pragma unroll
        for (int i = 0; i < 16; ++i) O[dt][i] = 0.f;
    float m = -1e30f, l = 0.f;
    const bf16_t* kb = p.proj + (size_t)b * SEQ * LD + DKOFF + h * 128;
    const bf16_t* vb = p.dvT + (size_t)(b * 512 + h * 128) * SEQ;
    const int ntl = 2 * qblk + 2;
    float qn2 = 0.f;
#pragma unroll
    for (int s4 = 0; s4 < 4; ++s4)
#pragma unroll
        for (int e = 0; e < 8; ++e) { const float qv = bf2f((bf16_t)qf[s4][e]); qn2 += qv * qv; }
    qn2 += __shfl_xor(qn2, 32);
    const float kmax2 = __uint_as_float(p.ctrl[CT_KMAX + b * 8 + h * 2 + mp]);
    const float ubase = sqrtf(qn2 * kmax2) * sc2 * 1.001f + 1.0f;
    unsigned* dflag = (unsigned*)(lm + D_VS + 16384);
    bool stop = false;
    const u32x4 z4 = (u32x4){0u, 0u, 0u, 0u};
    u32x4 a1 = z4, a2 = z4, a3 = z4, a4 = z4, b1 = z4, b2 = z4, b3 = z4, b4 = z4, c1 = z4, c2 = z4, c3 = z4, c4 = z4;
#define DIFF_LDT(k1, k2, v0, v1, jj) do { if ((jj) < ntl) { const int k0_ = 64 * (ntl - 1 - (jj)); \
        k1 = *(const u32x4*)(kb + (size_t)(k0_ + krow) * LD + kch * 8); k2 = *(const u32x4*)(kb + (size_t)(k0_ + krow) * LD + 64 + kch * 8); \
        v0 = *(const u32x4*)(vb + (size_t)krow * SEQ + k0_ + kch * 8); v1 = *(const u32x4*)(vb + (size_t)(krow + 64) * SEQ + k0_ + kch * 8); } } while (0)
#define DIFF_STEP(k1, k2, v0, v1, jj) do { const int j_ = ntl - 1 - (jj); \
        { const float ub = ubase - slope2 * (float)(t - (64 * j_ + 63)); const bool dead = __all(ub - m < -152.0f); if (lane == 0) dflag[w] = dead ? 1u : 0u; } \
        __syncthreads(); \
        { const u32x4 f0 = *(const u32x4*)dflag, f1 = *(const u32x4*)(dflag + 4); stop = (f0.x & f0.y & f0.z & f0.w & f1.x & f1.y & f1.z & f1.w) != 0u; } \
        if (!stop) { \
        *(u32x4*)(K1s + swz(krow, kch)) = k1; *(u32x4*)(K2s + swz(krow, kch)) = k2; \
        store_vt_chunk(Vs, krow, kch, v0); store_vt_chunk(Vs, krow + 64, kch, v1); \
        __syncthreads(); \
        DIFF_LDT(k1, k2, v0, v1, (jj) + 3); \
        { f32x16 qa0, qa1; if (pv != 13) { qa0 = qk32(myK, 0, qf, r, hi); qa1 = qk32(myK, 1, qf, r, hi); } else { _Pragma("unroll") for (int i_ = 0; i_ < 16; ++i_) { qa0[i_] = 0.f; qa1[i_] = 0.f; } } \
          { float s[16]; if (pv != 11) { make_scores<1, false>(qa0, s, t - (64 * j_ + 4 * hi), slope2, true); osm_update<4>(s, m, l, O); } else { _Pragma("unroll") for (int i_ = 0; i_ < 16; ++i_) s[i_] = qa0[i_]; } \
            bf16x8 pf[2]; pack_p(s, pf); if (pv != 12) pv32<4>(Vs, 0, pf, O, r, hi); else O[0][0] += s[3]; } \
          { float s[16]; if (pv != 11) { make_scores<1, false>(qa1, s, t - (64 * j_ + 32 + 4 * hi), slope2, true); osm_update<4>(s, m, l, O); } else { _Pragma("unroll") for (int i_ = 0; i_ < 16; ++i_) s[i_] = qa1[i_]; } \
            bf16x8 pf[2]; pack_p(s, pf); if (pv != 12) pv32<4>(Vs, 1, pf, O, r, hi); else O[0][0] += s[5]; } } } } while (0)
    DIFF_LDT(a1, a2, a3, a4, 0); DIFF_LDT(b1, b2, b3, b4, 1); DIFF_LDT(c1, c2, c3, c4, 2);
    for (int j = 0; j < ntl; j += 3) {
        DIFF_STEP(a1, a2, a3, a4, j); if (stop) break;
        if (j + 1 < ntl) { DIFF_STEP(b1, b2, b3, b4, j + 1); if (stop) break; }
        if (j + 2 < ntl) { DIFF_STEP(c1, c2, c3, c4, j + 2); if (stop) break; }
    }
#undef DIFF_LDT
#undef DIFF_STEP
    const float lt = l + __shfl_xor(l, 32);
    const float inv = 1.0f / fmaxf(lt, 1e-30f);
    __syncthreads();
    float* X = (float*)lm;
    if (mp == 1) {
#pragma unroll
        for (int dt = 0; dt < 4; ++dt)
#pragma unroll
            for (int i = 0; i < 16; ++i) X[ql * D_XS + 32 * dt + crow(i, hi)] = O[dt][i] * inv;
    }
    __syncthreads();
    if (mp == 0) {
        const float lam = p.misc[0];
        float ss = 0.f;
#pragma unroll
        for (int dt = 0; dt < 4; ++dt)
#pragma unroll
            for (int i = 0; i < 16; ++i) { const float o = O[dt][i] * inv - lam * X[ql * D_XS + 32 * dt + crow(i, hi)]; O[dt][i] = o; ss += o * o; }
        ss += __shfl_xor(ss, 32);
        const float rs = rsqrtf(ss * (1.0f / 128.0f) + RMS_EPS) * 0.8f;
        bf16_t* orow = p.ocat + row * DM + 512 + h * 128;
#pragma unroll
        for (int dt = 0; dt < 4; ++dt)
#pragma unroll
            for (int gi = 0; gi < 4; ++gi) {
                const int d0 = 32 * dt + 8 * gi + 4 * hi;
                const f32x4 gv = *(const f32x4*)(p.diff_subln + d0);
                u32x2 v; v.x = cvt_pk_bf16(O[dt][4 * gi] * rs * gv[0], O[dt][4 * gi + 1] * rs * gv[1]);
                v.y = cvt_pk_bf16(O[dt][4 * gi + 2] * rs * gv[2], O[dt][4 * gi + 3] * rs * gv[3]);
                *(u32x2*)(orow + d0) = v;
            }
    }
    __syncthreads();
}

struct BLoadIn {
    const float* w; int n0;
    DEV f32x4 ld(int k, int n) const {
        const int cp = n0 + n; int cg;
        if (cp < 1280) cg = cp; else if (cp < 2816) cg = cp + 24; else if (cp < 2840) cg = cp - 2816 + 1280; else return (f32x4){0.f, 0.f, 0.f, 0.f};
        return *(const f32x4*)(w + (size_t)k * 2840 + cg);
    }
};
struct BLqPlain {
    const bf16_t* wt;
    DEV u32x4 ldq(int n, int ks, int ch) const { return *(const u32x4*)(wt + (size_t)n * 1024 + ks * 64 + ch * 8); }
};
struct BLqRouter {
    const bf16_t* wt;
    DEV u32x4 ldq(int n, int ks, int ch) const { const int seg = ks >> 4, kk = ks & 15; return *(const u32x4*)(wt + (size_t)((seg == 2 ? 256 : 0) + n) * 1024 + kk * 64 + ch * 8); }
};
struct BLoadPlain { const float* w; int ldb; DEV f32x4 ld(int k, int n) const { return *(const f32x4*)(w + (size_t)k * ldb + n); } };
struct BLoadRouter {
    const float* w;
    DEV f32x4 ld(int k, int n) const {
        const int seg = k >> 10, kk = k & 1023;
        f32x4 v = *(const f32x4*)(w + (size_t)kk * 256 + n);
        if (seg == 2) {
#pragma unroll
            for (int i = 0; i < 4; ++i) v[i] = v[i] - bf2f(f2bf(v[i]));
        }
        return v;
    }
};
struct BLoadGU {
    const float* w; int nt;
    DEV f32x4 ld(int k, int n) const {
        const int col = ((n >> 5) & 1) * 256 + 64 * nt + 32 * (n >> 6) + 16 * ((n >> 4) & 1) + (n & 15);
        return *(const f32x4*)(w + (size_t)k * 512 + col);
    }
};

template <int NM> struct EpiProj {
    bf16_t* o; int row0, col0;
    DEV void operator()(const f32x4 (&acc)[NM][4], int r0, int c0, int rowlim, int c, int q) const {
#pragma unroll
        for (int mi = 0; mi < NM; ++mi) {
            if (r0 + 16 * mi < rowlim) {
#pragma unroll
                for (int ni = 0; ni < 4; ++ni) {
                    const f32x4 v = acc[mi][ni]; u32x2 u; u.x = cvt_pk_bf16(v[0], v[1]); u.y = cvt_pk_bf16(v[2], v[3]);
                    *(u32x2*)(o + (size_t)(row0 + r0 + 16 * mi + c) * LD + col0 + c0 + 16 * ni + 4 * q) = u;
                }
            }
        }
    }
};
template <int NM> struct EpiVT {
    bf16_t* vt; int row0, vbase, bstride;
    DEV void operator()(const f32x4 (&acc)[NM][4], int r0, int c0, int rowlim, int c, int q) const {
#pragma unroll
        for (int mi = 0; mi < NM; ++mi) {
            if (r0 + 16 * mi < rowlim) {
                const int rg = row0 + r0 + 16 * mi + 4 * q, bb = rg >> 13, tt = rg & (SEQ - 1);
#pragma unroll
                for (int ni = 0; ni < 4; ++ni) {
                    const f32x4 v = acc[mi][ni]; u32x2 u; u.x = cvt_pk_bf16(v[0], v[1]); u.y = cvt_pk_bf16(v[2], v[3]);
                    *(u32x2*)(vt + (size_t)(vbase + bb * bstride + c0 + 16 * ni + c) * SEQ + tt) = u;
                }
            }
        }
    }
};
template <int NM> struct EpiF32 {
    float* o; int ldo, row0, col0;
    DEV void operator()(const f32x4 (&acc)[NM][4], int r0, int c0, int rowlim, int c, int q) const {
#pragma unroll
        for (int mi = 0; mi < NM; ++mi) {
            if (r0 + 16 * mi < rowlim) {
#pragma unroll
                for (int ni = 0; ni < 4; ++ni)
                    *(f32x4*)(o + (size_t)(row0 + r0 + 16 * mi + c) * ldo + col0 + c0 + 16 * ni + 4 * q) = acc[mi][ni];
            }
        }
    }
};
template <int NM> struct EpiSwiglu {
    bf16_t* H; const int* rslot; const float* rwt; int nt;
    DEV void operator()(const f32x4 (&acc)[NM][4], int r0, int c0, int rowlim, int c, int q) const {
#pragma unroll
        for (int mi = 0; mi < NM; ++mi) {
            if (r0 + 16 * mi < rowlim) {
                const int rr = r0 + 16 * mi + c; const int slot = rslot[rr];
                if (slot >= 0) {
                    const float wt = rwt[rr];
#pragma unroll
                    for (int nh = 0; nh < 2; ++nh) {
                        const f32x4 a = acc[mi][nh], g = acc[mi][nh + 2]; float hv[4];
#pragma unroll
                        for (int i = 0; i < 4; ++i) hv[i] = a[i] / (1.0f + __expf(-a[i])) * g[i] * wt;
                        u32x2 u; u.x = cvt_pk_bf16(hv[0], hv[1]); u.y = cvt_pk_bf16(hv[2], hv[3]);
                        *(u32x2*)(H + (size_t)slot * 256 + 64 * nt + (c0 >> 1) + 16 * nh + 4 * q) = u;
                    }
                }
            }
        }
    }
};

DEV int entry_cnt(const unsigned* cnt, int e) { if (e >= 256) return 2048; const unsigned n = cnt[e]; return n > (unsigned)CAP ? CAP : (int)n; }

template <int STAGE>
DEV void moe_phase(const Params& p, char* lds, unsigned xcc, int rep) {
    char* lm = lds + L_MAIN;
    int* pre = (int*)(lm + G_PRE);
    int* rowoff = (int*)(lm + G_ROWOFF);
    int* rslot = (int*)(lm + G_RSLOT);
    float* rwt = (float*)(lm + G_RWT);
    int* bc = (int*)(lds + L_CTRL + 16);
    const unsigned* cnt = p.ctrl + CT_CNT;
    const int tid = ltid();
    constexpr int NT = (STAGE == 1) ? 4 : 8;
    __syncthreads();
    if (tid < 8) {
        int s = 0;
        for (int k = 0; k < 33; ++k) { pre[tid * 34 + k] = s; const int n = entry_cnt(cnt, tid + 8 * k); s += ((n + 383) / 384) * NT; }
        pre[tid * 34 + 33] = s;
    }
    __syncthreads();
    for (int xo = 0; xo < 8; ++xo) {
        const int x = (int)((xcc + xo) & 7u);
        unsigned* qc = p.ctrl + CT_Q + 64 * ((STAGE == 1 ? 16 : 32) + 8 * rep + x);
        const int total = pre[x * 34 + 33];
        for (;;) {
            __syncthreads();
            if (tid == 0) {
                const int u = (int)atomicAdd(qc, 1u);
                int k = -1;
                if (u < total) { k = 0; while (pre[x * 34 + k + 1] <= u) ++k; }
                bc[0] = u; bc[1] = k;
            }
            __syncthreads();
            const int u = bc[0], k = bc[1];
            if (k < 0) break;
            const int e = x + 8 * k, local = u - pre[x * 34 + k];
            const int n_e = entry_cnt(cnt, e);
            const int ngrp = (n_e + 383) / 384;
            const int nt = local / ngrp, mg = local % ngrp;
            int rows = n_e - mg * 384; if (rows > 384) rows = 384;
            const int nsub = (rows + 127) >> 7;
            {
                const int idx = mg * 384 + tid; int slot = -1; float wt = 0.f;
                if (tid < rows) {
                    if (e < 256) { const uint2 en = p.bucket[(size_t)e * CAP + idx]; slot = (int)en.x; wt = __uint_as_float(en.y); if ((unsigned)slot >= (unsigned)(T_TOK * 9)) slot = -1; }
                    else { slot = ((e - 256) * 2048 + idx) * 9 + 8; wt = 1.0f; }
                }
                rslot[tid] = slot; rwt[tid] = wt;
                rowoff[tid] = slot < 0 ? 0 : (STAGE == 1 ? (slot / 9) * 1024 : slot * 256);
            }
            __syncthreads();
            {
                ASrcPlain as; as.base = p.hhi;
                BLoadGU bl; bl.w = e < 256 ? p.w_gate_up + (size_t)e * 1024 * 512 : p.ws_gate_up; bl.nt = nt;
                EpiSwiglu<6> ep; ep.H = p.H; ep.rslot = rslot; ep.rwt = rwt; ep.nt = nt;
                gemm_big<3, true, 1, ASrcPlain, BLoadGU, EpiSwiglu<6>, 2>(lm, 16, nsub, as, bl, ep, (PROBE_PH == 9 && rep == 0) ? PROBE_VAR : 0);
            }
        }
    }
}

constexpr int DN_BS = 131072, DN_RSLOT = DN_BS + 18432, DN_PRE = DN_RSLOT + 1024;
DEV void moe_down_phase(const Params& p, char* lds, unsigned xcc, int rep) {
    char* lm = lds + L_MAIN;
    char* Bs = lm + DN_BS;
    int* rslot = (int*)(lm + DN_RSLOT);
    int* pre = (int*)(lm + DN_PRE);
    int* bc = (int*)(lds + L_CTRL + 16);
    const unsigned* cnt = p.ctrl + CT_CNT;
    const int tid = ltid(), lane = tid & 63, w = tid >> 6, wm = w >> 2, wn = w & 3, c = lane & 15, q = lane >> 4;
    const int bn4 = 8 * (w & 3) + (lane & 7), bkq = 8 * (w >> 2) + (lane >> 3);
    __syncthreads();
    if (tid < 8) {
        int sacc = 0;
        for (int k = 0; k < 33; ++k) { pre[tid * 34 + k] = sacc; const int n = entry_cnt(cnt, tid + 8 * k); sacc += (n + 255) >> 8; }
        pre[tid * 34 + 33] = sacc;
    }
    __syncthreads();
    for (int xo = 0; xo < 8; ++xo) {
        const int x = (int)((xcc + xo) & 7u);
        unsigned* qc = p.ctrl + CT_Q + 64 * (32 + 8 * rep + x);
        const int total = pre[x * 34 + 33];
        for (;;) {
            __syncthreads();
            if (tid == 0) {
                const int u = (int)atomicAdd(qc, 1u);
                int k = -1;
                if (u < total) { k = 0; while (pre[x * 34 + k + 1] <= u) ++k; }
                bc[0] = u; bc[1] = k;
            }
            __syncthreads();
            const int u = bc[0], k = bc[1];
            if (k < 0) break;
            const int e = x + 8 * k, mg = u - pre[x * 34 + k];
            const int n_e = entry_cnt(cnt, e);
            int rows = n_e - mg * 256; if (rows > 256) rows = 256;
            const int nsub = (rows + 127) >> 7;
            if (tid < 256) {
                const int idx = mg * 256 + tid; int slot = -1;
                if (tid < rows) {
                    if (e < 256) { slot = (int)p.bucket[(size_t)e * CAP + idx].x; if ((unsigned)slot >= (unsigned)(T_TOK * 9)) slot = -1; }
                    else slot = ((e - 256) * 2048 + idx) * 9 + 8;
                }
                rslot[tid] = slot;
            }
            __syncthreads();
#pragma unroll
            for (int hb = 0; hb < 2; ++hb) {
                u32x4 v[8];
#pragma unroll
                for (int i = 0; i < 8; ++i) {
                    const int id = tid + 512 * (8 * hb + i), row = id >> 5, kc = id & 31;
                    const int slot = rslot[row];
                    v[i] = *(const u32x4*)(p.H + (size_t)(slot < 0 ? 0 : slot) * 256 + kc * 8);
                }
#pragma unroll
                for (int i = 0; i < 8; ++i) {
                    const int id = tid + 512 * (8 * hb + i), row = id >> 5, kc = id & 31;
                    const int tile = (row >> 7) * 4 + (kc >> 3), rr = row & 127;
                    *(u32x4*)(lm + tile * 16384 + swz(rr, kc & 7)) = v[i];
                }
            }
            const float* wd = (e < 256 ? p.w_down + (size_t)e * 256 * 1024 : p.ws_down);
            f32x4 rb[2][4];
#pragma unroll
            for (int s2 = 0; s2 < 2; ++s2)
#pragma unroll
                for (int i = 0; i < 4; ++i) rb[s2][i] = *(const f32x4*)(wd + (size_t)(s2 * 64 + 4 * bkq + i) * 1024 + 4 * bn4);
            f32x4 acc[2][4][2];
#pragma unroll 1
            for (int nt = 0; nt < 8; ++nt) {
#pragma unroll
                for (int sb = 0; sb < 2; ++sb)
#pragma unroll
                    for (int mi = 0; mi < 4; ++mi)
#pragma unroll
                        for (int ni = 0; ni < 2; ++ni) acc[sb][mi][ni] = (f32x4){0.f, 0.f, 0.f, 0.f};
#pragma unroll 1
                for (int ksp = 0; ksp < 2; ++ksp) {
#pragma unroll
                    for (int k2 = 0; k2 < 2; ++k2) {
                        const int ks = 2 * ksp + k2;
                        __syncthreads();
#pragma unroll
                        for (int cc = 0; cc < 4; ++cc) {
                            u32x2 v; v.x = cvt_pk_bf16(rb[k2][0][cc], rb[k2][1][cc]); v.y = cvt_pk_bf16(rb[k2][2][cc], rb[k2][3][cc]);
                            *(u32x2*)(Bs + swz(4 * bn4 + cc, bkq >> 1) + (bkq & 1) * 8) = v;
                        }
                        __syncthreads();
                        {
                            const int st2 = nt * 4 + ks + 2;
                            if (st2 < 32) {
                                const int nt2 = st2 >> 2, ks2 = st2 & 3;
#pragma unroll
                                for (int i = 0; i < 4; ++i) rb[k2][i] = *(const f32x4*)(wd + (size_t)(ks2 * 64 + 4 * bkq + i) * 1024 + 128 * nt2 + 4 * bn4);
                            }
                        }
#pragma unroll
                        for (int kk = 0; kk < 2; ++kk) {
                            bf16x8 bfr[2];
#pragma unroll
                            for (int ni = 0; ni < 2; ++ni) bfr[ni] = *(const bf16x8*)(Bs + swz(32 * wn + 16 * ni + c, 4 * kk + q));
#pragma unroll
                            for (int sb = 0; sb < 2; ++sb) {
                                if (sb < nsub) {
                                    bf16x8 af[4];
#pragma unroll
                                    for (int mi = 0; mi < 4; ++mi) {
                                        const int rr = 64 * wm + 16 * mi + c;
                                        af[mi] = *(const bf16x8*)(lm + (sb * 4 + ks) * 16384 + swz(rr, 4 * kk + q));
                                    }
#pragma unroll
                                    for (int mi = 0; mi < 4; ++mi)
#pragma unroll
                                        for (int ni = 0; ni < 2; ++ni)
                                            acc[sb][mi][ni] = __builtin_amdgcn_mfma_f32_16x16x32_bf16(bfr[ni], af[mi], acc[sb][mi][ni], 0, 0, 0);
                                }
                            }
                        }
                    }
                }
#pragma unroll
                for (int sb = 0; sb < 2; ++sb) {
                    if (sb < nsub) {
#pragma unroll
                        for (int mi = 0; mi < 4; ++mi) {
                            const int slot = rslot[128 * sb + 64 * wm + 16 * mi + c];
                            if (slot >= 0) {
#pragma unroll
                                for (int ni = 0; ni < 2; ++ni) {
                                    const f32x4 v = acc[sb][mi][ni]; u32x2 uu; uu.x = cvt_pk_bf16(v[0], v[1]); uu.y = cvt_pk_bf16(v[2], v[3]);
                                    *(u32x2*)(p.yslot + (size_t)slot * 1024 + 128 * nt + 32 * wn + 16 * ni + 4 * q) = uu;
                                }
                            }
                        }
                    }
                }
            }
        }
    }
}

template <int MODE>
DEV void wt_tile(const float* src, int ldn, bf16_t* dstbase, int ntile, int ktile, float* tl, int tid) {
    __syncthreads();
#pragma unroll
    for (int j = 0; j < 2; ++j) {
        const int idx = tid + 512 * j, kk = idx >> 4, n4 = idx & 15;
        const int cp = ntile * 64 + n4 * 4; int cg = cp;
        if (MODE == 1) { if (cp < 1280) cg = cp; else if (cp < 2816) cg = cp + 24; else if (cp < 2840) cg = cp - 2816 + 1280; else cg = -1; }
        f32x4 v = (f32x4){0.f, 0.f, 0.f, 0.f};
        if (cg >= 0) v = *(const f32x4*)(src + (size_t)(ktile * 64 + kk) * ldn + cg);
        tl[kk * 65 + n4 * 4 + 0] = v[0]; tl[kk * 65 + n4 * 4 + 1] = v[1]; tl[kk * 65 + n4 * 4 + 2] = v[2]; tl[kk * 65 + n4 * 4 + 3] = v[3];
    }
    __syncthreads();
    const int n = tid >> 3, kc = tid & 7;
    float f[8];
#pragma unroll
    for (int e = 0; e < 8; ++e) f[e] = tl[(kc * 8 + e) * 65 + n];
    u32x4 o; o.x = cvt_pk_bf16(f[0], f[1]); o.y = cvt_pk_bf16(f[2], f[3]); o.z = cvt_pk_bf16(f[4], f[5]); o.w = cvt_pk_bf16(f[6], f[7]);
    bf16_t* dst = dstbase + (size_t)(ntile * 64 + n) * 1024 + ktile * 64 + kc * 8;
    *(u32x4*)dst = o;
    if (MODE == 2) {
#pragma unroll
        for (int e = 0; e < 8; ++e) f[e] = f[e] - bf2f(f2bf(f[e]));
        o.x = cvt_pk_bf16(f[0], f[1]); o.y = cvt_pk_bf16(f[2], f[3]); o.z = cvt_pk_bf16(f[4], f[5]); o.w = cvt_pk_bf16(f[6], f[7]);
        *(u32x4*)(dst + (size_t)256 * 1024) = o;
    }
}

#ifndef STOP_AFTER
#define STOP_AFTER 99
#endif
DEV void dump_out(const Params& p, int k) {
    const size_t n = (size_t)T_TOK * DM;
    for (size_t i = (size_t)blockIdx.x * 512 + threadIdx.x; i < n; i += (size_t)gridDim.x * 512) {
        float v = 0.f;
        if (k == 1) v = bf2f(p.hmix[i]);
        else if (k == 0) v = i < 12288 ? p.mod[i] : i < 12288 + 192 ? p.misc[i - 12288] : 0.f;
        else if (k == 2) v = (i % 2944 < 896 || (i % 2944 >= 1024 && i % 2944 < 1152) || (i % 2944 >= 1280 && i % 2944 < 2304) || i % 2944 >= 2816) ? bf2f(p.proj[i]) : 0.f;
        else if (k == 3) v = i < 131072 ? bf2f(p.kc[i]) : i < 262144 ? bf2f(p.vcT[i - 131072]) : i < 262144 + 12582912 ? bf2f(p.vselT[i - 262144]) : 0.f;
        else if (k == 4) v = bf2f(p.ocat[i]);
        else if (k == 5) v = p.y[i];
        else if (k == 6) v = bf2f(p.hhi[i]) + 64.f * bf2f(p.hlo[i]);
        else if (k == 7) v = i < (size_t)T_TOK * 256 ? p.logits[i] : 0.f;
        else if (k == 8) v = i < 256 ? (float)p.ctrl[CT_CNT + i] : 0.f;
        else if (k == 9) v = bf2f(p.H[i]) + bf2f(p.H[i + n]);
        else if (k == 10) v = bf2f(p.yslot[i]) + bf2f(p.yslot[i + 4 * n]) + bf2f(p.yslot[i + 8 * n]);
        p.out[i] = v;
    }
}
#define STOP_AT(k) do { if (STOP_AFTER == (k)) { dump_out(p, (k)); return; } } while (0)
__global__ void __launch_bounds__(512, 2) fwd_kernel(Params p) {
    extern __shared__ __attribute__((aligned(16))) char lds[];
    const int tid = ltid(), lane = tid & 63, w = tid >> 6;
    const int nb = gridDim.x, bid = blockIdx.x;
    char* lm = lds + L_MAIN;
    if (tid < 16) ((unsigned*)lds)[tid] = 0u;
    __syncthreads();
    XcdBarrier bar = xcd_barrier_post(p.ctrl, (volatile LAS unsigned*)lds);
    const unsigned xcc = bar.x & 7u;
    int* bc = (int*)(lds + L_CTRL + 16);

    {
    const int tid = ltid(), lane = tid & 63, w = tid >> 6; (void)lane; (void)w;
        float* sc = (float*)lm;
        float* red = (float*)(lm + 8192);
        for (int i = tid; i < 2048; i += 512) { const float v = p.c[i]; sc[i] = v / (1.0f + __expf(-v)); }
        __syncthreads();
        for (int cb = bid; cb < 256; cb += nb) {
            if (tid < 480) {
                const int j = tid % 24, ks = tid / 24; const int col = cb * 24 + j;
                float a0 = 0.f, a1 = 0.f;
                for (int k = ks; k < 1024; k += 20) { const float wv = p.w_ada[(size_t)k * 6144 + col]; a0 += sc[k] * wv; a1 += sc[1024 + k] * wv; }
                red[(ks * 24 + j) * 2] = a0; red[(ks * 24 + j) * 2 + 1] = a1;
            }
            __syncthreads();
            if (tid < 48) {
                const int j = tid >> 1, bb = tid & 1; float s = 0.f;
                for (int ks = 0; ks < 20; ++ks) s += red[(ks * 24 + j) * 2 + bb];
                const int col = cb * 24 + j;
                p.mod[bb * 6144 + col] = s + p.b_ada[col];
            }
            __syncthreads();
        }
        for (int cb = bid; cb < 256; cb += nb) {
            if (tid < 64) {
                const int kv = cb >> 7, chunk = cb & 127; float a = 0.f;
#pragma unroll
                for (int kk = 0; kk < 16; ++kk) { const int k = chunk * 16 + kk; a += p.pe_cmp[kv * 2048 + k] * p.w_cmp1[((size_t)kv * 2048 + k) * 64 + tid]; }
                p.misc[1024 + cb * 64 + tid] = a;
            }
        }
        {
            float* tl = (float*)(lm + 16384);
            for (int u = bid; u < 736; u += nb) wt_tile<1>(p.w_in, 2840, p.wT, u >> 4, u & 15, tl, tid);
            for (int u = bid; u < 256; u += nb) wt_tile<0>(p.w_out, 1024, p.wT + (size_t)2944 * 1024, u >> 4, u & 15, tl, tid);
            for (int u = bid; u < 64; u += nb) wt_tile<2>(p.w_router, 256, p.wT + (size_t)3968 * 1024, u >> 4, u & 15, tl, tid);
            __syncthreads();
        }
        if (bid == (2 % nb) && tid == 0) {
            float s01 = 0.f, s23 = 0.f;
            for (int i = 0; i < 64; ++i) { s01 += p.diff_lambda[i] * p.diff_lambda[64 + i]; s23 += p.diff_lambda[128 + i] * p.diff_lambda[192 + i]; }
            p.misc[0] = __expf(s01) - __expf(s23) + 0.2f;
        }
        if (bid == (3 % nb)) {
            for (int i = tid; i < 4 * 64; i += 512) { const int bg = i >> 6, d = i & 63; p.kc[((size_t)bg * 512 + 511) * 64 + d] = 0; p.vcT[((size_t)bg * 64 + d) * 512 + 511] = 0; }
        }
    }
    xcd_barrier(bar);
    STOP_AT(0);

    for (int rep_ = 0; rep_ < REPS(1); ++rep_) {
    const int tid = ltid(), lane = tid & 63, w = tid >> 6; (void)lane; (void)w;
    for (int row = bid * 8 + w; row < T_TOK; row += nb * 8) {
        const int bb = row >> 13; const float* xr = p.x + (size_t)row * DM;
        f32x4 v[4]; float ss = 0.f;
#pragma unroll
        for (int j = 0; j < 4; ++j) { v[j] = *(const f32x4*)(xr + lane * 4 + 256 * j); ss += v[j][0] * v[j][0] + v[j][1] * v[j][1] + v[j][2] * v[j][2] + v[j][3] * v[j][3]; }
        ss = wave_sum(ss);
        const float rs = rsqrtf(ss * (1.0f / 1024.0f) + RMS_EPS);
#pragma unroll
        for (int j = 0; j < 4; ++j) {
            const int col = lane * 4 + 256 * j;
            const f32x4 g = *(const f32x4*)(p.norm_g + col), s1 = *(const f32x4*)(p.mod + bb * 6144 + 1024 + col), h1 = *(const f32x4*)(p.mod + bb * 6144 + col);
            float o[4];
#pragma unroll
            for (int i = 0; i < 4; ++i) o[i] = v[j][i] * rs * g[i] * (1.0f + s1[i]) + h1[i];
            u32x2 u; u.x = cvt_pk_bf16(o[0], o[1]); u.y = cvt_pk_bf16(o[2], o[3]);
            *(u32x2*)(p.hmix + (size_t)row * DM + col) = u;
        }
    }
    xcd_barrier(bar);
    }
    STOP_AT(1);

    for (int rep_ = 0; rep_ < REPS(2); ++rep_) {
    const int tid = ltid(), lane = tid & 63, w = tid >> 6; (void)lane; (void)w;
    for (int u = bid; u < 43 * 23; u += nb) {
        const int mg = u / 23, nt = u % 23;
        const int nsub = (mg == 42) ? 2 : 3;
        __syncthreads();
        { int r = mg * 384 + tid; if (r > T_TOK - 1) r = T_TOK - 1; ((int*)(lm + G_ROWOFF))[tid] = r * DM; }
        __syncthreads();
        ASrcPlain as; as.base = p.hmix;
        BLqPlain bl; bl.wt = p.wT + (size_t)nt * 128 * 1024;
        const bool vt = (nt == 7) || (nt == 9) || (nt >= 18 && nt <= 21);
        if (!vt) {
            EpiProj<6> ep; ep.o = p.proj; ep.row0 = mg * 384; ep.col0 = nt * 128;
            gemm_big<3, true, 2, ASrcPlain, BLqPlain, EpiProj<6>, 2, true>(lm, 16, nsub, as, bl, ep);
        } else {
            EpiVT<6> ep; ep.row0 = mg * 384; ep.vt = p.vselT;
            ep.vbase = (nt == 7) ? 0 : (nt == 9) ? 256 : 512 + (nt - 18) * 128; ep.bstride = (nt >= 18) ? 512 : 128;
            gemm_big<3, false, 2, ASrcPlain, BLqPlain, EpiVT<6>, 2, true>(lm, 16, nsub, as, bl, ep);
        }
    }
    xcd_barrier(bar);
    }
    STOP_AT(2);

    for (int rep_ = 0; rep_ < REPS(3); ++rep_) {
    const int tid = ltid(), lane = tid & 63, w = tid >> 6; (void)lane; (void)w;
    for (int u2 = bid; u2 < 256; u2 += nb) {
        const int tokr = u2 * 64 + (tid >> 3), part = tid & 7;
        const bf16_t* kp = p.proj + (size_t)tokr * LD + DKOFF + part * 64;
        float sq = 0.f;
#pragma unroll
        for (int c8 = 0; c8 < 8; ++c8) {
            const u32x4 v = *(const u32x4*)(kp + c8 * 8);
            const float e0 = bflo(v.x), e1 = bfhi(v.x), e2 = bflo(v.y), e3 = bfhi(v.y), e4 = bflo(v.z), e5 = bfhi(v.z), e6 = bflo(v.w), e7 = bfhi(v.w);
            sq += e0 * e0 + e1 * e1 + e2 * e2 + e3 * e3 + e4 * e4 + e5 * e5 + e6 * e6 + e7 * e7;
        }
        sq = fmaxf(sq, __shfl_xor(sq, 8)); sq = fmaxf(sq, __shfl_xor(sq, 16)); sq = fmaxf(sq, __shfl_xor(sq, 32));
        if (lane < 8) atomicMax(p.ctrl + CT_KMAX + (tokr >> 13) * 8 + part, __float_as_uint(sq));
    }
    for (int u = bid; u < 256; u += nb) {
        const int kv = u >> 7, bb = (u >> 6) & 1, g = (u >> 5) & 1, ch = u & 31, n0 = ch * 16;
        bf16_t* raw = (bf16_t*)lm;
        float* hid = (float*)(lm + 272 * 128);
        __syncthreads();
        for (int i = tid; i < 272 * 8; i += 512) {
            const int tk = i >> 3, chn = i & 7; const int tok = 16 * n0 + tk;
            u32x4 v = (u32x4){0u, 0u, 0u, 0u};
            if (tok < SEQ) v = *(const u32x4*)(p.proj + ((size_t)bb * SEQ + tok) * LD + (kv ? VCOFF : KCOFF) + g * 64 + chn * 8);
            *(u32x4*)(raw + tk * 64 + chn * 8) = v;
        }
        __syncthreads();
        const int rr = tid >> 5, c2 = tid & 31;
        float* wl = (float*)(lm + 272 * 128 + 4096);
        float a0 = 0.f, a1 = 0.f;
        {
            const int n = tid & 63, part = tid >> 6; float sacc = 0.f;
#pragma unroll
            for (int jq = 0; jq < 16; ++jq) sacc += p.misc[1024 + (kv * 128 + part * 16 + jq) * 64 + n];
            hid[part * 64 + n] = sacc;
            __syncthreads();
#pragma unroll
            for (int pp = 0; pp < 8; ++pp) { a0 += hid[pp * 64 + 2 * c2]; a1 += hid[pp * 64 + 2 * c2 + 1]; }
        }
        const float* w1g = p.w_cmp1 + (size_t)kv * 2048 * 64;
        f32x4 wv[8];
#pragma unroll
        for (int j = 0; j < 8; ++j) wv[j] = *(const f32x4*)(w1g + (size_t)(tid + 512 * j) * 4);
        for (int chk = 0; chk < 8; ++chk) {
            __syncthreads();
#pragma unroll
            for (int j = 0; j < 8; ++j) *(f32x4*)(wl + (tid + 512 * j) * 4) = wv[j];
            __syncthreads();
            if (chk + 1 < 8) {
#pragma unroll
                for (int j = 0; j < 8; ++j) wv[j] = *(const f32x4*)(w1g + (size_t)(chk + 1) * 16384 + (size_t)(tid + 512 * j) * 4);
            }
            for (int i4 = 0; i4 < 4; ++i4) {
                const bf16_t* rp = raw + (16 * rr + chk * 4 + i4) * 64;
#pragma unroll 2
                for (int d8 = 0; d8 < 8; ++d8) {
                    const u32x4 rv = *(const u32x4*)(rp + d8 * 8);
                    const float av[8] = {bflo(rv.x), bfhi(rv.x), bflo(rv.y), bfhi(rv.y), bflo(rv.z), bfhi(rv.z), bflo(rv.w), bfhi(rv.w)};
#pragma unroll
                    for (int e = 0; e < 8; ++e) { const float2 wv2 = *(const float2*)(wl + (i4 * 64 + d8 * 8 + e) * 64 + 2 * c2); a0 += av[e] * wv2.x; a1 += av[e] * wv2.y; }
                }
            }
        }
        __syncthreads();
        {
            const float k0 = 0.7978845608028654f, k1 = 0.044715f;
            const float t0 = tanhf(k0 * (a0 + k1 * a0 * a0 * a0)), t1 = tanhf(k0 * (a1 + k1 * a1 * a1 * a1));
            hid[rr * 64 + 2 * c2] = 0.5f * a0 * (1.0f + t0); hid[rr * 64 + 2 * c2 + 1] = 0.5f * a1 * (1.0f + t1);
        }
        __syncthreads();
        const float* w2 = p.w_cmp2 + (size_t)kv * 64 * 64 + 2 * c2;
        float o0 = 0.f, o1 = 0.f;
        for (int jx = 0; jx < 64; ++jx) { const float hv = hid[rr * 64 + jx]; const float2 wv = *(const float2*)(w2 + jx * 64); o0 += hv * wv.x; o1 += hv * wv.y; }
        const int n = n0 + rr;
        if (n < 511) {
            if (kv == 0) { *(unsigned*)(p.kc + ((size_t)(bb * 2 + g) * 512 + n) * 64 + 2 * c2) = cvt_pk_bf16(o0, o1); }
            else { p.vcT[((size_t)(bb * 2 + g) * 64 + 2 * c2) * 512 + n] = f2bf(o0); p.vcT[((size_t)(bb * 2 + g) * 64 + 2 * c2 + 1) * 512 + n] = f2bf(o1); }
        }
    }
    xcd_barrier(bar);
    }
    STOP_AT(3);

    for (int rep_ = 0; rep_ < REPS(4); ++rep_) {
    const int tid = ltid(), lane = tid & 63, w = tid >> 6; (void)lane; (void)w;
    {
        int u;
        for (;;) {
            __syncthreads();
            if (tid == 0) bc[0] = (int)atomicAdd(p.ctrl + CT_Q + 64 * rep_, 1u);
            __syncthreads();
            u = bc[0];
            if (u >= 512) break;
            const int qk = 63 - (u >> 3), bh = u & 7;
            if (!(PROBE_PH == 4 && rep_ == 0 && PROBE_VAR == 2)) diff_unit(p, lm, bh >> 2, bh & 3, qk, (PROBE_PH == 4 && rep_ == 0) ? PROBE_VAR : 0);
        }
        while (u < 1024) {
            const int v = u - 512; const int qb = 127 - (v >> 2), bg = v & 3;
            if (!(PROBE_PH == 4 && rep_ == 0 && (PROBE_VAR == 1 || PROBE_VAR >= 11))) nsa_unit(p, lm, bg >> 1, bg & 1, qb);
            __syncthreads();
            if (tid == 0) bc[0] = (int)atomicAdd(p.ctrl + CT_Q + 64 * rep_, 1u);
            __syncthreads();
            u = bc[0];
        }
    }
    xcd_barrier(bar);
    }
    STOP_AT(4);

    for (int rep_ = 0; rep_ < REPS(5); ++rep_) {
    const int tid = ltid(), lane = tid & 63, w = tid >> 6; (void)lane; (void)w;
    for (int u = bid; u < 64 * 8; u += nb) {
        const int nt = u / 64, mg = u % 64;
        __syncthreads();
        if (tid < 256) ((int*)(lm + G_ROWOFF))[tid] = (mg * 256 + tid) * DM;
        __syncthreads();
        ASrcPlain as; as.base = p.ocat;
        BLqPlain bl; bl.wt = p.wT + (size_t)(2944 + nt * 128) * 1024;
        EpiF32<4> ep; ep.o = p.y; ep.ldo = 1024; ep.row0 = mg * 256; ep.col0 = nt * 128;
        gemm_big<2, true, 3, ASrcPlain, BLqPlain, EpiF32<4>, 3, true>(lm, 16, 2, as, bl, ep, (PROBE_PH == 5 && rep_ == 0) ? PROBE_VAR : 0);
    }
    xcd_barrier(bar);
    }
    STOP_AT(5);

    for (int rep_ = 0; rep_ < REPS(6); ++rep_) {
    const int tid = ltid(), lane = tid & 63, w = tid >> 6; (void)lane; (void)w;
    for (int row0 = bid * 8 + w; row0 < T_TOK; row0 += nb * 16) {
        const int row1r = row0 + nb * 8; const bool has1 = row1r < T_TOK; const int row1 = has1 ? row1r : row0;
        f32x4 yv[2][4], xv[2][4]; float ss[2] = {0.f, 0.f};
#pragma unroll
        for (int j = 0; j < 4; ++j) {
            yv[0][j] = *(const f32x4*)(p.y + (size_t)row0 * DM + lane * 4 + 256 * j); yv[1][j] = *(const f32x4*)(p.y + (size_t)row1 * DM + lane * 4 + 256 * j);
            xv[0][j] = *(const f32x4*)(p.x + (size_t)row0 * DM + lane * 4 + 256 * j); xv[1][j] = *(const f32x4*)(p.x + (size_t)row1 * DM + lane * 4 + 256 * j);
        }
#pragma unroll
        for (int rr = 0; rr < 2; ++rr)
#pragma unroll
            for (int j = 0; j < 4; ++j) ss[rr] += yv[rr][j][0] * yv[rr][j][0] + yv[rr][j][1] * yv[rr][j][1] + yv[rr][j][2] * yv[rr][j][2] + yv[rr][j][3] * yv[rr][j][3];
        ss[0] = wave_sum(ss[0]); ss[1] = wave_sum(ss[1]);
        float ss2[2] = {0.f, 0.f};
#pragma unroll
        for (int rr = 0; rr < 2; ++rr) {
            const int row = rr ? row1 : row0; const float* md = p.mod + (row >> 13) * 6144;
            const float rs = rsqrtf(ss[rr] * (1.0f / 1024.0f) + RMS_EPS);
#pragma unroll
            for (int j = 0; j < 4; ++j) {
                const int col = lane * 4 + 256 * j;
                const f32x4 g = *(const f32x4*)(p.norm_g + 1024 + col), g1 = *(const f32x4*)(md + 2048 + col);
#pragma unroll
                for (int i = 0; i < 4; ++i) { xv[rr][j][i] = xv[rr][j][i] + g1[i] * (yv[rr][j][i] * rs * g[i]); ss2[rr] += xv[rr][j][i] * xv[rr][j][i]; }
                if (rr == 0 || has1) *(f32x4*)(p.out + (size_t)row * DM + col) = xv[rr][j];
            }
        }
        ss2[0] = wave_sum(ss2[0]); ss2[1] = wave_sum(ss2[1]);
#pragma unroll
        for (int rr = 0; rr < 2; ++rr) {
            const int row = rr ? row1 : row0; const float* md = p.mod + (row >> 13) * 6144;
            const float rs2 = rsqrtf(ss2[rr] * (1.0f / 1024.0f) + RMS_EPS);
            if (rr == 0 || has1) {
#pragma unroll
                for (int j = 0; j < 4; ++j) {
                    const int col = lane * 4 + 256 * j;
                    const f32x4 g = *(const f32x4*)(p.norm_g + 2048 + col), s2 = *(const f32x4*)(md + 4096 + col), h2 = *(const f32x4*)(md + 3072 + col);
                    float hv[4], lo[4];
#pragma unroll
                    for (int i = 0; i < 4; ++i) { hv[i] = xv[rr][j][i] * rs2 * g[i] * (1.0f + s2[i]) + h2[i]; lo[i] = hv[i] - bf2f(f2bf(hv[i])); }
                    u32x2 uh, ul; uh.x = cvt_pk_bf16(hv[0], hv[1]); uh.y = cvt_pk_bf16(hv[2], hv[3]); ul.x = cvt_pk_bf16(lo[0], lo[1]); ul.y = cvt_pk_bf16(lo[2], lo[3]);
                    *(u32x2*)(p.hhi + (size_t)row * DM + col) = uh; *(u32x2*)(p.hlo + (size_t)row * DM + col) = ul;
                }
            }
        }
    }
    xcd_barrier(bar);
    }
    STOP_AT(6);

    for (int rep_ = 0; rep_ < REPS(7); ++rep_) {
    const int tid = ltid(), lane = tid & 63, w = tid >> 6; (void)lane; (void)w;
    for (int u = bid; u < 256; u += nb) {
        const int nt = u / 128, mt = u % 128;
        __syncthreads();
        if (tid < 128) ((int*)(lm + G_ROWOFF))[tid] = (mt * 128 + tid) * DM;
        __syncthreads();
        ASrcRouter as; as.hi = p.hhi; as.lo = p.hlo;
        BLqRouter bl; bl.wt = p.wT + (size_t)(2944 + 1024 + nt * 128) * 1024;
        EpiF32<2> ep; ep.o = p.logits; ep.ldo = 256; ep.row0 = mt * 128; ep.col0 = nt * 128;
        gemm_big<1, true, 4, ASrcRouter, BLqRouter, EpiF32<2>, 4, true>(lm, 48, 1, as, bl, ep);
    }
    xcd_barrier(bar);
    }
    STOP_AT(7);

    {
    const int tid = ltid(), lane = tid & 63, w = tid >> 6; (void)lane; (void)w;
    for (int tok = bid * 8 + w; tok < T_TOK; tok += nb * 8) {
        const f32x4 lg = *(const f32x4*)(p.logits + (size_t)tok * 256 + lane * 4);
        const f32x4 rb = *(const f32x4*)(p.router_bias + lane * 4);
        float aff[4], ch[4];
#pragma unroll
        for (int i = 0; i < 4; ++i) { aff[i] = 1.0f / (1.0f + __expf(-lg[i])); ch[i] = aff[i] + rb[i]; }
        float m1 = fmaxf(ch[0], ch[1]), m2 = fminf(ch[0], ch[1]);
#pragma unroll
        for (int i = 2; i < 4; ++i) { const float v = ch[i]; if (v > m1) { m2 = m1; m1 = v; } else if (v > m2) m2 = v; }
#pragma unroll
        for (int o = 1; o <= 4; o <<= 1) {
            const float o1 = __shfl_xor(m1, o), o2 = __shfl_xor(m2, o);
            const float n1 = fmaxf(m1, o1), n2 = fmaxf(fminf(m1, o1), fmaxf(m2, o2));
            m1 = n1; m2 = n2;
        }
        const float gs = m1 + m2; const int grp = lane >> 3;
        int rank = 0;
#pragma unroll
        for (int g2 = 0; g2 < 8; ++g2) { const float og = __shfl(gs, g2 * 8); if (og > gs || (og == gs && g2 < grp)) ++rank; }
        const bool gsel = rank < 4;
#pragma unroll
        for (int i = 0; i < 4; ++i) if (!gsel) ch[i] = -INFINITY;
        int myidx = -1; float myaff = 0.f, asum = 0.f;
        for (int it = 0; it < 8; ++it) {
            float bv = ch[0]; int bi = lane * 4;
#pragma unroll
            for (int i = 1; i < 4; ++i) if (ch[i] > bv) { bv = ch[i]; bi = lane * 4 + i; }
#pragma unroll
            for (int o = 32; o >= 1; o >>= 1) {
                const float ov = __shfl_xor(bv, o); const int oi = __shfl_xor(bi, o);
                if (ov > bv || (ov == bv && oi < bi)) { bv = ov; bi = oi; }
            }
            bi = __builtin_amdgcn_readfirstlane(bi);
            float av = 0.f;
            if ((bi >> 2) == lane) {
#pragma unroll
                for (int i = 0; i < 4; ++i) if ((bi & 3) == i) { av = aff[i]; ch[i] = -INFINITY; }
            }
            av = __shfl(av, bi >> 2);
            asum += av;
            if (lane == it) { myidx = bi; myaff = av; }
        }
        if (lane < 8) {
            const float wt = myaff / asum * 2.5f;
            const unsigned pos = atomicAdd(p.ctrl + CT_CNT + myidx, 1u);
            uint2 en; en.x = (unsigned)(tok * 9 + lane); en.y = __float_as_uint(wt);
            if (pos < (unsigned)CAP) p.bucket[(size_t)myidx * CAP + pos] = en;
        }
    }
    }
    xcd_barrier(bar);
    STOP_AT(8);

    for (int rep_ = 0; rep_ < REPS(9); ++rep_) {
    const int tid = ltid(), lane = tid & 63, w = tid >> 6; (void)lane; (void)w;
    moe_phase<1>(p, lds, xcc, rep_);
    xcd_barrier(bar);
    }
    STOP_AT(9);
    for (int rep_ = 0; rep_ < REPS(10); ++rep_) {
    moe_down_phase(p, lds, xcc, rep_);
    xcd_barrier(bar);
    }
    STOP_AT(10);

    {
    const int tid = ltid(), lane = tid & 63, w = tid >> 6; (void)lane; (void)w;
    for (int row = bid * 8 + w; row < T_TOK; row += nb * 8) {
        const int bb = row >> 13; const float* md = p.mod + bb * 6144;
        float acc[16];
#pragma unroll
        for (int i = 0; i < 16; ++i) acc[i] = 0.f;
        const bf16_t* sp = p.yslot + (size_t)row * 9 * 1024;
        for (int k = 0; k < 9; ++k) {
#pragma unroll
            for (int j = 0; j < 2; ++j) {
                const u32x4 v = *(const u32x4*)(sp + (size_t)k * 1024 + lane * 8 + 512 * j);
                acc[8 * j + 0] += bflo(v.x); acc[8 * j + 1] += bfhi(v.x); acc[8 * j + 2] += bflo(v.y); acc[8 * j + 3] += bfhi(v.y);
                acc[8 * j + 4] += bflo(v.z); acc[8 * j + 5] += bfhi(v.z); acc[8 * j + 6] += bflo(v.w); acc[8 * j + 7] += bfhi(v.w);
            }
        }
        float ss = 0.f;
#pragma unroll
        for (int i = 0; i < 16; ++i) ss += acc[i] * acc[i];
        ss = wave_sum(ss);
        const float rs = rsqrtf(ss * (1.0f / 1024.0f) + RMS_EPS);
#pragma unroll
        for (int j = 0; j < 2; ++j)
#pragma unroll
            for (int hf = 0; hf < 2; ++hf) {
                const int col = lane * 8 + 512 * j + 4 * hf;
                const f32x4 g = *(const f32x4*)(p.norm_g + 3072 + col), g2 = *(const f32x4*)(md + 5120 + col);
                f32x4 x1 = *(const f32x4*)(p.out + (size_t)row * DM + col);
#pragma unroll
                for (int i = 0; i < 4; ++i) x1[i] += g2[i] * (acc[8 * j + 4 * hf + i] * rs * g[i]);
                *(f32x4*)(p.out + (size_t)row * DM + col) = x1;
            }
    }
    }
}

static inline size_t al256(size_t v) { return (v + 255) & ~(size_t)255; }

extern "C" void kernel_launch(void* const* d_in, const int* in_sizes, int n_in, void* d_out, int out_size, void* d_ws, size_t ws_size, hipStream_t stream) {
    (void)in_sizes; (void)n_in; (void)out_size;
    Params p{};
    p.x = (const float*)d_in[0]; p.c = (const float*)d_in[1]; p.w_ada = (const float*)d_in[2]; p.b_ada = (const float*)d_in[3];
    p.norm_g = (const float*)d_in[4]; p.w_in = (const float*)d_in[5]; p.w_cmp1 = (const float*)d_in[6]; p.w_cmp2 = (const float*)d_in[7];
    p.pe_cmp = (const float*)d_in[8]; p.diff_lambda = (const float*)d_in[9]; p.diff_subln = (const float*)d_in[10]; p.w_out = (const float*)d_in[11];
    p.w_router = (const float*)d_in[12]; p.router_bias = (const float*)d_in[13]; p.w_gate_up = (const float*)d_in[14]; p.w_down = (const float*)d_in[15];
    p.ws_gate_up = (const float*)d_in[16]; p.ws_down = (const float*)d_in[17];
    p.out = (float*)d_out;
    char* ws = (char*)d_ws; size_t off = 0;
    auto take = [&](size_t bytes) { char* r = ws + off; off = al256(off + bytes); return r; };
    p.ctrl = (unsigned*)take((size_t)CT_WORDS * 4);
    p.mod = (float*)take(2 * 6144 * 4);
    p.misc = (float*)take((1024 + 256 * 64) * 4);
    p.wT = (bf16_t*)take((size_t)(2944 + 1024 + 512) * 1024 * 2);
    p.hmix = (bf16_t*)take((size_t)T_TOK * DM * 2);
    p.proj = (bf16_t*)take((size_t)T_TOK * LD * 2);
    p.vselT = (bf16_t*)take((size_t)256 * SEQ * 2);
    p.vwinT = (bf16_t*)take((size_t)256 * SEQ * 2);
    p.dvT = (bf16_t*)take((size_t)1024 * SEQ * 2);
    p.kc = (bf16_t*)take((size_t)4 * 512 * 64 * 2);
    p.vcT = (bf16_t*)take((size_t)4 * 64 * 512 * 2);
    p.ocat = (bf16_t*)take((size_t)T_TOK * DM * 2);
    p.y = (float*)take((size_t)T_TOK * DM * 4);
    p.hhi = (bf16_t*)take((size_t)T_TOK * DM * 2);
    p.hlo = (bf16_t*)take((size_t)T_TOK * DM * 2);
    p.logits = (float*)take((size_t)T_TOK * 256 * 4);
    p.bucket = (uint2*)take((size_t)NEXP * CAP * 8);
    p.H = (bf16_t*)take((size_t)T_TOK * 9 * 256 * 2);
    p.yslot = (bf16_t*)take((size_t)T_TOK * 9 * 1024 * 2);

    if (ws_size < off) { fprintf(stderr, "workspace too small: %zu < %zu\n", ws_size, off); return; }
    static int grid = 0;
    if (!grid) {
        int dev = 0, cus = 0, per_cu = 0;
        hipGetDevice(&dev);
        hipDeviceGetAttribute(&cus, hipDeviceAttributeMultiprocessorCount, dev);
        hipFuncSetAttribute((const void*)fwd_kernel, hipFuncAttributeMaxDynamicSharedMemorySize, LDS_BYTES);
        hipOccupancyMaxActiveBlocksPerMultiprocessor(&per_cu, fwd_kernel, 512, LDS_BYTES);
        if (per_cu < 1) fprintf(stderr, "occupancy query says the kernel does not fit\n");
        grid = cus > 0 ? cus : 256;
    }
    hipMemsetAsync(p.ctrl, 0, (size_t)CT_WORDS * 4, stream);
    hipLaunchKernelGGL(fwd_kernel, dim3(grid), dim3(512), LDS_BYTES, stream, p);
}
```

```cpp
#include <hip/hip_runtime.h>
#include <stdint.h>
#include <stdio.h>
#ifndef PROBE_PH
#define PROBE_PH -1
#endif
#define REPS(k) ((PROBE_PH == (k)) ? 2 : 1)
#ifndef AMP_PH
#define AMP_PH -1
#endif
#define AMP_MUL 1

typedef unsigned short bf16_t;
typedef short bf16x8 __attribute__((ext_vector_type(8)));
typedef short bf16x4 __attribute__((ext_vector_type(4)));
typedef float f32x4 __attribute__((ext_vector_type(4)));
typedef float f32x16 __attribute__((ext_vector_type(16)));
typedef unsigned u32x4 __attribute__((ext_vector_type(4)));
typedef unsigned u32x2 __attribute__((ext_vector_type(2)));

#define DEV __device__ __forceinline__

constexpr int T_TOK = 16384, SEQ = 8192, DM = 1024;
constexpr int LD = 2944;
constexpr int QOFF = 0, KCOFF = 512, VCOFF = 640, KSOFF = 768, VSOFF = 896, KWOFF = 1024, VWOFF = 1152,
              DQOFF = 1280, DKOFF = 1792, DVOFF = 2304, GTOFF = 2816;
constexpr int NEXP = 256, CAP = 16384;
constexpr float LOG2E = 1.4426950408889634f;
constexpr float RMS_EPS = 1e-6f;
DEV int swz(int row, int chunk) { return row * 128 + ((chunk ^ ((row >> 1) & 7)) << 4); }

typedef __bf16 bf16v2_t __attribute__((ext_vector_type(2)));
DEV unsigned cvt_pk_bf16(float lo, float hi) { bf16v2_t v; v[0] = (__bf16)lo; v[1] = (__bf16)hi; return __builtin_bit_cast(unsigned, v); }
DEV bf16_t f2bf(float f) { unsigned u = __float_as_uint(f); u += 0x7FFFu + ((u >> 16) & 1u); return (bf16_t)(u >> 16); }
DEV float bf2f(bf16_t b) { return __uint_as_float(((unsigned)b) << 16); }
DEV float bflo(unsigned w) { return __uint_as_float(w << 16); }
DEV float bfhi(unsigned w) { return __uint_as_float(w & 0xffff0000u); }
DEV float fexp2(float x) { return __builtin_amdgcn_exp2f(x); }
DEV float sigmoidf_(float x) { return 1.0f / (1.0f + __expf(-x)); }
DEV int ltid() { int t = threadIdx.x; asm volatile("" : "+v"(t)); return t; }
template <int CTRL> DEV float dppf(float v) { return __builtin_bit_cast(float, __builtin_amdgcn_update_dpp(0, __builtin_bit_cast(int, v), CTRL, 0xF, 0xF, true)); }
DEV float wave_max_dpp(float v) {
    v = fmaxf(v, dppf<0xB1>(v)); v = fmaxf(v, dppf<0x4E>(v)); v = fmaxf(v, dppf<0x141>(v)); v = fmaxf(v, dppf<0x140>(v));
    const float a = __builtin_bit_cast(float, __builtin_amdgcn_readlane(__builtin_bit_cast(int, v), 0)), b = __builtin_bit_cast(float, __builtin_amdgcn_readlane(__builtin_bit_cast(int, v), 16));
    const float c = __builtin_bit_cast(float, __builtin_amdgcn_readlane(__builtin_bit_cast(int, v), 32)), d = __builtin_bit_cast(float, __builtin_amdgcn_readlane(__builtin_bit_cast(int, v), 48));
    return fmaxf(fmaxf(a, b), fmaxf(c, d));
}
DEV int crow(int r, int hi) { return (r & 3) + 8 * (r >> 2) + 4 * hi; }
DEV float wave_sum(float v) {
#pragma unroll
    for (int o = 32; o >= 1; o >>= 1) v += __shfl_xor(v, o);
    return v;
}

#define XB_TMO      128
#define XB_XCNT(j)  (256  + 64 * (j))
#define XB_XSUB(j)  (1280 + 64 * (j))
#define XB_XGEN(j)  (2304 + 64 * (j))
#define XB_TOP      3328
#define XB_TOPGEN   3392
#define XCD_BAR_WORDS 3456
#define XB_SPIN_CAP (1u << 20)
#define LAS __attribute__((address_space(3)))

__device__ __forceinline__ unsigned xb_ld(unsigned* p)              { return __hip_atomic_load(p, __ATOMIC_RELAXED, __HIP_MEMORY_SCOPE_AGENT); }
__device__ __forceinline__ unsigned xb_add(unsigned* p, unsigned v) { return __hip_atomic_fetch_add(p, v, __ATOMIC_RELAXED, __HIP_MEMORY_SCOPE_AGENT); }
__device__ __forceinline__ unsigned xb_xcc_id() { return (unsigned)__builtin_amdgcn_s_getreg((3 << 11) | 20) & 0xFu; }
#define XB_SPIN(cond, bar) do { unsigned _sp = 0; while (cond) { __builtin_amdgcn_s_sleep(1); \
    if ((++_sp & 255u) == 0u) { if (xb_ld(&(bar)[XB_TMO])) break; if (_sp > XB_SPIN_CAP) { atomicAdd(&(bar)[XB_TMO], 1u); break; } } } } while (0)

struct XcdBarrier {
    unsigned* bar; unsigned x;
    volatile LAS unsigned* st;
};
__device__ __forceinline__ XcdBarrier xcd_barrier_post(unsigned* bar, volatile LAS unsigned* st) {
    XcdBarrier b; b.bar = bar; b.x = xb_xcc_id(); b.st = st;
    if (threadIdx.x == 0) (void)xb_add(&bar[XB_XCNT(b.x)], 1u);
    return b;
}
__device__ __forceinline__ void xcd_barrier_complete(unsigned* bar, unsigned x, unsigned& nloc, unsigned& nx) {
    const unsigned G = gridDim.x * gridDim.y * gridDim.z;
    unsigned sum, cnt, mine, sp = 0u;
    for (;;) {
        sum = 0u; cnt = 0u; mine = 0u;
#pragma unroll
        for (unsigned j = 0; j < 16; ++j) { const unsigned c = xb_ld(&bar[XB_XCNT(j)]); sum += c; cnt += (c > 0u) ? 1u : 0u; mine = (j == x) ? c : mine; }
        if (sum == G) break;
        __builtin_amdgcn_s_sleep(1);
        if ((++sp & 255u) == 0u) { if (xb_ld(&bar[XB_TMO])) break; if (sp > XB_SPIN_CAP) { atomicAdd(&bar[XB_TMO], 1u); break; } }
    }
    nloc = mine > 0u ? mine : 1u; nx = cnt > 0u ? cnt : 1u;
}
__device__ __forceinline__ void xcd_barrier(const XcdBarrier& b) {
    asm volatile("s_waitcnt vmcnt(0)" ::: "memory");
    __syncthreads();
    if (threadIdx.x == 0) {
        unsigned* bar = b.bar;
        __builtin_amdgcn_s_waitcnt(0);
        unsigned nloc = b.st[0], nx = b.st[1];
        if (nloc == 0u) { xcd_barrier_complete(bar, b.x, nloc, nx); b.st[0] = nloc; b.st[1] = nx; }
        const unsigned old = xb_add(&bar[XB_XSUB(b.x)], 1u);
        const unsigned gen = old / nloc;
        if (old + 1u == (gen + 1u) * nloc) {
            __builtin_amdgcn_fence(__ATOMIC_RELEASE, "agent");
            asm volatile("s_waitcnt vmcnt(0)" ::: "memory");
            const unsigned og = xb_add(&bar[XB_TOP], 1u);
            const unsigned tg = og / nx;
            if (og + 1u == (tg + 1u) * nx) xb_add(&bar[XB_TOPGEN], 1u);
            else XB_SPIN(xb_ld(&bar[XB_TOPGEN]) == tg, bar);
            __builtin_amdgcn_fence(__ATOMIC_ACQUIRE, "agent");
            xb_add(&bar[XB_XGEN(b.x)], 1u);
            asm volatile("s_waitcnt vmcnt(0)" ::: "memory");
        } else {
            XB_SPIN(xb_ld(&bar[XB_XGEN(b.x)]) == gen, bar);
            __builtin_amdgcn_fence(__ATOMIC_ACQUIRE, "agent");
            asm volatile("s_waitcnt vmcnt(0)" ::: "memory");
        }
    }
    __syncthreads();
}

struct Params {
    const float *x, *c, *w_ada, *b_ada, *norm_g, *w_in, *w_cmp1, *w_cmp2, *pe_cmp, *diff_lambda, *diff_subln,
                *w_out, *w_router, *router_bias, *w_gate_up, *w_down, *ws_gate_up, *ws_down;
    float* out;
    unsigned* ctrl;
    float* mod;
    float* misc;
    bf16_t* wT;
    bf16_t* hmix;
    bf16_t* proj;
    bf16_t* vselT;
    bf16_t* vwinT;
    bf16_t* dvT;
    bf16_t* kc;
    bf16_t* vcT;
    bf16_t* ocat;
    float* y;
    bf16_t* hhi;
    bf16_t* hlo;
    float* logits;
    uint2* bucket;
    uint2* asg;
    int* bh;
    bf16_t* H;
    bf16_t* yslot;
};
constexpr int CT_Q = 4096;
constexpr int CT_CNT = 8192;
constexpr int CT_KMAX = 12288;
constexpr int CT_WORDS = 16384;

constexpr int L_CTRL = 0;
constexpr int L_MAIN = 64;
constexpr int LDS_BYTES = 64 + 131072 + 18432 + 4096;

constexpr int G_AS = 0, G_ASZ = 49152, G_BS = 98304, G_BSZ = 16384, G_ROWOFF = 131072, G_RSLOT = 133120, G_RWT = 135168, G_PRE = 137216;
#ifndef PROBE_VAR
#define PROBE_VAR 0
#endif
template <int MS, bool TRANS, int PD, class AS, class BL, class EP, int PDB = PD, bool BF = false>
DEV void gemm_big(char* lm, int nk, int nsub, const AS& as, const BL& bl, const EP& ep, int pvar = 0) {
    static_assert(PDB % PD == 0, "the B ring depth must be a multiple of the A ring depth");
    const int tid = ltid(), lane = tid & 63, w = tid >> 6, wm = w >> 1, wn = w & 1, c = lane & 15, q = lane >> 4;
    const int* rowoff = (const int*)(lm + G_ROWOFF);
    const int ar0 = tid >> 3, akc = tid & 7;
    const int bn4 = 8 * (w & 3) + (lane & 7), bkq = 8 * (w >> 2) + (lane >> 3);
    const int rowlim = 128 * nsub;
    u32x4 ra[PD][2 * MS]; f32x4 rb[BF ? 1 : PDB][4]; u32x4 rq[BF ? PDB : 1][2];
    f32x4 acc[2 * MS][4];
#pragma unroll
    for (int mi = 0; mi < 2 * MS; ++mi)
#pragma unroll
        for (int ni = 0; ni < 4; ++ni) acc[mi][ni] = (f32x4){0.f, 0.f, 0.f, 0.f};
#define GB_LOADA(s_, ks_) do { \
        _Pragma("unroll") for (int i = 0; i < 2 * MS; ++i) if ((i >> 1) < nsub) ra[s_][i] = as.ld(rowoff[ar0 + 64 * i] + akc * 8, (ks_)); } while (0)
#define GB_LOADB(s_, ks_) do { if constexpr (BF) { rq[s_][0] = bl.ldq(ar0, (ks_), akc); rq[s_][1] = bl.ldq(ar0 + 64, (ks_), akc); } else { \
        _Pragma("unroll") for (int i = 0; i < 4; ++i) rb[s_][i] = bl.ld((ks_) * 64 + 4 * bkq + i, 4 * bn4); } } while (0)
#define GB_STORE(sa_, sb_, buf_) do { char* As_ = lm + G_AS + (buf_) * G_ASZ; char* Bs_ = lm + G_BS + (buf_) * G_BSZ; \
        _Pragma("unroll") for (int i = 0; i < 2 * MS; ++i) if ((i >> 1) < nsub) *(u32x4*)(As_ + swz(ar0 + 64 * i, akc)) = ra[sa_][i]; \
        if constexpr (BF) { *(u32x4*)(Bs_ + swz(ar0, akc)) = rq[sb_][0]; *(u32x4*)(Bs_ + swz(ar0 + 64, akc)) = rq[sb_][1]; } else { \
        _Pragma("unroll") for (int cc = 0; cc < 4; ++cc) { u32x2 v; v.x = cvt_pk_bf16(rb[sb_][0][cc], rb[sb_][1][cc]); v.y = cvt_pk_bf16(rb[sb_][2][cc], rb[sb_][3][cc]); \
            *(u32x2*)(Bs_ + swz(4 * bn4 + cc, bkq >> 1) + (bkq & 1) * 8) = v; } } } while (0)
#pragma unroll
    for (int s = 0; s < PD; ++s) {
#pragma unroll
        for (int i = 0; i < 2 * MS; ++i) ra[s][i] = (u32x4){0u, 0u, 0u, 0u};
        if (s < nk) GB_LOADA(s, s);
    }
#pragma unroll
    for (int s = 0; s < PDB; ++s) {
        if constexpr (BF) { rq[s][0] = (u32x4){0u, 0u, 0u, 0u}; rq[s][1] = (u32x4){0u, 0u, 0u, 0u}; }
        else {
#pragma unroll
            for (int i = 0; i < 4; ++i) rb[s][i] = (f32x4){0.f, 0.f, 0.f, 0.f};
        }
        if (s < nk) GB_LOADB(s, s);
    }
    __syncthreads();
    GB_STORE(0, 0, 0);
    if (PD < nk) GB_LOADA(0, PD);
    if (PDB < nk) GB_LOADB(0, PDB);
    __syncthreads();
    for (int ks0 = 0; ks0 < nk; ks0 += PDB) {
#pragma unroll
        for (int s = 0; s < PDB; ++s) {
            const int ks = ks0 + s;
            if (ks < nk) {
                const int sna = (s + 1) % PD, snb = (s + 1) % PDB;
                const char* As = lm + G_AS + (ks & 1) * G_ASZ; const char* Bs = lm + G_BS + (ks & 1) * G_BSZ;
#define GB_STAGE() do { if (ks + 1 < nk && pvar != 3) { GB_STORE(sna, snb, (ks + 1) & 1); \
                    if (pvar != 2) { if (ks + 1 + PD < nk) GB_LOADA(sna, ks + 1 + PD); if (ks + 1 + PDB < nk) GB_LOADB(snb, ks + 1 + PDB); } } } while (0)
#define GB_COMPUTE() do { if (pvar != 1 && pvar != 3) { \
                  \
                bf16x8 bq[2][4]; bf16x8 af[4 * MS]; \
                _Pragma("unroll") for (int ni = 0; ni < 4; ++ni) bq[0][ni] = *(const bf16x8*)(Bs + swz(64 * wn + 16 * ni + c, q)); \
                af[0] = *(const bf16x8*)(As + swz(32 * MS * wm + c, q)); \
                af[1] = *(const bf16x8*)(As + swz(32 * MS * wm + 16 + c, q)); \
                __builtin_amdgcn_sched_barrier(0); \
                _Pragma("unroll") for (int g = 0; g < 4 * MS; ++g) { \
                    const int kk = g / (2 * MS), mi = g % (2 * MS); \
                    if (g + 2 < 4 * MS) { const int kk2 = (g + 2) / (2 * MS), mi2 = (g + 2) % (2 * MS); af[g + 2] = *(const bf16x8*)(As + swz(32 * MS * wm + 16 * mi2 + c, 4 * kk2 + q)); } \
                    if (kk == 0 && mi < 2) { bq[1][2 * mi] = *(const bf16x8*)(Bs + swz(64 * wn + 16 * (2 * mi) + c, 4 + q)); bq[1][2 * mi + 1] = *(const bf16x8*)(Bs + swz(64 * wn + 16 * (2 * mi + 1) + c, 4 + q)); } \
                    if (32 * MS * wm + 16 * mi < rowlim) { \
                        _Pragma("unroll") for (int ni = 0; ni < 4; ++ni) \
                            acc[mi][ni] = TRANS ? __builtin_amdgcn_mfma_f32_16x16x32_bf16(bq[kk][ni], af[g], acc[mi][ni], 0, 0, 0) \
                                                : __builtin_amdgcn_mfma_f32_16x16x32_bf16(af[g], bq[kk][ni], acc[mi][ni], 0, 0, 0); \
                    } \
                    __builtin_amdgcn_sched_barrier(0); \
                } } } while (0)
                if (w < 4) { GB_STAGE(); GB_COMPUTE(); } else { GB_COMPUTE(); GB_STAGE(); }
#undef GB_STAGE
#undef GB_COMPUTE
                __syncthreads();
            }
        }
    }
#undef GB_LOADA
#undef GB_LOADB
#undef GB_STORE
    ep(acc, 32 * MS * wm, 64 * wn, rowlim, c, q);
}

struct ASrcPlain { const bf16_t* base; DEV u32x4 ld(int off, int ks) const { return *(const u32x4*)(base + off + ks * 64); } };
struct ASrcRouter {
    const bf16_t *hi, *lo;
    DEV u32x4 ld(int off, int ks) const { const int seg = ks >> 4, kk = ks & 15; return *(const u32x4*)(((seg == 1) ? lo : hi) + off + kk * 64); }
};

DEV void store_vt_chunk(char* Vs, int row, int ch, const u32x4& v) {
    const int g2 = ch & ~1, e8 = (ch & 1) * 8;
    u32x2 lo; lo.x = v.x; lo.y = v.y; u32x2 hi; hi.x = v.z; hi.y = v.w;
    *(u32x2*)(Vs + swz(row, g2) + e8) = lo;
    *(u32x2*)(Vs + swz(row, g2 + 1) + e8) = hi;
}
DEV f32x16 qk32(const char* Ks, int kt, const bf16x8 (&qf)[4], int r, int hi) {
    f32x16 a;
#pragma unroll
    for (int i = 0; i < 16; ++i) a[i] = 0.f;
#pragma unroll
    for (int s = 0; s < 4; ++s) {
        const bf16x8 kf = *(const bf16x8*)(Ks + swz(32 * kt + r, 2 * s + hi));
        a = __builtin_amdgcn_mfma_f32_32x32x16_bf16(kf, qf[s], a, 0, 0, 0);
    }
    return a;
}
template <int NDT>
DEV void pv32(const char* Vs, int kt, const bf16x8 (&pf)[2], f32x16 (&O)[NDT], int r, int hi) {
#pragma unroll
    for (int s2 = 0; s2 < 2; ++s2)
#pragma unroll
        for (int dt = 0; dt < NDT; ++dt) {
            const bf16x8 vf = *(const bf16x8*)(Vs + swz(32 * dt + r, 4 * kt + 2 * s2 + hi));
            O[dt] = __builtin_amdgcn_mfma_f32_32x32x16_bf16(vf, pf[s2], O[dt], 0, 0, 0);
        }
}
template <int NDT>
DEV void vload(const char* Vs, int kt, bf16x8 (&vf)[2 * NDT], int r, int hi) {
#pragma unroll
    for (int s2 = 0; s2 < 2; ++s2)
#pragma unroll
        for (int dt = 0; dt < NDT; ++dt) vf[s2 * NDT + dt] = *(const bf16x8*)(Vs + swz(32 * dt + r, 4 * kt + 2 * s2 + hi));
}
template <int NDT>
DEV void pvmma(const bf16x8 (&vf)[2 * NDT], const bf16x8 (&pf)[2], f32x16 (&O)[NDT]) {
#pragma unroll
    for (int s2 = 0; s2 < 2; ++s2)
#pragma unroll
        for (int dt = 0; dt < NDT; ++dt) O[dt] = __builtin_amdgcn_mfma_f32_32x32x16_bf16(vf[s2 * NDT + dt], pf[s2], O[dt], 0, 0, 0);
}
DEV void pack_p(const float (&pv)[16], bf16x8 (&pf)[2]) {
#pragma unroll
    for (int s2 = 0; s2 < 2; ++s2) {
        u32x4 u;
        u.x = cvt_pk_bf16(pv[8 * s2 + 0], pv[8 * s2 + 1]); u.y = cvt_pk_bf16(pv[8 * s2 + 2], pv[8 * s2 + 3]);
        u.z = cvt_pk_bf16(pv[8 * s2 + 4], pv[8 * s2 + 5]); u.w = cvt_pk_bf16(pv[8 * s2 + 6], pv[8 * s2 + 7]);
        pf[s2] = __builtin_bit_cast(bf16x8, u);
    }
}
DEV float xhalf_max(float v) {
    auto rr = __builtin_amdgcn_permlane32_swap(__float_as_uint(v), __float_as_uint(v), false, false);
    return fmaxf(__uint_as_float(rr[0]), __uint_as_float(rr[1]));
}
DEV float rowmax16(const float (&s)[16]) {
    float a = fmaxf(fmaxf(s[0], s[1]), s[2]), b = fmaxf(fmaxf(s[3], s[4]), s[5]);
    a = fmaxf(fmaxf(a, s[6]), s[7]); b = fmaxf(fmaxf(b, s[8]), s[9]);
    a = fmaxf(fmaxf(a, s[10]), s[11]); b = fmaxf(fmaxf(b, s[12]), s[13]);
    a = fmaxf(fmaxf(a, s[14]), s[15]);
    return xhalf_max(fmaxf(a, b));
}
constexpr float OSM_THR = 8.0f;
template <int NDT>
DEV void osm_update(float (&s)[16], float& m, float& l, f32x16 (&O)[NDT]) {
    const float mx = rowmax16(s);
    if (__any(mx > m + OSM_THR)) {
        const float mn = fmaxf(m, mx);
        const float alpha = fexp2(m - mn);
        l *= alpha; m = mn;
#pragma unroll
        for (int dt = 0; dt < NDT; ++dt)
#pragma unroll
            for (int i = 0; i < 16; ++i) O[dt][i] *= alpha;
    }
    float sum = 0.f;
#pragma unroll
    for (int i = 0; i < 16; ++i) { s[i] = fexp2(s[i] - m); sum += s[i]; }
    l += sum;
}
template <int KS, bool WIN>
DEV void make_scores(const f32x16& a, float (&s)[16], int D0, float slope2, bool selb) {
    const float sc2 = 0.125f * LOG2E;
    const float nb0 = -slope2 * (float)D0, sk = slope2 * (float)KS;
#pragma unroll
    for (int i = 0; i < 16; ++i) s[i] = fmaf(sk, (float)((i & 3) + 8 * (i >> 2)), fmaf(a[i], sc2, nb0));
    if (__any(!selb || D0 < 27 * KS || (WIN && D0 >= 512))) {
#pragma unroll
        for (int i = 0; i < 16; ++i) {
            const int dist = D0 - KS * ((i & 3) + 8 * (i >> 2));
            const bool valid = selb && dist >= 0 && (!WIN || dist < 512);
            s[i] = valid ? s[i] : -INFINITY;
        }
    }
}
DEV int first_bit4(unsigned a, unsigned b, unsigned c, unsigned d, int from) {
    if (from < 32)  { const unsigned v = a & (0xffffffffu << from); if (v) return __builtin_ctz(v); from = 32; }
    if (from < 64)  { const unsigned v = b & (0xffffffffu << (from - 32)); if (v) return 32 + __builtin_ctz(v); from = 64; }
    if (from < 96)  { const unsigned v = c & (0xffffffffu << (from - 64)); if (v) return 64 + __builtin_ctz(v); from = 96; }
    if (from < 128) { const unsigned v = d & (0xffffffffu << (from - 96)); if (v) return 96 + __builtin_ctz(v); }
    return -1;
}
DEV unsigned range_mask32(int lo, int hi, int base) {
    int a = lo - base, b = hi - base; if (a < 0) a = 0; if (b > 31) b = 31; if (a > b) return 0u;
    const unsigned up = (b == 31) ? 0xffffffffu : ((1u << (b + 1)) - 1u);
    return up & (0xffffffffu << a);
}

template <int MODE>
DEV void nsa_tile(const char* Ks, const char* Vs, float* imp, int j, unsigned mk0, unsigned mk1, unsigned mk2, unsigned mk3,
                  const bf16x8 (&qf)[4], int t, int tl, float slope2, float& m, float& l, float inv, f32x16 (&O)[2], int r, int hi, float& carry) {
    bool selb = true;
    if (MODE == 2) { const unsigned wsel = (j < 32) ? mk0 : (j < 64) ? mk1 : (j < 96) ? mk2 : mk3; selb = (wsel >> (j & 31)) & 1u; }
    if (MODE == 2 && !__any(selb)) return;
#pragma unroll
    for (int kt = 0; kt < 2; ++kt) {
        const f32x16 a = qk32(Ks, kt, qf, r, hi);
        bf16x8 vf[4];
        if (MODE != 0) vload<2>(Vs, kt, vf, r, hi);
        float s[16];
        if (MODE <= 1) make_scores<16, false>(a, s, t - 31 - 16 * (64 * j + 32 * kt + 4 * hi), slope2, true);
        else if (MODE == 2) make_scores<1, false>(a, s, t - (64 * j + 32 * kt + 4 * hi), slope2, selb);
        else make_scores<1, true>(a, s, t - (64 * j + 32 * kt + 4 * hi), slope2, true);
        if (MODE == 0) {
            const float mx = rowmax16(s);
            if (__any(mx > m + OSM_THR)) { const float mn = fmaxf(m, mx); l *= fexp2(m - mn); m = mn; }
            float sum = 0.f;
#pragma unroll
            for (int i = 0; i < 16; ++i) sum += fexp2(s[i] - m);
            l += sum;
        } else if (MODE == 1) {
#pragma unroll
            for (int i = 0; i < 16; ++i) s[i] = fexp2(s[i] - m) * inv;
            {
                float av[4], hb[4];
#pragma unroll
                for (int gi = 0; gi < 4; ++gi) {
                    hb[gi] = 0.5f * s[4 * gi + 3]; av[gi] = s[4 * gi] + s[4 * gi + 1] + s[4 * gi + 2] + hb[gi];
                    av[gi] += __shfl_xor(av[gi], 8); av[gi] += __shfl_xor(av[gi], 16);
                    hb[gi] += __shfl_xor(hb[gi], 8); hb[gi] += __shfl_xor(hb[gi], 16);
                }
                float ph[4];
#pragma unroll
                for (int gi = 0; gi < 4; ++gi) ph[gi] = __shfl_xor(hb[gi], 32);
                float val[4];
#pragma unroll
                for (int gi = 0; gi < 4; ++gi) val[gi] = av[gi] + (hi ? ph[gi] : (gi ? ph[gi - 1] : carry));
                carry = ph[3];
                if ((r >> 3) == 0) {
                    float* ip = imp + tl * 129 + 16 * j + 8 * kt + hi;
#pragma unroll
                    for (int gi = 0; gi < 4; ++gi) ip[2 * gi] = val[gi];
                }
            }
            bf16x8 pf[2]; pack_p(s, pf); pvmma<2>(vf, pf, O);
        } else {
            osm_update<2>(s, m, l, O);
            bf16x8 pf[2]; pack_p(s, pf); pvmma<2>(vf, pf, O);
        }
    }
}

template <int MODE>
DEV void nsa_branch(char* Ks, char* Vs, float* imp, const bf16_t* kbase, int kld, const bf16_t* vbase, int vld,
                    unsigned tm0, unsigned tm1, unsigned tm2, unsigned tm3, unsigned mk0, unsigned mk1, unsigned mk2, unsigned mk3,
                    const bf16x8 (&qf)[4], int t, int tl, float slope2, float& m, float& l, float inv, f32x16 (&O)[2]) {
    const int tid = ltid(), lane = tid & 63, r = lane & 31, hi = lane >> 5, krow = tid >> 3, kch = tid & 7;
    const u32x4 z4 = (u32x4){0u, 0u, 0u, 0u};
    u32x4 rkA = z4, rvA = z4, rkB = z4, rvB = z4, rkC = z4, rvC = z4; int jA, jB, jC;
    float carry = 0.f;
    int jn = first_bit4(tm0, tm1, tm2, tm3, 0);
#define NSA_LDT(rk, rv, jr) do { jr = jn; if (jn >= 0) { \
        rk = *(const u32x4*)(kbase + (size_t)(64 * jn + krow) * kld + kch * 8); \
        if (MODE != 0) rv = *(const u32x4*)(vbase + (size_t)krow * vld + 64 * jn + kch * 8); \
        jn = first_bit4(tm0, tm1, tm2, tm3, jn + 1); } } while (0)
#define NSA_STEP(rk, rv, jr) do { const int j = jr; \
        __syncthreads(); \
        *(u32x4*)(Ks + swz(krow, kch)) = rk; \
        if (MODE != 0) store_vt_chunk(Vs, krow, kch, rv); \
        __syncthreads(); \
        NSA_LDT(rk, rv, jr); \
        nsa_tile<MODE>(Ks, Vs, imp, j, mk0, mk1, mk2, mk3, qf, t, tl, slope2, m, l, inv, O, r, hi, carry); } while (0)
    NSA_LDT(rkA, rvA, jA); NSA_LDT(rkB, rvB, jB); NSA_LDT(rkC, rvC, jC);
    for (;;) {
        if (jA < 0) break; NSA_STEP(rkA, rvA, jA);
        if (jB < 0) break; NSA_STEP(rkB, rvB, jB);
        if (jC < 0) break; NSA_STEP(rkC, rvC, jC);
    }
#undef NSA_LDT
#undef NSA_STEP
}

constexpr int N_KS = 0, N_VS = 9216, N_IMP = 18432, N_SEL = N_IMP + 64 * 129 * 4  , N_UNI = N_SEL + 1024, N_OUT = 52736;

DEV void nsa_unit(const Params& p, char* lm, int b, int g, int qb, int pv = 0) {
    const int tid = ltid(), lane = tid & 63, w = tid >> 6, r = lane & 31, hi = lane >> 5, hh = r >> 3;
    const int head = g * 4 + hh, tl = 8 * w + (r & 7), t = 64 * qb + tl;
    const size_t row = (size_t)b * SEQ + t;
    const float slope2 = LOG2E / (float)(2 << head);
    char* Ks = lm + N_KS; char* Vs = lm + N_VS; float* imp = (float*)(lm + N_IMP);
    unsigned* selm = (unsigned*)(lm + N_SEL); unsigned* uni = (unsigned*)(lm + N_UNI);
    __syncthreads();
    for (int i = tid; i < 64 * 129; i += 512) imp[i] = 0.f;
    if (tid < 4) uni[tid] = 0u;
    const bf16_t* prow = p.proj + row * LD;
    bf16x8 qf[4];
#pragma unroll
    for (int s = 0; s < 4; ++s) qf[s] = *(const bf16x8*)(prow + QOFF + head * 64 + 16 * s + 8 * hi);
    float gt[3];
#pragma unroll
    for (int c3 = 0; c3 < 3; ++c3) gt[c3] = sigmoidf_(bf2f(prow[GTOFF + head * 3 + c3]));
    float* outl = (float*)(lm + N_OUT) + tid;
    f32x16 O[2];
#pragma unroll
    for (int dt = 0; dt < 2; ++dt)
#pragma unroll
        for (int i = 0; i < 16; ++i) O[dt][i] = 0.f;

    {
        int ncmp = 4 * qb + 3; if (ncmp > 511) ncmp = 511;
        const int ntc = (ncmp + 63) >> 6;
        const unsigned tm0 = (1u << ntc) - 1u;
        const bf16_t* kb = p.kc + (size_t)((b * 2 + g) * 512) * 64;
        const bf16_t* vb = p.vcT + (size_t)((b * 2 + g) * 64) * 512;
        float m = -1e30f, l = 0.f;
        if (pv != 21) nsa_branch<0>(Ks, Vs, imp, kb, 64, vb, 512, tm0, 0u, 0u, 0u, 0u, 0u, 0u, 0u, qf, t, tl, slope2, m, l, 0.f, O);
        const float lt = l + __shfl_xor(l, 32);
        const float inv = 1.0f / fmaxf(lt, 1e-30f);
        if (pv != 21 && pv != 24) nsa_branch<1>(Ks, Vs, imp, kb, 64, vb, 512, tm0, 0u, 0u, 0u, 0u, 0u, 0u, 0u, qf, t, tl, slope2, m, l, inv, O);
#pragma unroll
        for (int dt = 0; dt < 2; ++dt)
#pragma unroll
            for (int i = 0; i < 16; ++i) { outl[(16 * dt + i) * 512] = gt[0] * O[dt][i]; O[dt][i] = 0.f; }
    }
    __syncthreads();
    if (qb + 1 <= 16) {
        if (tid < 64) { const unsigned s0 = range_mask32(0, qb, 0); selm[tid * 4 + 0] = s0; selm[tid * 4 + 1] = 0u; selm[tid * 4 + 2] = 0u; selm[tid * 4 + 3] = 0u; }
        if (tid == 0) uni[0] = range_mask32(0, qb, 0);
    } else {
        if (tid < 64) { imp[tid * 129] += 1e4f; imp[tid * 129 + qb] += 1e4f; imp[tid * 129 + qb - 1] += 1e4f; }
        if (tid < 256) selm[tid] = 0u;
        __syncthreads();
        const int tok = tid >> 3, j0 = tid & 7;
        float vj[16]; int rk[16];
#pragma unroll
        for (int jj = 0; jj < 16; ++jj) { const int j = j0 + 8 * jj; vj[jj] = (j <= qb) ? imp[tok * 129 + j] : -INFINITY; rk[jj] = 0; }
        for (int k = 0; k <= qb; ++k) {
            const float vk = imp[tok * 129 + k];
#pragma unroll
            for (int jj = 0; jj < 16; ++jj) { const int j = j0 + 8 * jj; rk[jj] += ((vk > vj[jj]) || (vk == vj[jj] && k < j)) ? 1 : 0; }
        }
        unsigned s0 = 0u, s1 = 0u, s2 = 0u, s3 = 0u;
#pragma unroll
        for (int jj = 0; jj < 16; ++jj) {
            const int j = j0 + 8 * jj;
            if (j <= qb && rk[jj] < 16) { const unsigned bit = 1u << (j & 31); if (jj < 4) s0 |= bit; else if (jj < 8) s1 |= bit; else if (jj < 12) s2 |= bit; else s3 |= bit; }
        }
        if (s0) { atomicOr(&selm[tok * 4 + 0], s0); atomicOr(&uni[0], s0); }
        if (s1) { atomicOr(&selm[tok * 4 + 1], s1); atomicOr(&uni[1], s1); }
        if (s2) { atomicOr(&selm[tok * 4 + 2], s2); atomicOr(&uni[2], s2); }
        if (s3) { atomicOr(&selm[tok * 4 + 3], s3); atomicOr(&uni[3], s3); }
    }
    __syncthreads();
    {
        const unsigned u0 = uni[0], u1 = uni[1], u2 = uni[2], u3 = uni[3];
        const unsigned mk0 = selm[tl * 4 + 0], mk1 = selm[tl * 4 + 1], mk2 = selm[tl * 4 + 2], mk3 = selm[tl * 4 + 3];
        const bf16_t* kb = p.proj + (size_t)b * SEQ * LD + KSOFF + g * 64;
        const bf16_t* vb = p.vselT + (size_t)(b * 128 + g * 64) * SEQ;
        float m = -1e30f, l = 0.f;
        if (pv != 22) nsa_branch<2>(Ks, Vs, imp, kb, LD, vb, SEQ, u0, u1, u2, u3, mk0, mk1, mk2, mk3, qf, t, tl, slope2, m, l, 0.f, O);
        const float lt = l + __shfl_xor(l, 32);
        const float sc = gt[1] / fmaxf(lt, 1e-30f);
#pragma unroll
        for (int dt = 0; dt < 2; ++dt)
#pragma unroll
            for (int i = 0; i < 16; ++i) { outl[(16 * dt + i) * 512] += sc * O[dt][i]; O[dt][i] = 0.f; }
    }
    {
        const int jlo = qb - 8 < 0 ? 0 : qb - 8;
        const unsigned w0 = range_mask32(jlo, qb, 0), w1 = range_mask32(jlo, qb, 32), w2 = range_mask32(jlo, qb, 64), w3 = range_mask32(jlo, qb, 96);
        const bf16_t* kb = p.proj + (size_t)b * SEQ * LD + KWOFF + g * 64;
        const bf16_t* vb = p.vwinT + (size_t)(b * 128 + g * 64) * SEQ;
        float m = -1e30f, l = 0.f;
        if (pv != 23) nsa_branch<3>(Ks, Vs, imp, kb, LD, vb, SEQ, w0, w1, w2, w3, 0u, 0u, 0u, 0u, qf, t, tl, slope2, m, l, 0.f, O);
        const float lt = l + __shfl_xor(l, 32);
        const float sc = gt[2] / fmaxf(lt, 1e-30f);
#pragma unroll
        for (int dt = 0; dt < 2; ++dt)
#pragma unroll
            for (int i = 0; i < 16; ++i) O[dt][i] = outl[(16 * dt + i) * 512] + sc * O[dt][i];
    }
    bf16_t* orow = p.ocat + row * DM + head * 64;
#pragma unroll
    for (int dt = 0; dt < 2; ++dt)
#pragma unroll
        for (int gi = 0; gi < 4; ++gi) {
            u32x2 v; v.x = cvt_pk_bf16(O[dt][4 * gi], O[dt][4 * gi + 1]); v.y = cvt_pk_bf16(O[dt][4 * gi + 2], O[dt][4 * gi + 3]);
            *(u32x2*)(orow + 32 * dt + 8 * gi + 4 * hi) = v;
        }
}

constexpr int D_K1 = 0, D_K2 = 9216, D_VS = 18432, D_XS = 132;
DEV void diff_unit(const Params& p, char* lm, int b, int h, int qblk, int pv = 0) {
    const int tid = ltid(), lane = tid & 63, w = tid >> 6, r = lane & 31, hi = lane >> 5, mp = w >> 2, qs = w & 3;
    const int krow = tid >> 3, kch = tid & 7;
    const int ql = 32 * qs + r, t = 128 * qblk + ql;
    const size_t row = (size_t)b * SEQ + t;
    const float slope2 = LOG2E / (float)(1 << (2 * (h + 1)));
    const float sc2 = 0.125f * LOG2E;
    char* K1s = lm + D_K1; char* K2s = lm + D_K2; char* Vs = lm + D_VS;
    const char* myK = mp ? K2s : K1s;
    const bf16_t* prow = p.proj + row * LD;
    bf16x8 qf[4];
#pragma unroll
    for (int s = 0; s < 4; ++s) qf[s] = *(const bf16x8*)(prow + DQOFF + h * 128 + mp * 64 + 16 * s + 8 * hi);
    f32x16 O[4];
#pragma unroll
    for (int dt = 0; dt < 4; ++dt)
#pragma unroll
        for (int i = 0; i < 16; ++i) O[dt][i] = 0.f;
    float m = -1e30f, l = 0.f;
    const bf16_t* kb = p.proj + (size_t)b * SEQ * LD + DKOFF + h * 128;
    const bf16_t* vb = p.dvT + (size_t)(b * 512 + h * 128) * SEQ;
    const int ntl = 2 * qblk + 2;
    float qn2 = 0.f;
#pragma unroll
    for (int s4 = 0; s4 < 4; ++s4)
#pragma unroll
        for (int e = 0; e < 8; ++e) { const float qv = bf2f((bf16_t)qf[s4][e]); qn2 += qv * qv; }
    qn2 += __shfl_xor(qn2, 32);
    const float kmax2 = __uint_as_float(p.ctrl[CT_KMAX + 64 * (b * 8 + h * 2 + mp)]);
    const float ubase = sqrtf(qn2 * kmax2) * sc2 * 1.001f + 1.0f;
    unsigned* dflag = (unsigned*)(lm + D_VS + 16384);
    bool stop = false;
    const u32x4 z4 = (u32x4){0u, 0u, 0u, 0u};
    u32x4 a1 = z4, a2 = z4, a3 = z4, a4 = z4, b1 = z4, b2 = z4, b3 = z4, b4 = z4, c1 = z4, c2 = z4, c3 = z4, c4 = z4;
#define DIFF_LDT(k1, k2, v0, v1, jj) do { if ((jj) < ntl) { const int k0_ = 64 * (ntl - 1 - (jj)); \
        k1 = *(const u32x4*)(kb + (size_t)(k0_ + krow) * LD + kch * 8); k2 = *(const u32x4*)(kb + (size_t)(k0_ + krow) * LD + 64 + kch * 8); \
        v0 = *(const u32x4*)(vb + (size_t)krow * SEQ + k0_ + kch * 8); v1 = *(const u32x4*)(vb + (size_t)(krow + 64) * SEQ + k0_ + kch * 8); } } while (0)
#define DIFF_STEP(k1, k2, v0, v1, jj) do { const int j_ = ntl - 1 - (jj); \
        { const float ub = ubase - slope2 * (float)(t - (64 * j_ + 63)); const bool dead = __all(ub - m < -152.0f); if (lane == 0) dflag[w] = dead ? 1u : 0u; } \
        __syncthreads(); \
        { const u32x4 f0 = *(const u32x4*)dflag, f1 = *(const u32x4*)(dflag + 4); stop = (f0.x & f0.y & f0.z & f0.w & f1.x & f1.y & f1.z & f1.w) != 0u; } \
        if (!stop) { \
        *(u32x4*)(K1s + swz(krow, kch)) = k1; *(u32x4*)(K2s + swz(krow, kch)) = k2; \
        store_vt_chunk(Vs, krow, kch, v0); store_vt_chunk(Vs, krow + 64, kch, v1); \
        __syncthreads(); \
        DIFF_LDT(k1, k2, v0, v1, (jj) + 3); \
        { const f32x16 qa0 = qk32(myK, 0, qf, r, hi); const f32x16 qa1 = qk32(myK, 1, qf, r, hi); \
          { float s[16]; make_scores<1, false>(qa0, s, t - (64 * j_ + 4 * hi), slope2, true); osm_update<4>(s, m, l, O); \
            bf16x8 pf[2]; pack_p(s, pf); pv32<4>(Vs, 0, pf, O, r, hi); } \
          { float s[16]; make_scores<1, false>(qa1, s, t - (64 * j_ + 32 + 4 * hi), slope2, true); osm_update<4>(s, m, l, O); \
            bf16x8 pf[2]; pack_p(s, pf); pv32<4>(Vs, 1, pf, O, r, hi); } } } } while (0)
    DIFF_LDT(a1, a2, a3, a4, 0); DIFF_LDT(b1, b2, b3, b4, 1); DIFF_LDT(c1, c2, c3, c4, 2);
    for (int j = 0; j < ntl; j += 3) {
        DIFF_STEP(a1, a2, a3, a4, j); if (stop) break;
        if (j + 1 < ntl) { DIFF_STEP(b1, b2, b3, b4, j + 1); if (stop) break; }
        if (j + 2 < ntl) { DIFF_STEP(c1, c2, c3, c4, j + 2); if (stop) break; }
    }
#undef DIFF_LDT
#undef DIFF_STEP
    const float lt = l + __shfl_xor(l, 32);
    const float inv = 1.0f / fmaxf(lt, 1e-30f);
    __syncthreads();
    float* X = (float*)lm;
    if (mp == 1) {
#pragma unroll
        for (int dt = 0; dt < 4; ++dt)
#pragma unroll
            for (int i = 0; i < 16; ++i) X[ql * D_XS + 32 * dt + crow(i, hi)] = O[dt][i] * inv;
    }
    __syncthreads();
    if (mp == 0) {
        const float lam = p.misc[0];
        float ss = 0.f;
#pragma unroll
        for (int dt = 0; dt < 4; ++dt)
#pragma unroll
            for (int i = 0; i < 16; ++i) { const float o = O[dt][i] * inv - lam * X[ql * D_XS + 32 * dt + crow(i, hi)]; O[dt][i] = o; ss += o * o; }
        ss += __shfl_xor(ss, 32);
        const float rs = rsqrtf(ss * (1.0f / 128.0f) + RMS_EPS) * 0.8f;
        bf16_t* orow = p.ocat + row * DM + 512 + h * 128;
#pragma unroll
        for (int dt = 0; dt < 4; ++dt)
#pragma unroll
            for (int gi = 0; gi < 4; ++gi) {
                const int d0 = 32 * dt + 8 * gi + 4 * hi;
                const f32x4 gv = *(const f32x4*)(p.diff_subln + d0);
                u32x2 v; v.x = cvt_pk_bf16(O[dt][4 * gi] * rs * gv[0], O[dt][4 * gi + 1] * rs * gv[1]);
                v.y = cvt_pk_bf16(O[dt][4 * gi + 2] * rs * gv[2], O[dt][4 * gi + 3] * rs * gv[3]);
                *(u32x2*)(orow + d0) = v;
            }
    }
    __syncthreads();
}

struct BLoadIn {
    const float* w; int n0;
    DEV f32x4 ld(int k, int n) const {
        const int cp = n0 + n; int cg;
        if (cp < 1280) cg = cp; else if (cp < 2816) cg = cp + 24; else if (cp < 2840) cg = cp - 2816 + 1280; else return (f32x4){0.f, 0.f, 0.f, 0.f};
        return *(const f32x4*)(w + (size_t)k * 2840 + cg);
    }
};
struct BLqPlain {
    const bf16_t* wt;
    DEV u32x4 ldq(int n, int ks, int ch) const { return *(const u32x4*)(wt + (size_t)n * 1024 + ks * 64 + ch * 8); }
};
struct BLqRouter {
    const bf16_t* wt;
    DEV u32x4 ldq(int n, int ks, int ch) const { const int seg = ks >> 4, kk = ks & 15; return *(const u32x4*)(wt + (size_t)((seg == 2 ? 256 : 0) + n) * 1024 + kk * 64 + ch * 8); }
};
struct BLoadPlain { const float* w; int ldb; DEV f32x4 ld(int k, int n) const { return *(const f32x4*)(w + (size_t)k * ldb + n); } };
struct BLoadRouter {
    const float* w;
    DEV f32x4 ld(int k, int n) const {
        const int seg = k >> 10, kk = k & 1023;
        f32x4 v = *(const f32x4*)(w + (size_t)kk * 256 + n);
        if (seg == 2) {
#pragma unroll
            for (int i = 0; i < 4; ++i) v[i] = v[i] - bf2f(f2bf(v[i]));
        }
        return v;
    }
};
struct BLoadGU {
    const float* w; int nt;
    DEV f32x4 ld(int k, int n) const {
        const int col = ((n >> 5) & 1) * 256 + 64 * nt + 32 * (n >> 6) + 16 * ((n >> 4) & 1) + (n & 15);
        return *(const f32x4*)(w + (size_t)k * 512 + col);
    }
};

template <int NM> struct EpiProj {
    bf16_t* o; int row0, col0;
    DEV void operator()(const f32x4 (&acc)[NM][4], int r0, int c0, int rowlim, int c, int q) const {
#pragma unroll
        for (int mi = 0; mi < NM; ++mi) {
            if (r0 + 16 * mi < rowlim) {
#pragma unroll
                for (int ni = 0; ni < 4; ++ni) {
                    const f32x4 v = acc[mi][ni]; u32x2 u; u.x = cvt_pk_bf16(v[0], v[1]); u.y = cvt_pk_bf16(v[2], v[3]);
                    *(u32x2*)(o + (size_t)(row0 + r0 + 16 * mi + c) * LD + col0 + c0 + 16 * ni + 4 * q) = u;
                }
            }
        }
    }
};
template <int NM> struct EpiVT {
    bf16_t* vt; int row0, vbase, bstride;
    DEV void operator()(const f32x4 (&acc)[NM][4], int r0, int c0, int rowlim, int c, int q) const {
#pragma unroll
        for (int mi = 0; mi < NM; ++mi) {
            if (r0 + 16 * mi < rowlim) {
                const int rg = row0 + r0 + 16 * mi + 4 * q, bb = rg >> 13, tt = rg & (SEQ - 1);
#pragma unroll
                for (int ni = 0; ni < 4; ++ni) {
                    const f32x4 v = acc[mi][ni]; u32x2 u; u.x = cvt_pk_bf16(v[0], v[1]); u.y = cvt_pk_bf16(v[2], v[3]);
                    *(u32x2*)(vt + (size_t)(vbase + bb * bstride + c0 + 16 * ni + c) * SEQ + tt) = u;
                }
            }
        }
    }
};
template <int NM> struct EpiF32 {
    float* o; int ldo, row0, col0;
    DEV void operator()(const f32x4 (&acc)[NM][4], int r0, int c0, int rowlim, int c, int q) const {
#pragma unroll
        for (int mi = 0; mi < NM; ++mi) {
            if (r0 + 16 * mi < rowlim) {
#pragma unroll
                for (int ni = 0; ni < 4; ++ni)
                    *(f32x4*)(o + (size_t)(row0 + r0 + 16 * mi + c) * ldo + col0 + c0 + 16 * ni + 4 * q) = acc[mi][ni];
            }
        }
    }
};
template <int NM> struct EpiSwiglu {
    bf16_t* H; const int* rslot; const float* rwt; int nt;
    DEV void operator()(const f32x4 (&acc)[NM][4], int r0, int c0, int rowlim, int c, int q) const {
#pragma unroll
        for (int mi = 0; mi < NM; ++mi) {
            if (r0 + 16 * mi < rowlim) {
                const int rr = r0 + 16 * mi + c; const int slot = rslot[rr];
                if (slot >= 0) {
                    const float wt = rwt[rr];
#pragma unroll
                    for (int nh = 0; nh < 2; ++nh) {
                        const f32x4 a = acc[mi][nh], g = acc[mi][nh + 2]; float hv[4];
#pragma unroll
                        for (int i = 0; i < 4; ++i) hv[i] = a[i] / (1.0f + __expf(-a[i])) * g[i] * wt;
                        u32x2 u; u.x = cvt_pk_bf16(hv[0], hv[1]); u.y = cvt_pk_bf16(hv[2], hv[3]);
                        *(u32x2*)(H + (size_t)slot * 256 + 64 * nt + (c0 >> 1) + 16 * nh + 4 * q) = u;
                    }
                }
            }
        }
    }
};

template <int MS, bool TRANS, bool BF, int PD, class AS, class BL, class EP>
DEV void gemm_ws(char* lm, int nk, int nsub, const AS& as, const BL& bl, const EP& ep) {
    const int tid = ltid(), lane = tid & 63, w = __builtin_amdgcn_readfirstlane(tid >> 6);
    const int* rowoff = (const int*)(lm + G_ROWOFF);
    const int rowlim = 128 * nsub;
    if (w < 4) {
        const int ar0 = tid >> 3, akc = tid & 7;
        const int bn4 = 8 * w + (lane & 7), bk0 = lane >> 3;
        u32x4 ra[PD][4 * MS]; f32x4 rb[BF ? 1 : PD][8]; u32x4 rq[BF ? PD : 1][4];
#define WS_LOAD(s_, ks_) do { \
        _Pragma("unroll") for (int i = 0; i < 4 * MS; ++i) if (32 * i < rowlim) ra[s_][i] = as.ld(rowoff[ar0 + 32 * i] + akc * 8, (ks_)); \
        if constexpr (BF) { _Pragma("unroll") for (int i = 0; i < 4; ++i) rq[s_][i] = bl.ldq(ar0 + 32 * i, (ks_), akc); } \
        else { _Pragma("unroll") for (int jq = 0; jq < 2; ++jq) _Pragma("unroll") for (int i = 0; i < 4; ++i) rb[s_][4 * jq + i] = bl.ld((ks_) * 64 + 4 * (bk0 + 8 * jq) + i, 4 * bn4); } } while (0)
#define WS_STORE(s_, buf_) do { char* As_ = lm + G_AS + (buf_) * G_ASZ; char* Bs_ = lm + G_BS + (buf_) * G_BSZ; \
        _Pragma("unroll") for (int i = 0; i < 4 * MS; ++i) if (32 * i < rowlim) *(u32x4*)(As_ + swz(ar0 + 32 * i, akc)) = ra[s_][i]; \
        if constexpr (BF) { _Pragma("unroll") for (int i = 0; i < 4; ++i) *(u32x4*)(Bs_ + swz(ar0 + 32 * i, akc)) = rq[s_][i]; } \
        else { _Pragma("unroll") for (int jq = 0; jq < 2; ++jq) _Pragma("unroll") for (int cc = 0; cc < 4; ++cc) { \
            u32x2 v; v.x = cvt_pk_bf16(rb[s_][4 * jq][cc], rb[s_][4 * jq + 1][cc]); v.y = cvt_pk_bf16(rb[s_][4 * jq + 2][cc], rb[s_][4 * jq + 3][cc]); \
            *(u32x2*)(Bs_ + swz(4 * bn4 + cc, (bk0 + 8 * jq) >> 1) + ((bk0 + 8 * jq) & 1) * 8) = v; } } } while (0)
#pragma unroll
        for (int s = 0; s < PD; ++s) {
#pragma unroll
            for (int i = 0; i < 4 * MS; ++i) ra[s][i] = (u32x4){0u, 0u, 0u, 0u};
            if constexpr (BF) {
#pragma unroll
                for (int i = 0; i < 4; ++i) rq[s][i] = (u32x4){0u, 0u, 0u, 0u};
            } else {
#pragma unroll
                for (int i = 0; i < 8; ++i) rb[s][i] = (f32x4){0.f, 0.f, 0.f, 0.f};
            }
            if (s < nk) WS_LOAD(s, s);
        }
        __syncthreads();
        WS_STORE(0, 0);
        if (PD < nk) WS_LOAD(0, PD);
        __syncthreads();
        for (int ks0 = 0; ks0 < nk; ks0 += PD) {
#pragma unroll
            for (int s = 0; s < PD; ++s) {
                const int ks = ks0 + s;
                if (ks < nk) {
                    const int sn = (s + 1) % PD;
                    if (ks + 1 < nk) { WS_STORE(sn, (ks + 1) & 1); if (ks + 1 + PD < nk) WS_LOAD(sn, ks + 1 + PD); }
                    __syncthreads();
                }
            }
        }
#undef WS_LOAD
#undef WS_STORE
    } else {
        const int cw = w - 4, c = lane & 15, q = lane >> 4;
        f32x4 acc[2 * MS][8];
#pragma unroll
        for (int mi = 0; mi < 2 * MS; ++mi)
#pragma unroll
            for (int ni = 0; ni < 8; ++ni) acc[mi][ni] = (f32x4){0.f, 0.f, 0.f, 0.f};
        __syncthreads();
        __syncthreads();
        for (int ks = 0; ks < nk; ++ks) {
            const char* As = lm + G_AS + (ks & 1) * G_ASZ; const char* Bs = lm + G_BS + (ks & 1) * G_BSZ;
            bf16x8 bq[2][8]; bf16x8 af[4 * MS];
#pragma unroll
            for (int ni = 0; ni < 8; ++ni) bq[0][ni] = *(const bf16x8*)(Bs + swz(16 * ni + c, q));
            af[0] = *(const bf16x8*)(As + swz(32 * MS * cw + c, q));
            af[1] = *(const bf16x8*)(As + swz(32 * MS * cw + 16 + c, q));
            __builtin_amdgcn_sched_barrier(0);
#pragma unroll
            for (int g = 0; g < 4 * MS; ++g) {
                const int kk = g / (2 * MS), mi = g % (2 * MS);
                if (g + 2 < 4 * MS) { const int kk2 = (g + 2) / (2 * MS), mi2 = (g + 2) % (2 * MS); af[g + 2] = *(const bf16x8*)(As + swz(32 * MS * cw + 16 * mi2 + c, 4 * kk2 + q)); }
                if (kk == 0 && mi < 4) {
                    bq[1][2 * mi] = *(const bf16x8*)(Bs + swz(16 * (2 * mi) + c, 4 + q));
                    bq[1][2 * mi + 1] = *(const bf16x8*)(Bs + swz(16 * (2 * mi + 1) + c, 4 + q));
                }
                if (32 * MS * cw + 16 * mi < rowlim) {
#pragma unroll
                    for (int ni = 0; ni < 8; ++ni)
                        acc[mi][ni] = TRANS ? __builtin_amdgcn_mfma_f32_16x16x32_bf16(bq[kk][ni], af[g], acc[mi][ni], 0, 0, 0)
                                            : __builtin_amdgcn_mfma_f32_16x16x32_bf16(af[g], bq[kk][ni], acc[mi][ni], 0, 0, 0);
                }
                __builtin_amdgcn_sched_barrier(0);
            }
            __syncthreads();
        }
        ep(acc, 32 * MS * cw, rowlim, c, q);
    }
}
template <int NM> struct EpiF32W {
    float* o; int ldo, row0, col0;
    DEV void operator()(const f32x4 (&acc)[NM][8], int r0, int rowlim, int c, int q) const {
#pragma unroll
        for (int mi = 0; mi < NM; ++mi) {
            if (r0 + 16 * mi < rowlim) {
#pragma unroll
                for (int ni = 0; ni < 8; ++ni)
                    *(f32x4*)(o + (size_t)(row0 + r0 + 16 * mi + c) * ldo + col0 + 16 * ni + 4 * q) = acc[mi][ni];
            }
        }
    }
};
template <int NM> struct EpiProjW {
    bf16_t* o; int row0, col0;
    DEV void operator()(const f32x4 (&acc)[NM][8], int r0, int rowlim, int c, int q) const {
#pragma unroll
        for (int mi = 0; mi < NM; ++mi) {
            if (r0 + 16 * mi < rowlim) {
#pragma unroll
                for (int ni = 0; ni < 8; ++ni) {
                    const f32x4 v = acc[mi][ni]; u32x2 u; u.x = cvt_pk_bf16(v[0], v[1]); u.y = cvt_pk_bf16(v[2], v[3]);
                    *(u32x2*)(o + (size_t)(row0 + r0 + 16 * mi + c) * LD + col0 + 16 * ni + 4 * q) = u;
                }
            }
        }
    }
};
template <int NM> struct EpiVTW {
    bf16_t* vt; int row0, vbase, bstride;
    DEV void operator()(const f32x4 (&acc)[NM][8], int r0, int rowlim, int c, int q) const {
#pragma unroll
        for (int mi = 0; mi < NM; ++mi) {
            if (r0 + 16 * mi < rowlim) {
                const int rg = row0 + r0 + 16 * mi + 4 * q, bb = rg >> 13, tt = rg & (SEQ - 1);
#pragma unroll
                for (int ni = 0; ni < 8; ++ni) {
                    const f32x4 v = acc[mi][ni]; u32x2 u; u.x = cvt_pk_bf16(v[0], v[1]); u.y = cvt_pk_bf16(v[2], v[3]);
                    *(u32x2*)(vt + (size_t)(vbase + bb * bstride + 16 * ni + c) * SEQ + tt) = u;
                }
            }
        }
    }
};
struct BLoadGUW {
    const float* w; int nt;
    DEV f32x4 ld(int k, int n) const { return *(const f32x4*)(w + (size_t)k * 512 + (n >> 6) * 256 + 64 * nt + (n & 63)); }
};
template <int NM> struct EpiSwigluW {
    bf16_t* H; const int* rslot; const float* rwt; int nt;
    DEV void operator()(const f32x4 (&acc)[NM][8], int r0, int rowlim, int c, int q) const {
#pragma unroll
        for (int mi = 0; mi < NM; ++mi) {
            if (r0 + 16 * mi < rowlim) {
                const int rr = r0 + 16 * mi + c; const int slot = rslot[rr];
                if (slot >= 0) {
                    const float wt = rwt[rr];
#pragma unroll
                    for (int nh = 0; nh < 4; ++nh) {
                        const f32x4 a = acc[mi][nh], g = acc[mi][nh + 4]; float hv[4];
#pragma unroll
                        for (int i = 0; i < 4; ++i) hv[i] = a[i] / (1.0f + __expf(-a[i])) * g[i] * wt;
                        u32x2 u; u.x = cvt_pk_bf16(hv[0], hv[1]); u.y = cvt_pk_bf16(hv[2], hv[3]);
                        *(u32x2*)(H + (size_t)slot * 256 + 64 * nt + 16 * nh + 4 * q) = u;
                    }
                }
            }
        }
    }
};

DEV int entry_cnt(const unsigned* cnt, int e) { if (e >= 256) return 2048; const unsigned n = cnt[e]; return n > (unsigned)CAP ? CAP : (int)n; }

template <int STAGE>
DEV void moe_phase(const Params& p, char* lds, unsigned xcc, int rep) {
    char* lm = lds + L_MAIN;
    int* pre = (int*)(lm + G_PRE);
    int* rowoff = (int*)(lm + G_ROWOFF);
    int* rslot = (int*)(lm + G_RSLOT);
    float* rwt = (float*)(lm + G_RWT);
    int* bc = (int*)(lds + L_CTRL + 16);
    const unsigned* cnt = p.ctrl + CT_CNT;
    const int tid = ltid();
    constexpr int NT = (STAGE == 1) ? 4 : 8;
    __syncthreads();
    if (tid < 8) {
        int s = 0;
        for (int k = 0; k < 33; ++k) { pre[tid * 34 + k] = s; const int n = entry_cnt(cnt, tid + 8 * k); s += ((n + 383) / 384) * NT; }
        pre[tid * 34 + 33] = s;
    }
    __syncthreads();
    for (int xo = 0; xo < 8; ++xo) {
        const int x = (int)((xcc + xo) & 7u);
        unsigned* qc = p.ctrl + CT_Q + 64 * ((STAGE == 1 ? 16 : 32) + 8 * rep + x);
        const int total = pre[x * 34 + 33];
        for (;;) {
            __syncthreads();
            if (tid == 0) {
                const int u = (int)atomicAdd(qc, 1u);
                int k = -1;
                if (u < total) { k = 0; while (pre[x * 34 + k + 1] <= u) ++k; }
                bc[0] = u; bc[1] = k;
            }
            __syncthreads();
            const int u = bc[0], k = bc[1];
            if (k < 0) break;
            const int e = x + 8 * k, local = u - pre[x * 34 + k];
            const int n_e = entry_cnt(cnt, e);
            const int ngrp = (n_e + 383) / 384;
            const int nt = local / ngrp, mg = local % ngrp;
            int rows = n_e - mg * 384; if (rows > 384) rows = 384;
            const int nsub = (rows + 127) >> 7;
            {
                const int idx = mg * 384 + tid; int slot = -1; float wt = 0.f;
                if (tid < rows) {
                    if (e < 256) { const uint2 en = p.bucket[(size_t)e * CAP + idx]; slot = (int)en.x; wt = __uint_as_float(en.y); if ((unsigned)slot >= (unsigned)(T_TOK * 9)) slot = -1; }
                    else { slot = ((e - 256) * 2048 + idx) * 9 + 8; wt = 1.0f; }
                }
                rslot[tid] = slot; rwt[tid] = wt;
                rowoff[tid] = slot < 0 ? 0 : (STAGE == 1 ? (slot / 9) * 1024 : slot * 256);
            }
            __syncthreads();
            {
                ASrcPlain as; as.base = p.hhi;
                BLoadGU bl; bl.w = e < 256 ? p.w_gate_up + (size_t)e * 1024 * 512 : p.ws_gate_up; bl.nt = nt;
                EpiSwiglu<6> ep; ep.H = p.H; ep.rslot = rslot; ep.rwt = rwt; ep.nt = nt;
                gemm_big<3, true, 1, ASrcPlain, BLoadGU, EpiSwiglu<6>, 2>(lm, 16, nsub, as, bl, ep, (PROBE_PH == 9 && rep == 0) ? PROBE_VAR : 0);
            }
        }
    }
}

constexpr int DN_BS = 131072, DN_RSLOT = DN_BS + 18432, DN_PRE = DN_RSLOT + 1024;
DEV void moe_down_phase(const Params& p, char* lds, unsigned xcc, int rep) {
    char* lm = lds + L_MAIN;
    char* Bs = lm + DN_BS;
    int* rslot = (int*)(lm + DN_RSLOT);
    int* pre = (int*)(lm + DN_PRE);
    int* bc = (int*)(lds + L_CTRL + 16);
    const unsigned* cnt = p.ctrl + CT_CNT;
    const int tid = ltid(), lane = tid & 63, w = tid >> 6, wm = w >> 2, wn = w & 3, c = lane & 15, q = lane >> 4;
    const int bn4 = 8 * (w & 3) + (lane & 7), bkq = 8 * (w >> 2) + (lane >> 3);
    __syncthreads();
    if (tid < 8) {
        int sacc = 0;
        for (int k = 0; k < 33; ++k) { pre[tid * 34 + k] = sacc; const int n = entry_cnt(cnt, tid + 8 * k); sacc += (n + 255) >> 8; }
        pre[tid * 34 + 33] = sacc;
    }
    __syncthreads();
    for (int xo = 0; xo < 8; ++xo) {
        const int x = (int)((xcc + xo) & 7u);
        unsigned* qc = p.ctrl + CT_Q + 64 * (32 + 8 * rep + x);
        const int total = pre[x * 34 + 33];
        for (;;) {
            __syncthreads();
            if (tid == 0) {
                const int u = (int)atomicAdd(qc, 1u);
                int k = -1;
                if (u < total) { k = 0; while (pre[x * 34 + k + 1] <= u) ++k; }
                bc[0] = u; bc[1] = k;
            }
            __syncthreads();
            const int u = bc[0], k = bc[1];
            if (k < 0) break;
            const int e = x + 8 * k, mg = u - pre[x * 34 + k];
            const int n_e = entry_cnt(cnt, e);
            int rows = n_e - mg * 256; if (rows > 256) rows = 256;
            const int nsub = (rows + 127) >> 7;
            if (tid < 256) {
                const int idx = mg * 256 + tid; int slot = -1;
                if (tid < rows) {
                    if (e < 256) { slot = (int)p.bucket[(size_t)e * CAP + idx].x; if ((unsigned)slot >= (unsigned)(T_TOK * 9)) slot = -1; }
                    else slot = ((e - 256) * 2048 + idx) * 9 + 8;
                }
                rslot[tid] = slot;
            }
            __syncthreads();
#pragma unroll
            for (int hb = 0; hb < 2; ++hb) {
                u32x4 v[8];
#pragma unroll
                for (int i = 0; i < 8; ++i) {
                    const int id = tid + 512 * (8 * hb + i), row = id >> 5, kc = id & 31;
                    const int slot = rslot[row];
                    v[i] = *(const u32x4*)(p.H + (size_t)(slot < 0 ? 0 : slot) * 256 + kc * 8);
                }
#pragma unroll
                for (int i = 0; i < 8; ++i) {
                    const int id = tid + 512 * (8 * hb + i), row = id >> 5, kc = id & 31;
                    const int tile = (row >> 7) * 4 + (kc >> 3), rr = row & 127;
                    *(u32x4*)(lm + tile * 16384 + swz(rr, kc & 7)) = v[i];
                }
            }
            const float* wd = (e < 256 ? p.w_down + (size_t)e * 256 * 1024 : p.ws_down);
            f32x4 rb[2][4];
#pragma unroll
            for (int s2 = 0; s2 < 2; ++s2)
#pragma unroll
                for (int i = 0; i < 4; ++i) rb[s2][i] = *(const f32x4*)(wd + (size_t)(s2 * 64 + 4 * bkq + i) * 1024 + 4 * bn4);
            f32x4 acc[2][4][2];
#pragma unroll 1
            for (int nt = 0; nt < 8; ++nt) {
#pragma unroll
                for (int sb = 0; sb < 2; ++sb)
#pragma unroll
                    for (int mi = 0; mi < 4; ++mi)
#pragma unroll
                        for (int ni = 0; ni < 2; ++ni) acc[sb][mi][ni] = (f32x4){0.f, 0.f, 0.f, 0.f};
#pragma unroll 1
                for (int ksp = 0; ksp < 2; ++ksp) {
#pragma unroll
                    for (int k2 = 0; k2 < 2; ++k2) {
                        const int ks = 2 * ksp + k2;
                        __syncthreads();
#pragma unroll
                        for (int cc = 0; cc < 4; ++cc) {
                            u32x2 v; v.x = cvt_pk_bf16(rb[k2][0][cc], rb[k2][1][cc]); v.y = cvt_pk_bf16(rb[k2][2][cc], rb[k2][3][cc]);
                            *(u32x2*)(Bs + swz(4 * bn4 + cc, bkq >> 1) + (bkq & 1) * 8) = v;
                        }
                        __syncthreads();
                        {
                            const int st2 = nt * 4 + ks + 2;
                            if (st2 < 32) {
                                const int nt2 = st2 >> 2, ks2 = st2 & 3;
#pragma unroll
                                for (int i = 0; i < 4; ++i) rb[k2][i] = *(const f32x4*)(wd + (size_t)(ks2 * 64 + 4 * bkq + i) * 1024 + 128 * nt2 + 4 * bn4);
                            }
                        }
#pragma unroll
                        for (int kk = 0; kk < 2; ++kk) {
                            bf16x8 bfr[2];
#pragma unroll
                            for (int ni = 0; ni < 2; ++ni) bfr[ni] = *(const bf16x8*)(Bs + swz(32 * wn + 16 * ni + c, 4 * kk + q));
#pragma unroll
                            for (int sb = 0; sb < 2; ++sb) {
                                if (sb < nsub) {
                                    bf16x8 af[4];
#pragma unroll
                                    for (int mi = 0; mi < 4; ++mi) {
                                        const int rr = 64 * wm + 16 * mi + c;
                                        af[mi] = *(const bf16x8*)(lm + (sb * 4 + ks) * 16384 + swz(rr, 4 * kk + q));
                                    }
#pragma unroll
                                    for (int mi = 0; mi < 4; ++mi)
#pragma unroll
                                        for (int ni = 0; ni < 2; ++ni)
                                            acc[sb][mi][ni] = __builtin_amdgcn_mfma_f32_16x16x32_bf16(bfr[ni], af[mi], acc[sb][mi][ni], 0, 0, 0);
                                }
                            }
                        }
                    }
                }
#pragma unroll
                for (int sb = 0; sb < 2; ++sb) {
                    if (sb < nsub) {
#pragma unroll
                        for (int mi = 0; mi < 4; ++mi) {
                            const int slot = rslot[128 * sb + 64 * wm + 16 * mi + c];
                            if (slot >= 0) {
#pragma unroll
                                for (int ni = 0; ni < 2; ++ni) {
                                    const f32x4 v = acc[sb][mi][ni]; u32x2 uu; uu.x = cvt_pk_bf16(v[0], v[1]); uu.y = cvt_pk_bf16(v[2], v[3]);
                                    *(u32x2*)(p.yslot + (size_t)slot * 1024 + 128 * nt + 32 * wn + 16 * ni + 4 * q) = uu;
                                }
                            }
                        }
                    }
                }
            }
        }
    }
}

template <int MODE>
DEV void wt_tile(const float* src, int ldn, bf16_t* dstbase, int ntile, int ktile, float* tl, int tid) {
    __syncthreads();
#pragma unroll
    for (int j = 0; j < 2; ++j) {
        const int idx = tid + 512 * j, kk = idx >> 4, n4 = idx & 15;
        const int cp = ntile * 64 + n4 * 4; int cg = cp;
        if (MODE == 1) { if (cp < 1280) cg = cp; else if (cp < 2816) cg = cp + 24; else if (cp < 2840) cg = cp - 2816 + 1280; else cg = -1; }
        f32x4 v = (f32x4){0.f, 0.f, 0.f, 0.f};
        if (cg >= 0) v = *(const f32x4*)(src + (size_t)(ktile * 64 + kk) * ldn + cg);
        tl[kk * 65 + n4 * 4 + 0] = v[0]; tl[kk * 65 + n4 * 4 + 1] = v[1]; tl[kk * 65 + n4 * 4 + 2] = v[2]; tl[kk * 65 + n4 * 4 + 3] = v[3];
    }
    __syncthreads();
    const int n = tid >> 3, kc = tid & 7;
    float f[8];
#pragma unroll
    for (int e = 0; e < 8; ++e) f[e] = tl[(kc * 8 + e) * 65 + n];
    u32x4 o; o.x = cvt_pk_bf16(f[0], f[1]); o.y = cvt_pk_bf16(f[2], f[3]); o.z = cvt_pk_bf16(f[4], f[5]); o.w = cvt_pk_bf16(f[6], f[7]);
    bf16_t* dst = dstbase + (size_t)(ntile * 64 + n) * 1024 + ktile * 64 + kc * 8;
    *(u32x4*)dst = o;
    if (MODE == 2) {
#pragma unroll
        for (int e = 0; e < 8; ++e) f[e] = f[e] - bf2f(f2bf(f[e]));
        o.x = cvt_pk_bf16(f[0], f[1]); o.y = cvt_pk_bf16(f[2], f[3]); o.z = cvt_pk_bf16(f[4], f[5]); o.w = cvt_pk_bf16(f[6], f[7]);
        *(u32x4*)(dst + (size_t)256 * 1024) = o;
    }
}

#ifndef STOP_AFTER
#define STOP_AFTER 99
#endif
DEV void dump_out(const Params& p, int k) {
    const size_t n = (size_t)T_TOK * DM;
    for (size_t i = (size_t)blockIdx.x * 512 + threadIdx.x; i < n; i += (size_t)gridDim.x * 512) {
        float v = 0.f;
        if (k == 1) v = bf2f(p.hmix[i]);
        else if (k == 0) v = i < 12288 ? p.mod[i] : i < 12288 + 192 ? p.misc[i - 12288] : 0.f;
        else if (k == 2) v = (i % 2944 < 896 || (i % 2944 >= 1024 && i % 2944 < 1152) || (i % 2944 >= 1280 && i % 2944 < 2304) || i % 2944 >= 2816) ? bf2f(p.proj[i]) : 0.f;
        else if (k == 3) v = i < 131072 ? bf2f(p.kc[i]) : i < 262144 ? bf2f(p.vcT[i - 131072]) : i < 262144 + 12582912 ? bf2f(p.vselT[i - 262144]) : 0.f;
        else if (k == 4) v = bf2f(p.ocat[i]);
        else if (k == 5) v = p.y[i];
        else if (k == 6) v = bf2f(p.hhi[i]) + 64.f * bf2f(p.hlo[i]);
        else if (k == 7) v = i < (size_t)T_TOK * 256 ? p.logits[i] : 0.f;
        else if (k == 8) v = i < 256 ? (float)p.ctrl[CT_CNT + i] : 0.f;
        else if (k == 9) v = bf2f(p.H[i]) + bf2f(p.H[i + n]);
        else if (k == 10) v = bf2f(p.yslot[i]) + bf2f(p.yslot[i + 4 * n]) + bf2f(p.yslot[i + 8 * n]);
        p.out[i] = v;
    }
}
#define STOP_AT(k) do { if (STOP_AFTER == (k)) { dump_out(p, (k)); return; } } while (0)
__global__ void __launch_bounds__(512, 2) fwd_kernel(Params p) {
    extern __shared__ __attribute__((aligned(16))) char lds[];
    const int tid = ltid(), lane = tid & 63, w = tid >> 6;
    const int nb = gridDim.x, bid = blockIdx.x;
    char* lm = lds + L_MAIN;
    if (tid < 16) ((unsigned*)lds)[tid] = 0u;
    __syncthreads();
    XcdBarrier bar = xcd_barrier_post(p.ctrl, (volatile LAS unsigned*)lds);
    const unsigned xcc = bar.x & 7u;
    if (AMP_PH >= 0 && blockIdx.x == 0 && threadIdx.x == 0) ((volatile unsigned long long*)(p.ctrl + 15360))[0] = wall_clock64();
    int* bc = (int*)(lds + L_CTRL + 16);

    {
    const int tid = ltid(), lane = tid & 63, w = tid >> 6; (void)lane; (void)w;
        float* sc = (float*)lm;
        float* red = (float*)(lm + 8192);
        for (int i = tid; i < 2048; i += 512) { const float v = p.c[i]; sc[i] = v / (1.0f + __expf(-v)); }
        __syncthreads();
        for (int cb = bid; cb < 256; cb += nb) {
            if (tid < 480) {
                const int j = tid % 24, ks = tid / 24; const int col = cb * 24 + j;
                float a0 = 0.f, a1 = 0.f;
                for (int k = ks; k < 1024; k += 20) { const float wv = p.w_ada[(size_t)k * 6144 + col]; a0 += sc[k] * wv; a1 += sc[1024 + k] * wv; }
                red[(ks * 24 + j) * 2] = a0; red[(ks * 24 + j) * 2 + 1] = a1;
            }
            __syncthreads();
            if (tid < 48) {
                const int j = tid >> 1, bb = tid & 1; float s = 0.f;
                for (int ks = 0; ks < 20; ++ks) s += red[(ks * 24 + j) * 2 + bb];
                const int col = cb * 24 + j;
                p.mod[bb * 6144 + col] = s + p.b_ada[col];
            }
            __syncthreads();
        }
        for (int cb = bid; cb < 256; cb += nb) {
            if (tid < 64) {
                const int kv = cb >> 7, chunk = cb & 127; float a = 0.f;
#pragma unroll
                for (int kk = 0; kk < 16; ++kk) { const int k = chunk * 16 + kk; a += p.pe_cmp[kv * 2048 + k] * p.w_cmp1[((size_t)kv * 2048 + k) * 64 + tid]; }
                p.misc[1024 + cb * 64 + tid] = a;
            }
        }
        {
            float* tl = (float*)(lm + 16384);
            for (int u = bid; u < 736; u += nb) wt_tile<1>(p.w_in, 2840, p.wT, u >> 4, u & 15, tl, tid);
            for (int u = bid; u < 256; u += nb) wt_tile<0>(p.w_out, 1024, p.wT + (size_t)2944 * 1024, u >> 4, u & 15, tl, tid);
            for (int u = bid; u < 64; u += nb) wt_tile<2>(p.w_router, 256, p.wT + (size_t)3968 * 1024, u >> 4, u & 15, tl, tid);
            __syncthreads();
        }
        if (bid == (2 % nb) && tid == 0) {
            float s01 = 0.f, s23 = 0.f;
            for (int i = 0; i < 64; ++i) { s01 += p.diff_lambda[i] * p.diff_lambda[64 + i]; s23 += p.diff_lambda[128 + i] * p.diff_lambda[192 + i]; }
            p.misc[0] = __expf(s01) - __expf(s23) + 0.2f;
        }
        if (bid == (3 % nb)) {
            for (int i = tid; i < 4 * 64; i += 512) { const int bg = i >> 6, d = i & 63; p.kc[((size_t)bg * 512 + 511) * 64 + d] = 0; p.vcT[((size_t)bg * 64 + d) * 512 + 511] = 0; }
        }
    }
    xcd_barrier(bar);
    if (AMP_PH >= 0 && blockIdx.x == 0 && threadIdx.x == 0) ((volatile unsigned long long*)(p.ctrl + 15360))[1] = wall_clock64();
    STOP_AT(0);

    for (int rep_ = 0; rep_ < REPS(1); ++rep_) {
    const int tid = ltid(), lane = tid & 63, w = tid >> 6; (void)lane; (void)w;
    for (int row = bid * 8 + w; row < T_TOK; row += nb * 8) {
        const int bb = row >> 13; const float* xr = p.x + (size_t)row * DM;
        f32x4 v[4]; float ss = 0.f;
#pragma unroll
        for (int j = 0; j < 4; ++j) { v[j] = *(const f32x4*)(xr + lane * 4 + 256 * j); ss += v[j][0] * v[j][0] + v[j][1] * v[j][1] + v[j][2] * v[j][2] + v[j][3] * v[j][3]; }
        ss = wave_sum(ss);
        const float rs = rsqrtf(ss * (1.0f / 1024.0f) + RMS_EPS);
#pragma unroll
        for (int j = 0; j < 4; ++j) {
            const int col = lane * 4 + 256 * j;
            const f32x4 g = *(const f32x4*)(p.norm_g + col), s1 = *(const f32x4*)(p.mod + bb * 6144 + 1024 + col), h1 = *(const f32x4*)(p.mod + bb * 6144 + col);
            float o[4];
#pragma unroll
            for (int i = 0; i < 4; ++i) o[i] = v[j][i] * rs * g[i] * (1.0f + s1[i]) + h1[i];
            u32x2 u; u.x = cvt_pk_bf16(o[0], o[1]); u.y = cvt_pk_bf16(o[2], o[3]);
            *(u32x2*)(p.hmix + (size_t)row * DM + col) = u;
        }
    }
    xcd_barrier(bar);
    if (AMP_PH >= 0 && blockIdx.x == 0 && threadIdx.x == 0) ((volatile unsigned long long*)(p.ctrl + 15360))[2] = wall_clock64();
    }
    STOP_AT(1);

    for (int rep_ = 0; rep_ < REPS(2); ++rep_) {
    const int tid = ltid(), lane = tid & 63, w = tid >> 6; (void)lane; (void)w;
    for (int xo = 0; xo < 8; ++xo) {
        const int x = (int)((xcc + xo) & 7u);
        unsigned* qc = p.ctrl + CT_Q + 64 * (48 + 8 * rep_ + x);
        for (;;) {
            __syncthreads();
            if (tid == 0) bc[0] = (int)atomicAdd(qc, 1u);
            __syncthreads();
            const int v = bc[0];
            if (v >= 184) break;
            const int mg = x + 8 * (v / 23), nt = v % 23;
            ((int*)(lm + G_ROWOFF))[tid & 255] = (mg * 256 + (tid & 255)) * DM;
            __syncthreads();
            ASrcPlain as; as.base = p.hmix;
            BLqPlain bl; bl.wt = p.wT + (size_t)nt * 128 * 1024;
            const bool vt = (nt == 7) || (nt == 9) || (nt >= 18 && nt <= 21);
            if (!vt) {
                EpiProjW<4> ep; ep.o = p.proj; ep.row0 = mg * 256; ep.col0 = nt * 128;
                gemm_ws<2, true, true, 2>(lm, 16, 2, as, bl, ep);
            } else {
                EpiVTW<4> ep; ep.row0 = mg * 256; ep.vt = p.vselT;
                ep.vbase = (nt == 7) ? 0 : (nt == 9) ? 256 : 512 + (nt - 18) * 128; ep.bstride = (nt >= 18) ? 512 : 128;
                gemm_ws<2, false, true, 2>(lm, 16, 2, as, bl, ep);
            }
        }
    }
    xcd_barrier(bar);
    if (AMP_PH >= 0 && blockIdx.x == 0 && threadIdx.x == 0) ((volatile unsigned long long*)(p.ctrl + 15360))[3] = wall_clock64();
    }
    STOP_AT(2);

    for (int rep_ = 0; rep_ < REPS(3); ++rep_) {
    const int tid = ltid(), lane = tid & 63, w = tid >> 6; (void)lane; (void)w;
    for (int u2 = bid; u2 < 256; u2 += nb) {
        const int tokr = u2 * 64 + (tid >> 3), part = tid & 7;
        const bf16_t* kp = p.proj + (size_t)tokr * LD + DKOFF + part * 64;
        float sq = 0.f;
#pragma unroll
        for (int c8 = 0; c8 < 8; ++c8) {
            const u32x4 v = *(const u32x4*)(kp + c8 * 8);
            const float e0 = bflo(v.x), e1 = bfhi(v.x), e2 = bflo(v.y), e3 = bfhi(v.y), e4 = bflo(v.z), e5 = bfhi(v.z), e6 = bflo(v.w), e7 = bfhi(v.w);
            sq += e0 * e0 + e1 * e1 + e2 * e2 + e3 * e3 + e4 * e4 + e5 * e5 + e6 * e6 + e7 * e7;
        }
        sq = fmaxf(sq, __shfl_xor(sq, 8)); sq = fmaxf(sq, __shfl_xor(sq, 16)); sq = fmaxf(sq, __shfl_xor(sq, 32));
        float* kred = (float*)lm;
        __syncthreads();
        if (lane < 8) kred[w * 8 + lane] = sq;
        __syncthreads();
        if (tid < 8) {
            float mx = kred[tid];
#pragma unroll
            for (int w2 = 1; w2 < 8; ++w2) mx = fmaxf(mx, kred[w2 * 8 + tid]);
            atomicMax(p.ctrl + CT_KMAX + 64 * ((u2 >> 7) * 8 + tid), __float_as_uint(mx));
        }
    }
    for (int u = bid; u < 256; u += nb) {
        const int kv = u >> 7, bb = (u >> 6) & 1, g = (u >> 5) & 1, ch = u & 31, n0 = ch * 16;
        bf16_t* raw = (bf16_t*)lm;
        float* hid = (float*)(lm + 272 * 128);
        __syncthreads();
        for (int i = tid; i < 272 * 8; i += 512) {
            const int tk = i >> 3, chn = i & 7; const int tok = 16 * n0 + tk;
            u32x4 v = (u32x4){0u, 0u, 0u, 0u};
            if (tok < SEQ) v = *(const u32x4*)(p.proj + ((size_t)bb * SEQ + tok) * LD + (kv ? VCOFF : KCOFF) + g * 64 + chn * 8);
            *(u32x4*)(raw + tk * 64 + chn * 8) = v;
        }
        __syncthreads();
        const int rr = tid >> 5, c2 = tid & 31;
        float* wl = (float*)(lm + 272 * 128 + 4096);
        float a0 = 0.f, a1 = 0.f;
        {
            const int n = tid & 63, part = tid >> 6; float sacc = 0.f;
#pragma unroll
            for (int jq = 0; jq < 16; ++jq) sacc += p.misc[1024 + (kv * 128 + part * 16 + jq) * 64 + n];
            hid[part * 64 + n] = sacc;
            __syncthreads();
#pragma unroll
            for (int pp = 0; pp < 8; ++pp) { a0 += hid[pp * 64 + 2 * c2]; a1 += hid[pp * 64 + 2 * c2 + 1]; }
        }
        const float* w1g = p.w_cmp1 + (size_t)kv * 2048 * 64;
        f32x4 wv[8];
#pragma unroll
        for (int j = 0; j < 8; ++j) wv[j] = *(const f32x4*)(w1g + (size_t)(tid + 512 * j) * 4);
        for (int chk = 0; chk < 8; ++chk) {
            __syncthreads();
#pragma unroll
            for (int j = 0; j < 8; ++j) *(f32x4*)(wl + (tid + 512 * j) * 4) = wv[j];
            __syncthreads();
            if (chk + 1 < 8) {
#pragma unroll
                for (int j = 0; j < 8; ++j) wv[j] = *(const f32x4*)(w1g + (size_t)(chk + 1) * 16384 + (size_t)(tid + 512 * j) * 4);
            }
            for (int i4 = 0; i4 < 4; ++i4) {
                const bf16_t* rp = raw + (16 * rr + chk * 4 + i4) * 64;
#pragma unroll 2
                for (int d8 = 0; d8 < 8; ++d8) {
                    const u32x4 rv = *(const u32x4*)(rp + d8 * 8);
                    const float av[8] = {bflo(rv.x), bfhi(rv.x), bflo(rv.y), bfhi(rv.y), bflo(rv.z), bfhi(rv.z), bflo(rv.w), bfhi(rv.w)};
#pragma unroll
                    for (int e = 0; e < 8; ++e) { const float2 wv2 = *(const float2*)(wl + (i4 * 64 + d8 * 8 + e) * 64 + 2 * c2); a0 += av[e] * wv2.x; a1 += av[e] * wv2.y; }
                }
            }
        }
        __syncthreads();
        {
            const float k0 = 0.7978845608028654f, k1 = 0.044715f;
            const float t0 = tanhf(k0 * (a0 + k1 * a0 * a0 * a0)), t1 = tanhf(k0 * (a1 + k1 * a1 * a1 * a1));
            hid[rr * 64 + 2 * c2] = 0.5f * a0 * (1.0f + t0); hid[rr * 64 + 2 * c2 + 1] = 0.5f * a1 * (1.0f + t1);
        }
        __syncthreads();
        for (int i = tid; i < 1024; i += 512) *(f32x4*)(wl + i * 4) = *(const f32x4*)(p.w_cmp2 + (size_t)kv * 4096 + i * 4);
        __syncthreads();
        float o0 = 0.f, o1 = 0.f;
#pragma unroll 8
        for (int jx = 0; jx < 64; ++jx) { const float hv = hid[rr * 64 + jx]; const float2 wv = *(const float2*)(wl + jx * 64 + 2 * c2); o0 += hv * wv.x; o1 += hv * wv.y; }
        const int n = n0 + rr;
        if (n < 511) {
            if (kv == 0) { *(unsigned*)(p.kc + ((size_t)(bb * 2 + g) * 512 + n) * 64 + 2 * c2) = cvt_pk_bf16(o0, o1); }
            else { p.vcT[((size_t)(bb * 2 + g) * 64 + 2 * c2) * 512 + n] = f2bf(o0); p.vcT[((size_t)(bb * 2 + g) * 64 + 2 * c2 + 1) * 512 + n] = f2bf(o1); }
        }
    }
    xcd_barrier(bar);
    if (AMP_PH >= 0 && blockIdx.x == 0 && threadIdx.x == 0) ((volatile unsigned long long*)(p.ctrl + 15360))[4] = wall_clock64();
    }
    STOP_AT(3);

    for (int rep_ = 0; rep_ < REPS(4); ++rep_) {
    const int tid = ltid(), lane = tid & 63, w = tid >> 6; (void)lane; (void)w;
    {
        int u;
        for (;;) {
            __syncthreads();
            if (tid == 0) bc[0] = (int)atomicAdd(p.ctrl + CT_Q + 64 * rep_, 1u);
            __syncthreads();
            u = bc[0];
            if (u >= 512) break;
            const int qk = 63 - (u >> 3), bh = u & 7;
            if (!(PROBE_PH == 4 && rep_ == 0 && (PROBE_VAR == 2 || PROBE_VAR >= 20))) diff_unit(p, lm, bh >> 2, bh & 3, qk, (PROBE_PH == 4 && rep_ == 0) ? PROBE_VAR : 0);
        }
        while (u < 1024) {
            const int v = u - 512; const int qb = 127 - (v >> 2), bg = v & 3;
            if (!(PROBE_PH == 4 && rep_ == 0 && (PROBE_VAR == 1 || (PROBE_VAR >= 11 && PROBE_VAR < 20)))) nsa_unit(p, lm, bg >> 1, bg & 1, qb, (PROBE_PH == 4 && rep_ == 0) ? PROBE_VAR : 0);
            __syncthreads();
            if (tid == 0) bc[0] = (int)atomicAdd(p.ctrl + CT_Q + 64 * rep_, 1u);
            __syncthreads();
            u = bc[0];
        }
    }
    xcd_barrier(bar);
    if (AMP_PH >= 0 && blockIdx.x == 0 && threadIdx.x == 0) ((volatile unsigned long long*)(p.ctrl + 15360))[5] = wall_clock64();
    }
    STOP_AT(4);

    for (int rep_ = 0; rep_ < REPS(5); ++rep_) {
    const int tid = ltid(), lane = tid & 63, w = tid >> 6; (void)lane; (void)w;
    for (int xo = 0; xo < 8; ++xo) {
        const int x = (int)((xcc + xo) & 7u);
        unsigned* qc = p.ctrl + 13312 + 64 * (8 * rep_ + x);
        for (;;) {
            __syncthreads();
            if (tid == 0) bc[0] = (int)atomicAdd(qc, 1u);
            __syncthreads();
            const int v = bc[0];
            if (v >= 64) break;
            const int mg = x + 8 * (v >> 3), nt = v & 7;
            ((int*)(lm + G_ROWOFF))[tid & 255] = (mg * 256 + (tid & 255)) * DM;
            __syncthreads();
            ASrcPlain as; as.base = p.ocat;
            BLqPlain bl; bl.wt = p.wT + (size_t)(2944 + nt * 128) * 1024;
            EpiF32W<4> ep; ep.o = p.y; ep.ldo = 1024; ep.row0 = mg * 256; ep.col0 = nt * 128;
            gemm_ws<2, true, true, 2>(lm, 16, 2, as, bl, ep);
        }
    }
    xcd_barrier(bar);
    if (AMP_PH >= 0 && blockIdx.x == 0 && threadIdx.x == 0) ((volatile unsigned long long*)(p.ctrl + 15360))[6] = wall_clock64();
    }
    STOP_AT(5);

    for (int rep_ = 0; rep_ < REPS(6); ++rep_) {
    const int tid = ltid(), lane = tid & 63, w = tid >> 6; (void)lane; (void)w;
    for (int row0 = bid * 8 + w; row0 < T_TOK; row0 += nb * 16) {
        const int row1r = row0 + nb * 8; const bool has1 = row1r < T_TOK; const int row1 = has1 ? row1r : row0;
        f32x4 yv[2][4], xv[2][4]; float ss[2] = {0.f, 0.f};
#pragma unroll
        for (int j = 0; j < 4; ++j) {
            yv[0][j] = *(const f32x4*)(p.y + (size_t)row0 * DM + lane * 4 + 256 * j); yv[1][j] = *(const f32x4*)(p.y + (size_t)row1 * DM + lane * 4 + 256 * j);
            xv[0][j] = *(const f32x4*)(p.x + (size_t)row0 * DM + lane * 4 + 256 * j); xv[1][j] = *(const f32x4*)(p.x + (size_t)row1 * DM + lane * 4 + 256 * j);
        }
#pragma unroll
        for (int rr = 0; rr < 2; ++rr)
#pragma unroll
            for (int j = 0; j < 4; ++j) ss[rr] += yv[rr][j][0] * yv[rr][j][0] + yv[rr][j][1] * yv[rr][j][1] + yv[rr][j][2] * yv[rr][j][2] + yv[rr][j][3] * yv[rr][j][3];
        ss[0] = wave_sum(ss[0]); ss[1] = wave_sum(ss[1]);
        float ss2[2] = {0.f, 0.f};
#pragma unroll
        for (int rr = 0; rr < 2; ++rr) {
            const int row = rr ? row1 : row0; const float* md = p.mod + (row >> 13) * 6144;
            const float rs = rsqrtf(ss[rr] * (1.0f / 1024.0f) + RMS_EPS);
#pragma unroll
            for (int j = 0; j < 4; ++j) {
                const int col = lane * 4 + 256 * j;
                const f32x4 g = *(const f32x4*)(p.norm_g + 1024 + col), g1 = *(const f32x4*)(md + 2048 + col);
#pragma unroll
                for (int i = 0; i < 4; ++i) { xv[rr][j][i] = xv[rr][j][i] + g1[i] * (yv[rr][j][i] * rs * g[i]); ss2[rr] += xv[rr][j][i] * xv[rr][j][i]; }
                if (rr == 0 || has1) *(f32x4*)(p.out + (size_t)row * DM + col) = xv[rr][j];
            }
        }
        ss2[0] = wave_sum(ss2[0]); ss2[1] = wave_sum(ss2[1]);
#pragma unroll
        for (int rr = 0; rr < 2; ++rr) {
            const int row = rr ? row1 : row0; const float* md = p.mod + (row >> 13) * 6144;
            const float rs2 = rsqrtf(ss2[rr] * (1.0f / 1024.0f) + RMS_EPS);
            if (rr == 0 || has1) {
#pragma unroll
                for (int j = 0; j < 4; ++j) {
                    const int col = lane * 4 + 256 * j;
                    const f32x4 g = *(const f32x4*)(p.norm_g + 2048 + col), s2 = *(const f32x4*)(md + 4096 + col), h2 = *(const f32x4*)(md + 3072 + col);
                    float hv[4], lo[4];
#pragma unroll
                    for (int i = 0; i < 4; ++i) { hv[i] = xv[rr][j][i] * rs2 * g[i] * (1.0f + s2[i]) + h2[i]; lo[i] = hv[i] - bf2f(f2bf(hv[i])); }
                    u32x2 uh, ul; uh.x = cvt_pk_bf16(hv[0], hv[1]); uh.y = cvt_pk_bf16(hv[2], hv[3]); ul.x = cvt_pk_bf16(lo[0], lo[1]); ul.y = cvt_pk_bf16(lo[2], lo[3]);
                    *(u32x2*)(p.hhi + (size_t)row * DM + col) = uh; *(u32x2*)(p.hlo + (size_t)row * DM + col) = ul;
                }
            }
        }
    }
    xcd_barrier(bar);
    if (AMP_PH >= 0 && blockIdx.x == 0 && threadIdx.x == 0) ((volatile unsigned long long*)(p.ctrl + 15360))[7] = wall_clock64();
    }
    STOP_AT(6);

    for (int rep_ = 0; rep_ < REPS(7); ++rep_) {
    const int tid = ltid(), lane = tid & 63, w = tid >> 6; (void)lane; (void)w;
    for (int u = bid; u < 256; u += nb) {
        const int nt = u / 128, mt = u % 128;
        __syncthreads();
        if (tid < 128) ((int*)(lm + G_ROWOFF))[tid] = (mt * 128 + tid) * DM;
        __syncthreads();
        ASrcRouter as; as.hi = p.hhi; as.lo = p.hlo;
        BLqRouter bl; bl.wt = p.wT + (size_t)(2944 + 1024 + nt * 128) * 1024;
        EpiF32<2> ep; ep.o = p.logits; ep.ldo = 256; ep.row0 = mt * 128; ep.col0 = nt * 128;
        gemm_big<1, true, 4, ASrcRouter, BLqRouter, EpiF32<2>, 4, true>(lm, 48, 1, as, bl, ep);
    }
    xcd_barrier(bar);
    if (AMP_PH >= 0 && blockIdx.x == 0 && threadIdx.x == 0) ((volatile unsigned long long*)(p.ctrl + 15360))[8] = wall_clock64();
    }
    STOP_AT(7);

    {
    const int tid = ltid(), lane = tid & 63, w = tid >> 6; (void)lane; (void)w;
    int* lhist = (int*)lm;
    __syncthreads();
    if (tid < 256) lhist[tid] = 0;
    __syncthreads();
    for (int tok = bid * 8 + w; tok < T_TOK; tok += nb * 8) {
        const f32x4 lg = *(const f32x4*)(p.logits + (size_t)tok * 256 + lane * 4);
        const f32x4 rb = *(const f32x4*)(p.router_bias + lane * 4);
        float aff[4], ch[4];
#pragma unroll
        for (int i = 0; i < 4; ++i) { aff[i] = 1.0f / (1.0f + __expf(-lg[i])); ch[i] = aff[i] + rb[i]; }
        float m1 = fmaxf(ch[0], ch[1]), m2 = fminf(ch[0], ch[1]);
#pragma unroll
        for (int i = 2; i < 4; ++i) { const float v = ch[i]; if (v > m1) { m2 = m1; m1 = v; } else if (v > m2) m2 = v; }
        { float o1 = dppf<0xB1>(m1), o2 = dppf<0xB1>(m2); float n1 = fmaxf(m1, o1), n2 = fmaxf(fminf(m1, o1), fmaxf(m2, o2)); m1 = n1; m2 = n2;
          o1 = dppf<0x4E>(m1); o2 = dppf<0x4E>(m2); n1 = fmaxf(m1, o1); n2 = fmaxf(fminf(m1, o1), fmaxf(m2, o2)); m1 = n1; m2 = n2;
          o1 = dppf<0x141>(m1); o2 = dppf<0x141>(m2); n1 = fmaxf(m1, o1); n2 = fmaxf(fminf(m1, o1), fmaxf(m2, o2)); m1 = n1; m2 = n2; }
        const float gs = m1 + m2; const int grp = lane >> 3;
        int rank = 0;
#pragma unroll
        for (int g2 = 0; g2 < 8; ++g2) { const float og = __builtin_bit_cast(float, __builtin_amdgcn_readlane(__builtin_bit_cast(int, gs), g2 * 8)); if (og > gs || (og == gs && g2 < grp)) ++rank; }
        const bool gsel = rank < 4;
#pragma unroll
        for (int i = 0; i < 4; ++i) if (!gsel) ch[i] = -INFINITY;
        int myidx = 0; float myaff = 0.f, asum = 0.f;
        for (int it = 0; it < 8; ++it) {
            float bv = ch[0]; int bi = lane * 4;
#pragma unroll
            for (int i = 1; i < 4; ++i) if (ch[i] > bv) { bv = ch[i]; bi = lane * 4 + i; }
            const float M = wave_max_dpp(bv);
            const unsigned long long bal = __ballot(bv == M);
            const int L = (int)__builtin_ctzll(bal);
            bi = __builtin_amdgcn_readlane(bi, L);
            float av = 0.f;
            if (L == lane) {
#pragma unroll
                for (int i = 0; i < 4; ++i) if ((bi & 3) == i) { av = aff[i]; ch[i] = -INFINITY; }
            }
            av = __builtin_bit_cast(float, __builtin_amdgcn_readlane(__builtin_bit_cast(int, av), L));
            asum += av;
            if (lane == it) { myidx = bi; myaff = av; }
        }
        if (lane < 8) {
            const float wt = myaff / asum * 2.5f;
            const int rk = atomicAdd(&lhist[myidx], 1);
            uint2 en; en.x = (unsigned)myidx | ((unsigned)rk << 16); en.y = __float_as_uint(wt);
            p.asg[(size_t)tok * 8 + lane] = en;
        }
    }
    __syncthreads();
    if (tid < 256) { p.bh[tid * 256 + (bid & 255)] = lhist[tid]; for (int b2 = bid + nb; b2 < 256; b2 += nb) p.bh[tid * 256 + b2] = 0; }
    }
    xcd_barrier(bar);
    {
    const int tid = ltid(), lane = tid & 63, w = tid >> 6; (void)lane; (void)w;
    int* loff = (int*)lm;
    __syncthreads();
    for (int e = w; e < 256; e += 8) {
        const int4 c4 = *(const int4*)(p.bh + e * 256 + lane * 4);
        const int b0 = lane * 4;
        int below = (b0 < bid ? c4.x : 0) + (b0 + 1 < bid ? c4.y : 0) + (b0 + 2 < bid ? c4.z : 0) + (b0 + 3 < bid ? c4.w : 0);
        int tot = c4.x + c4.y + c4.z + c4.w;
#pragma unroll
        for (int o = 32; o >= 1; o >>= 1) { below += __shfl_xor(below, o); tot += __shfl_xor(tot, o); }
        if (lane == 0) { loff[e] = below; if (bid == 0) p.ctrl[CT_CNT + e] = (unsigned)tot; }
    }
    __syncthreads();
    for (int tok = bid * 8 + w; tok < T_TOK; tok += nb * 8) {
        if (lane < 8) {
            const uint2 en = p.asg[(size_t)tok * 8 + lane];
            const int e = (int)(en.x & 0xffffu), rk = (int)(en.x >> 16);
            uint2 o; o.x = (unsigned)(tok * 9 + lane); o.y = en.y;
            p.bucket[(size_t)e * CAP + loff[e] + rk] = o;
        }
    }
    }
    xcd_barrier(bar);
    STOP_AT(8);

    for (int rep_ = 0; rep_ < REPS(9); ++rep_) {
    const int tid = ltid(), lane = tid & 63, w = tid >> 6; (void)lane; (void)w;
    moe_phase<1>(p, lds, xcc, rep_);
    xcd_barrier(bar);
    if (AMP_PH >= 0 && blockIdx.x == 0 && threadIdx.x == 0) ((volatile unsigned long long*)(p.ctrl + 15360))[10] = wall_clock64();
    }
    STOP_AT(9);
    for (int rep_ = 0; rep_ < REPS(10); ++rep_) {
    moe_down_phase(p, lds, xcc, rep_);
    xcd_barrier(bar);
    if (AMP_PH >= 0 && blockIdx.x == 0 && threadIdx.x == 0) ((volatile unsigned long long*)(p.ctrl + 15360))[11] = wall_clock64();
    }
    STOP_AT(10);

    {
    const int tid = ltid(), lane = tid & 63, w = tid >> 6; (void)lane; (void)w;
    for (int row = bid * 8 + w; row < T_TOK; row += nb * 8) {
        const int bb = row >> 13; const float* md = p.mod + bb * 6144;
        float acc[16];
#pragma unroll
        for (int i = 0; i < 16; ++i) acc[i] = 0.f;
        const bf16_t* sp = p.yslot + (size_t)row * 9 * 1024;
        for (int k = 0; k < 9; ++k) {
#pragma unroll
            for (int j = 0; j < 2; ++j) {
                const u32x4 v = *(const u32x4*)(sp + (size_t)k * 1024 + lane * 8 + 512 * j);
                acc[8 * j + 0] += bflo(v.x); acc[8 * j + 1] += bfhi(v.x); acc[8 * j + 2] += bflo(v.y); acc[8 * j + 3] += bfhi(v.y);
                acc[8 * j + 4] += bflo(v.z); acc[8 * j + 5] += bfhi(v.z); acc[8 * j + 6] += bflo(v.w); acc[8 * j + 7] += bfhi(v.w);
            }
        }
        float ss = 0.f;
#pragma unroll
        for (int i = 0; i < 16; ++i) ss += acc[i] * acc[i];
        ss = wave_sum(ss);
        const float rs = rsqrtf(ss * (1.0f / 1024.0f) + RMS_EPS);
#pragma unroll
        for (int j = 0; j < 2; ++j)
#pragma unroll
            for (int hf = 0; hf < 2; ++hf) {
                const int col = lane * 8 + 512 * j + 4 * hf;
                const f32x4 g = *(const f32x4*)(p.norm_g + 3072 + col), g2 = *(const f32x4*)(md + 5120 + col);
                f32x4 x1 = *(const f32x4*)(p.out + (size_t)row * DM + col);
#pragma unroll
                for (int i = 0; i < 4; ++i) x1[i] += g2[i] * (acc[8 * j + 4 * hf + i] * rs * g[i]);
                *(f32x4*)(p.out + (size_t)row * DM + col) = x1;
            }
    }
    }
    if (AMP_PH >= 0 && blockIdx.x == 0 && threadIdx.x == 0) {
        volatile unsigned long long* ts = (volatile unsigned long long*)(p.ctrl + 15360);
        const unsigned long long tend = wall_clock64();
        const unsigned long long a = ts[AMP_PH], b = (AMP_PH + 1 <= 11) ? ts[AMP_PH + 1] : tend;
        const unsigned long long dt = (b - a) * AMP_MUL, t0 = wall_clock64();
        while (wall_clock64() - t0 < dt) __builtin_amdgcn_s_sleep(8);
    }
}

static inline size_t al256(size_t v) { return (v + 255) & ~(size_t)255; }

extern "C" void kernel_launch(void* const* d_in, const int* in_sizes, int n_in, void* d_out, int out_size, void* d_ws, size_t ws_size, hipStream_t stream) {
    (void)in_sizes; (void)n_in; (void)out_size;
    Params p{};
    p.x = (const float*)d_in[0]; p.c = (const float*)d_in[1]; p.w_ada = (const float*)d_in[2]; p.b_ada = (const float*)d_in[3];
    p.norm_g = (const float*)d_in[4]; p.w_in = (const float*)d_in[5]; p.w_cmp1 = (const float*)d_in[6]; p.w_cmp2 = (const float*)d_in[7];
    p.pe_cmp = (const float*)d_in[8]; p.diff_lambda = (const float*)d_in[9]; p.diff_subln = (const float*)d_in[10]; p.w_out = (const float*)d_in[11];
    p.w_router = (const float*)d_in[12]; p.router_bias = (const float*)d_in[13]; p.w_gate_up = (const float*)d_in[14]; p.w_down = (const float*)d_in[15];
    p.ws_gate_up = (const float*)d_in[16]; p.ws_down = (const float*)d_in[17];
    p.out = (float*)d_out;
    char* ws = (char*)d_ws; size_t off = 0;
    auto take = [&](size_t bytes) { char* r = ws + off; off = al256(off + bytes); return r; };
    p.ctrl = (unsigned*)take((size_t)CT_WORDS * 4);
    p.mod = (float*)take(2 * 6144 * 4);
    p.misc = (float*)take((1024 + 256 * 64) * 4);
    p.wT = (bf16_t*)take((size_t)(2944 + 1024 + 512) * 1024 * 2);
    p.hmix = (bf16_t*)take((size_t)T_TOK * DM * 2);
    p.proj = (bf16_t*)take((size_t)T_TOK * LD * 2);
    p.vselT = (bf16_t*)take((size_t)256 * SEQ * 2);
    p.vwinT = (bf16_t*)take((size_t)256 * SEQ * 2);
    p.dvT = (bf16_t*)take((size_t)1024 * SEQ * 2);
    p.kc = (bf16_t*)take((size_t)4 * 512 * 64 * 2);
    p.vcT = (bf16_t*)take((size_t)4 * 64 * 512 * 2);
    p.ocat = (bf16_t*)take((size_t)T_TOK * DM * 2);
    p.y = (float*)take((size_t)T_TOK * DM * 4);
    p.hhi = (bf16_t*)take((size_t)T_TOK * DM * 2);
    p.hlo = (bf16_t*)take((size_t)T_TOK * DM * 2);
    p.logits = (float*)take((size_t)T_TOK * 256 * 4);
    p.bucket = (uint2*)take((size_t)NEXP * CAP * 8);
    p.asg = (uint2*)take((size_t)T_TOK * 8 * 8);
    p.bh = (int*)take((size_t)256 * 256 * 4);
    p.H = (bf16_t*)take((size_t)T_TOK * 9 * 256 * 2);
    p.yslot = (bf16_t*)take((size_t)T_TOK * 9 * 1024 * 2);

    if (ws_size < off) { fprintf(stderr, "workspace too small: %zu < %zu\n", ws_size, off); return; }
    static int grid = 0;
    if (!grid) {
        int dev = 0, cus = 0, per_cu = 0;
        hipGetDevice(&dev);
        hipDeviceGetAttribute(&cus, hipDeviceAttributeMultiprocessorCount, dev);
        hipFuncSetAttribute((const void*)fwd_kernel, hipFuncAttributeMaxDynamicSharedMemorySize, LDS_BYTES);
        hipOccupancyMaxActiveBlocksPerMultiprocessor(&per_cu, fwd_kernel, 512, LDS_BYTES);
        if (per_cu < 1) fprintf(stderr, "occupancy query says the kernel does not fit\n");
        grid = cus > 0 ? cus : 256;
    }
    hipMemsetAsync(p.ctrl, 0, (size_t)CT_WORDS * 4, stream);
    hipLaunchKernelGGL(fwd_kernel, dim3(grid), dim3(512), LDS_BYTES, stream, p);
}
```

```cpp
#include <hip/hip_runtime.h>
#include <stdint.h>
#include <stdio.h>
#ifndef PROBE_PH
#define PROBE_PH -1
#endif
#define REPS(k) ((PROBE_PH == (k)) ? 2 : 1)
#ifndef AMP_PH
#define AMP_PH -1
#endif
#define AMP_MUL 1

typedef unsigned short bf16_t;
typedef short bf16x8 __attribute__((ext_vector_type(8)));
typedef short bf16x4 __attribute__((ext_vector_type(4)));
typedef float f32x4 __attribute__((ext_vector_type(4)));
typedef float f32x16 __attribute__((ext_vector_type(16)));
typedef unsigned u32x4 __attribute__((ext_vector_type(4)));
typedef unsigned u32x2 __attribute__((ext_vector_type(2)));

#define DEV __device__ __forceinline__

constexpr int T_TOK = 16384, SEQ = 8192, DM = 1024;
constexpr int LD = 2944;
constexpr int QOFF = 0, KCOFF = 512, VCOFF = 640, KSOFF = 768, VSOFF = 896, KWOFF = 1024, VWOFF = 1152,
              DQOFF = 1280, DKOFF = 1792, DVOFF = 2304, GTOFF = 2816;
constexpr int NEXP = 256, CAP = 16384;
constexpr float LOG2E = 1.4426950408889634f;
constexpr float RMS_EPS = 1e-6f;
DEV int swz(int row, int chunk) { return row * 128 + ((chunk ^ ((row >> 1) & 7)) << 4); }

typedef __bf16 bf16v2_t __attribute__((ext_vector_type(2)));
DEV unsigned cvt_pk_bf16(float lo, float hi) { bf16v2_t v; v[0] = (__bf16)lo; v[1] = (__bf16)hi; return __builtin_bit_cast(unsigned, v); }
DEV bf16_t f2bf(float f) { unsigned u = __float_as_uint(f); u += 0x7FFFu + ((u >> 16) & 1u); return (bf16_t)(u >> 16); }
DEV float bf2f(bf16_t b) { return __uint_as_float(((unsigned)b) << 16); }
DEV float bflo(unsigned w) { return __uint_as_float(w << 16); }
DEV float bfhi(unsigned w) { return __uint_as_float(w & 0xffff0000u); }
DEV float fexp2(float x) { return __builtin_amdgcn_exp2f(x); }
DEV float sigmoidf_(float x) { return 1.0f / (1.0f + __expf(-x)); }
DEV int ltid() { int t = threadIdx.x; asm volatile("" : "+v"(t)); return t; }
DEV int crow(int r, int hi) { return (r & 3) + 8 * (r >> 2) + 4 * hi; }
template <int CTRL> DEV float dppf(float v) { return __builtin_bit_cast(float, __builtin_amdgcn_update_dpp(0, __builtin_bit_cast(int, v), CTRL, 0xF, 0xF, true)); }
DEV float wave_max_dpp(float v) {
    v = fmaxf(v, dppf<0xB1>(v)); v = fmaxf(v, dppf<0x4E>(v)); v = fmaxf(v, dppf<0x141>(v)); v = fmaxf(v, dppf<0x140>(v));
    const float a = __builtin_bit_cast(float, __builtin_amdgcn_readlane(__builtin_bit_cast(int, v), 0)), b = __builtin_bit_cast(float, __builtin_amdgcn_readlane(__builtin_bit_cast(int, v), 16));
    const float c = __builtin_bit_cast(float, __builtin_amdgcn_readlane(__builtin_bit_cast(int, v), 32)), d = __builtin_bit_cast(float, __builtin_amdgcn_readlane(__builtin_bit_cast(int, v), 48));
    return fmaxf(fmaxf(a, b), fmaxf(c, d));
}
DEV float wave_sum(float v) {
    v += dppf<0xB1>(v); v += dppf<0x4E>(v); v += dppf<0x141>(v); v += dppf<0x140>(v);
    const float a = __builtin_bit_cast(float, __builtin_amdgcn_readlane(__builtin_bit_cast(int, v), 0)), b = __builtin_bit_cast(float, __builtin_amdgcn_readlane(__builtin_bit_cast(int, v), 16));
    const float c = __builtin_bit_cast(float, __builtin_amdgcn_readlane(__builtin_bit_cast(int, v), 32)), d = __builtin_bit_cast(float, __builtin_amdgcn_readlane(__builtin_bit_cast(int, v), 48));
    return (a + b) + (c + d);
}
DEV int wave_sum_i(int v) {
    v += __builtin_amdgcn_update_dpp(0, v, 0xB1, 0xF, 0xF, true); v += __builtin_amdgcn_update_dpp(0, v, 0x4E, 0xF, 0xF, true);
    v += __builtin_amdgcn_update_dpp(0, v, 0x141, 0xF, 0xF, true); v += __builtin_amdgcn_update_dpp(0, v, 0x140, 0xF, 0xF, true);
    return __builtin_amdgcn_readlane(v, 0) + __builtin_amdgcn_readlane(v, 16) + __builtin_amdgcn_readlane(v, 32) + __builtin_amdgcn_readlane(v, 48);
}

#define XB_TMO      128
#define XB_XCNT(j)  (256  + 64 * (j))
#define XB_XSUB(j)  (1280 + 64 * (j))
#define XB_XGEN(j)  (2304 + 64 * (j))
#define XB_TOP      3328
#define XB_TOPGEN   3392
#define XCD_BAR_WORDS 3456
#define XB_SPIN_CAP (1u << 20)
#define LAS __attribute__((address_space(3)))

__device__ __forceinline__ unsigned xb_ld(unsigned* p)              { return __hip_atomic_load(p, __ATOMIC_RELAXED, __HIP_MEMORY_SCOPE_AGENT); }
__device__ __forceinline__ unsigned xb_add(unsigned* p, unsigned v) { return __hip_atomic_fetch_add(p, v, __ATOMIC_RELAXED, __HIP_MEMORY_SCOPE_AGENT); }
__device__ __forceinline__ unsigned xb_xcc_id() { return (unsigned)__builtin_amdgcn_s_getreg((3 << 11) | 20) & 0xFu; }
#define XB_SPIN(cond, bar) do { unsigned _sp = 0; while (cond) { __builtin_amdgcn_s_sleep(1); \
    if ((++_sp & 255u) == 0u) { if (xb_ld(&(bar)[XB_TMO])) break; if (_sp > XB_SPIN_CAP) { atomicAdd(&(bar)[XB_TMO], 1u); break; } } } } while (0)

struct XcdBarrier {
    unsigned* bar; unsigned x;
    volatile LAS unsigned* st;
};
__device__ __forceinline__ XcdBarrier xcd_barrier_post(unsigned* bar, volatile LAS unsigned* st) {
    XcdBarrier b; b.bar = bar; b.x = xb_xcc_id(); b.st = st;
    if (threadIdx.x == 0) (void)xb_add(&bar[XB_XCNT(b.x)], 1u);
    return b;
}
__device__ __forceinline__ void xcd_barrier_complete(unsigned* bar, unsigned x, unsigned& nloc, unsigned& nx) {
    const unsigned G = gridDim.x * gridDim.y * gridDim.z;
    unsigned sum, cnt, mine, sp = 0u;
    for (;;) {
        sum = 0u; cnt = 0u; mine = 0u;
#pragma unroll
        for (unsigned j = 0; j < 16; ++j) { const unsigned c = xb_ld(&bar[XB_XCNT(j)]); sum += c; cnt += (c > 0u) ? 1u : 0u; mine = (j == x) ? c : mine; }
        if (sum == G) break;
        __builtin_amdgcn_s_sleep(1);
        if ((++sp & 255u) == 0u) { if (xb_ld(&bar[XB_TMO])) break; if (sp > XB_SPIN_CAP) { atomicAdd(&bar[XB_TMO], 1u); break; } }
    }
    nloc = mine > 0u ? mine : 1u; nx = cnt > 0u ? cnt : 1u;
}
__device__ __forceinline__ void xcd_barrier(const XcdBarrier& b) {
    asm volatile("s_waitcnt vmcnt(0)" ::: "memory");
    __syncthreads();
    if (threadIdx.x == 0) {
        unsigned* bar = b.bar;
        __builtin_amdgcn_s_waitcnt(0);
        unsigned nloc = b.st[0], nx = b.st[1];
        if (nloc == 0u) { xcd_barrier_complete(bar, b.x, nloc, nx); b.st[0] = nloc; b.st[1] = nx; }
        const unsigned old = xb_add(&bar[XB_XSUB(b.x)], 1u);
        const unsigned gen = old / nloc;
        if (old + 1u == (gen + 1u) * nloc) {
            __builtin_amdgcn_fence(__ATOMIC_RELEASE, "agent");
            asm volatile("s_waitcnt vmcnt(0)" ::: "memory");
            const unsigned og = xb_add(&bar[XB_TOP], 1u);
            const unsigned tg = og / nx;
            if (og + 1u == (tg + 1u) * nx) xb_add(&bar[XB_TOPGEN], 1u);
            else XB_SPIN(xb_ld(&bar[XB_TOPGEN]) == tg, bar);
            __builtin_amdgcn_fence(__ATOMIC_ACQUIRE, "agent");
            xb_add(&bar[XB_XGEN(b.x)], 1u);
            asm volatile("s_waitcnt vmcnt(0)" ::: "memory");
        } else {
            XB_SPIN(xb_ld(&bar[XB_XGEN(b.x)]) == gen, bar);
            __builtin_amdgcn_fence(__ATOMIC_ACQUIRE, "agent");
            asm volatile("s_waitcnt vmcnt(0)" ::: "memory");
        }
    }
    __syncthreads();
}

struct Params {
    const float *x, *c, *w_ada, *b_ada, *norm_g, *w_in, *w_cmp1, *w_cmp2, *pe_cmp, *diff_lambda, *diff_subln,
                *w_out, *w_router, *router_bias, *w_gate_up, *w_down, *ws_gate_up, *ws_down;
    float* out;
    unsigned* ctrl;
    float* mod;
    float* misc;
    bf16_t* wT;
    bf16_t* hmix;
    bf16_t* proj;
    bf16_t* vselT;
    bf16_t* vwinT;
    bf16_t* dvT;
    bf16_t* kc;
    bf16_t* vcT;
    bf16_t* ocat;
    float* y;
    bf16_t* hhi;
    bf16_t* hlo;
    float* logits;
    uint2* bucket;
    uint2* asg;
    int* bh;
    bf16_t* H;
    bf16_t* yslot;
};
constexpr int CT_Q = 4096;
constexpr int CT_CNT = 8192;
constexpr int CT_KMAX = 12288;
constexpr int CT_WORDS = 16384;

constexpr int L_CTRL = 0;
constexpr int L_MAIN = 64;
constexpr int LDS_BYTES = 64 + 131072 + 18432 + 4096;

constexpr int G_AS = 0, G_ASZ = 49152, G_BS = 98304, G_BSZ = 16384, G_ROWOFF = 131072, G_RSLOT = 133120, G_RWT = 135168, G_PRE = 137216;
#ifndef PROBE_VAR
#define PROBE_VAR 0
#endif
template <int MS, bool TRANS, int PD, class AS, class BL, class EP, int PDB = PD, bool BF = false>
DEV void gemm_big(char* lm, int nk, int nsub, const AS& as, const BL& bl, const EP& ep, int pvar = 0) {
    static_assert(PDB % PD == 0, "the B ring depth must be a multiple of the A ring depth");
    const int tid = ltid(), lane = tid & 63, w = tid >> 6, wm = w >> 1, wn = w & 1, c = lane & 15, q = lane >> 4;
    const int* rowoff = (const int*)(lm + G_ROWOFF);
    const int ar0 = tid >> 3, akc = tid & 7;
    const int bn4 = 8 * (w & 3) + (lane & 7), bkq = 8 * (w >> 2) + (lane >> 3);
    const int rowlim = 128 * nsub;
    u32x4 ra[PD][2 * MS]; f32x4 rb[BF ? 1 : PDB][4]; u32x4 rq[BF ? PDB : 1][2];
    f32x4 acc[2 * MS][4];
#pragma unroll
    for (int mi = 0; mi < 2 * MS; ++mi)
#pragma unroll
        for (int ni = 0; ni < 4; ++ni) acc[mi][ni] = (f32x4){0.f, 0.f, 0.f, 0.f};
#define GB_LOADA(s_, ks_) do { \
        _Pragma("unroll") for (int i = 0; i < 2 * MS; ++i) if ((i >> 1) < nsub) ra[s_][i] = as.ld(rowoff[ar0 + 64 * i] + akc * 8, (ks_)); } while (0)
#define GB_LOADB(s_, ks_) do { if constexpr (BF) { rq[s_][0] = bl.ldq(ar0, (ks_), akc); rq[s_][1] = bl.ldq(ar0 + 64, (ks_), akc); } else { \
        _Pragma("unroll") for (int i = 0; i < 4; ++i) rb[s_][i] = bl.ld((ks_) * 64 + 4 * bkq + i, 4 * bn4); } } while (0)
#define GB_STORE(sa_, sb_, buf_) do { char* As_ = lm + G_AS + (buf_) * G_ASZ; char* Bs_ = lm + G_BS + (buf_) * G_BSZ; \
        _Pragma("unroll") for (int i = 0; i < 2 * MS; ++i) if ((i >> 1) < nsub) *(u32x4*)(As_ + swz(ar0 + 64 * i, akc)) = ra[sa_][i]; \
        if constexpr (BF) { *(u32x4*)(Bs_ + swz(ar0, akc)) = rq[sb_][0]; *(u32x4*)(Bs_ + swz(ar0 + 64, akc)) = rq[sb_][1]; } else { \
        _Pragma("unroll") for (int cc = 0; cc < 4; ++cc) { u32x2 v; v.x = cvt_pk_bf16(rb[sb_][0][cc], rb[sb_][1][cc]); v.y = cvt_pk_bf16(rb[sb_][2][cc], rb[sb_][3][cc]); \
            *(u32x2*)(Bs_ + swz(4 * bn4 + cc, bkq >> 1) + (bkq & 1) * 8) = v; } } } while (0)
#pragma unroll
    for (int s = 0; s < PD; ++s) {
#pragma unroll
        for (int i = 0; i < 2 * MS; ++i) ra[s][i] = (u32x4){0u, 0u, 0u, 0u};
        if (s < nk) GB_LOADA(s, s);
    }
#pragma unroll
    for (int s = 0; s < PDB; ++s) {
        if constexpr (BF) { rq[s][0] = (u32x4){0u, 0u, 0u, 0u}; rq[s][1] = (u32x4){0u, 0u, 0u, 0u}; }
        else {
#pragma unroll
            for (int i = 0; i < 4; ++i) rb[s][i] = (f32x4){0.f, 0.f, 0.f, 0.f};
        }
        if (s < nk) GB_LOADB(s, s);
    }
    __syncthreads();
    GB_STORE(0, 0, 0);
    if (PD < nk) GB_LOADA(0, PD);
    if (PDB < nk) GB_LOADB(0, PDB);
    __syncthreads();
    for (int ks0 = 0; ks0 < nk; ks0 += PDB) {
#pragma unroll
        for (int s = 0; s < PDB; ++s) {
            const int ks = ks0 + s;
            if (ks < nk) {
                const int sna = (s + 1) % PD, snb = (s + 1) % PDB;
                const char* As = lm + G_AS + (ks & 1) * G_ASZ; const char* Bs = lm + G_BS + (ks & 1) * G_BSZ;
#define GB_STAGE() do { if (ks + 1 < nk && pvar != 3) { GB_STORE(sna, snb, (ks + 1) & 1); \
                    if (pvar != 2) { if (ks + 1 + PD < nk) GB_LOADA(sna, ks + 1 + PD); if (ks + 1 + PDB < nk) GB_LOADB(snb, ks + 1 + PDB); } } } while (0)
#define GB_COMPUTE() do { if (pvar != 1 && pvar != 3) { \
                  \
                bf16x8 bq[2][4]; bf16x8 af[4 * MS]; \
                _Pragma("unroll") for (int ni = 0; ni < 4; ++ni) bq[0][ni] = *(const bf16x8*)(Bs + swz(64 * wn + 16 * ni + c, q)); \
                af[0] = *(const bf16x8*)(As + swz(32 * MS * wm + c, q)); \
                af[1] = *(const bf16x8*)(As + swz(32 * MS * wm + 16 + c, q)); \
                __builtin_amdgcn_sched_barrier(0); \
                _Pragma("unroll") for (int g = 0; g < 4 * MS; ++g) { \
                    const int kk = g / (2 * MS), mi = g % (2 * MS); \
                    if (g + 2 < 4 * MS) { const int kk2 = (g + 2) / (2 * MS), mi2 = (g + 2) % (2 * MS); af[g + 2] = *(const bf16x8*)(As + swz(32 * MS * wm + 16 * mi2 + c, 4 * kk2 + q)); } \
                    if (kk == 0 && mi < 2) { bq[1][2 * mi] = *(const bf16x8*)(Bs + swz(64 * wn + 16 * (2 * mi) + c, 4 + q)); bq[1][2 * mi + 1] = *(const bf16x8*)(Bs + swz(64 * wn + 16 * (2 * mi + 1) + c, 4 + q)); } \
                    if (32 * MS * wm + 16 * mi < rowlim) { \
                        _Pragma("unroll") for (int ni = 0; ni < 4; ++ni) \
                            acc[mi][ni] = TRANS ? __builtin_amdgcn_mfma_f32_16x16x32_bf16(bq[kk][ni], af[g], acc[mi][ni], 0, 0, 0) \
                                                : __builtin_amdgcn_mfma_f32_16x16x32_bf16(af[g], bq[kk][ni], acc[mi][ni], 0, 0, 0); \
                    } \
                    __builtin_amdgcn_sched_barrier(0); \
                } } } while (0)
                if (w < 4) { GB_STAGE(); GB_COMPUTE(); } else { GB_COMPUTE(); GB_STAGE(); }
#undef GB_STAGE
#undef GB_COMPUTE
                __syncthreads();
            }
        }
    }
#undef GB_LOADA
#undef GB_LOADB
#undef GB_STORE
    ep(acc, 32 * MS * wm, 64 * wn, rowlim, c, q);
}

struct ASrcPlain { const bf16_t* base; DEV u32x4 ld(int off, int ks) const { return *(const u32x4*)(base + off + ks * 64); } };
struct ASrcRouter {
    const bf16_t *hi, *lo;
    DEV u32x4 ld(int off, int ks) const { const int seg = ks >> 4, kk = ks & 15; return *(const u32x4*)(((seg == 1) ? lo : hi) + off + kk * 64); }
};

DEV void store_vt_chunk(char* Vs, int row, int ch, const u32x4& v) {
    const int g2 = ch & ~1, e8 = (ch & 1) * 8;
    u32x2 lo; lo.x = v.x; lo.y = v.y; u32x2 hi; hi.x = v.z; hi.y = v.w;
    *(u32x2*)(Vs + swz(row, g2) + e8) = lo;
    *(u32x2*)(Vs + swz(row, g2 + 1) + e8) = hi;
}
DEV f32x16 qk32(const char* Ks, int kt, const bf16x8 (&qf)[4], int r, int hi) {
    f32x16 a;
#pragma unroll
    for (int i = 0; i < 16; ++i) a[i] = 0.f;
#pragma unroll
    for (int s = 0; s < 4; ++s) {
        const bf16x8 kf = *(const bf16x8*)(Ks + swz(32 * kt + r, 2 * s + hi));
        a = __builtin_amdgcn_mfma_f32_32x32x16_bf16(kf, qf[s], a, 0, 0, 0);
    }
    return a;
}
template <int NDT>
DEV void pv32(const char* Vs, int kt, const bf16x8 (&pf)[2], f32x16 (&O)[NDT], int r, int hi) {
#pragma unroll
    for (int s2 = 0; s2 < 2; ++s2)
#pragma unroll
        for (int dt = 0; dt < NDT; ++dt) {
            const bf16x8 vf = *(const bf16x8*)(Vs + swz(32 * dt + r, 4 * kt + 2 * s2 + hi));
            O[dt] = __builtin_amdgcn_mfma_f32_32x32x16_bf16(vf, pf[s2], O[dt], 0, 0, 0);
        }
}
template <int NDT>
DEV void vload(const char* Vs, int kt, bf16x8 (&vf)[2 * NDT], int r, int hi) {
#pragma unroll
    for (int s2 = 0; s2 < 2; ++s2)
#pragma unroll
        for (int dt = 0; dt < NDT; ++dt) vf[s2 * NDT + dt] = *(const bf16x8*)(Vs + swz(32 * dt + r, 4 * kt + 2 * s2 + hi));
}
template <int NDT>
DEV void pvmma(const bf16x8 (&vf)[2 * NDT], const bf16x8 (&pf)[2], f32x16 (&O)[NDT]) {
#pragma unroll
    for (int s2 = 0; s2 < 2; ++s2)
#pragma unroll
        for (int dt = 0; dt < NDT; ++dt) O[dt] = __builtin_amdgcn_mfma_f32_32x32x16_bf16(vf[s2 * NDT + dt], pf[s2], O[dt], 0, 0, 0);
}
DEV void pack_p(const float (&pv)[16], bf16x8 (&pf)[2]) {
#pragma unroll
    for (int s2 = 0; s2 < 2; ++s2) {
        u32x4 u;
        u.x = cvt_pk_bf16(pv[8 * s2 + 0], pv[8 * s2 + 1]); u.y = cvt_pk_bf16(pv[8 * s2 + 2], pv[8 * s2 + 3]);
        u.z = cvt_pk_bf16(pv[8 * s2 + 4], pv[8 * s2 + 5]); u.w = cvt_pk_bf16(pv[8 * s2 + 6], pv[8 * s2 + 7]);
        pf[s2] = __builtin_bit_cast(bf16x8, u);
    }
}
DEV float xhalf_max(float v) {
    auto rr = __builtin_amdgcn_permlane32_swap(__float_as_uint(v), __float_as_uint(v), false, false);
    return fmaxf(__uint_as_float(rr[0]), __uint_as_float(rr[1]));
}
DEV float rowmax16(const float (&s)[16]) {
    float a = fmaxf(fmaxf(s[0], s[1]), s[2]), b = fmaxf(fmaxf(s[3], s[4]), s[5]);
    a = fmaxf(fmaxf(a, s[6]), s[7]); b = fmaxf(fmaxf(b, s[8]), s[9]);
    a = fmaxf(fmaxf(a, s[10]), s[11]); b = fmaxf(fmaxf(b, s[12]), s[13]);
    a = fmaxf(fmaxf(a, s[14]), s[15]);
    return xhalf_max(fmaxf(a, b));
}
constexpr float OSM_THR = 8.0f;
template <int NDT>
DEV void osm_update(float (&s)[16], float& m, float& l, f32x16 (&O)[NDT]) {
    const float mx = rowmax16(s);
    if (__any(mx > m + OSM_THR)) {
        const float mn = fmaxf(m, mx);
        const float alpha = fexp2(m - mn);
        l *= alpha; m = mn;
#pragma unroll
        for (int dt = 0; dt < NDT; ++dt)
#pragma unroll
            for (int i = 0; i < 16; ++i) O[dt][i] *= alpha;
    }
    float sum = 0.f;
#pragma unroll
    for (int i = 0; i < 16; ++i) { s[i] = fexp2(s[i] - m); sum += s[i]; }
    l += sum;
}
template <int KS, bool WIN>
DEV void make_scores(const f32x16& a, float (&s)[16], int D0, float slope2, bool selb) {
    const float sc2 = 0.125f * LOG2E;
    const float nb0 = -slope2 * (float)D0, sk = slope2 * (float)KS;
#pragma unroll
    for (int i = 0; i < 16; ++i) s[i] = fmaf(sk, (float)((i & 3) + 8 * (i >> 2)), fmaf(a[i], sc2, nb0));
    if (__any(!selb || D0 < 27 * KS || (WIN && D0 >= 512))) {
#pragma unroll
        for (int i = 0; i < 16; ++i) {
            const int dist = D0 - KS * ((i & 3) + 8 * (i >> 2));
            const bool valid = selb && dist >= 0 && (!WIN || dist < 512);
            s[i] = valid ? s[i] : -INFINITY;
        }
    }
}
DEV int first_bit4(unsigned a, unsigned b, unsigned c, unsigned d, int from) {
    if (from < 32)  { const unsigned v = a & (0xffffffffu << from); if (v) return __builtin_ctz(v); from = 32; }
    if (from < 64)  { const unsigned v = b & (0xffffffffu << (from - 32)); if (v) return 32 + __builtin_ctz(v); from = 64; }
    if (from < 96)  { const unsigned v = c & (0xffffffffu << (from - 64)); if (v) return 64 + __builtin_ctz(v); from = 96; }
    if (from < 128) { const unsigned v = d & (0xffffffffu << (from - 96)); if (v) return 96 + __builtin_ctz(v); }
    return -1;
}
DEV unsigned range_mask32(int lo, int hi, int base) {
    int a = lo - base, b = hi - base; if (a < 0) a = 0; if (b > 31) b = 31; if (a > b) return 0u;
    const unsigned up = (b == 31) ? 0xffffffffu : ((1u << (b + 1)) - 1u);
    return up & (0xffffffffu << a);
}

template <int MODE>
DEV void nsa_tile(const char* Ks, const char* Vs, float* imp, int j, unsigned mk0, unsigned mk1, unsigned mk2, unsigned mk3,
                  const bf16x8 (&qf)[4], int t, int tl, float slope2, float& m, float& l, float inv, f32x16 (&O)[2], int r, int hi, float& carry) {
    bool selb = true;
    if (MODE == 2) { const unsigned wsel = (j < 32) ? mk0 : (j < 64) ? mk1 : (j < 96) ? mk2 : mk3; selb = (wsel >> (j & 31)) & 1u; }
    if (MODE == 2 && !__any(selb)) return;
#pragma unroll
    for (int kt = 0; kt < 2; ++kt) {
        const f32x16 a = qk32(Ks, kt, qf, r, hi);
        bf16x8 vf[4];
        if (MODE != 0) vload<2>(Vs, kt, vf, r, hi);
        float s[16];
        if (MODE <= 1) make_scores<16, false>(a, s, t - 31 - 16 * (64 * j + 32 * kt + 4 * hi), slope2, true);
        else if (MODE == 2) make_scores<1, false>(a, s, t - (64 * j + 32 * kt + 4 * hi), slope2, selb);
        else make_scores<1, true>(a, s, t - (64 * j + 32 * kt + 4 * hi), slope2, true);
        if (MODE == 0) {
            const float mx = rowmax16(s);
            if (__any(mx > m + OSM_THR)) { const float mn = fmaxf(m, mx); l *= fexp2(m - mn); m = mn; }
            float sum = 0.f;
#pragma unroll
            for (int i = 0; i < 16; ++i) sum += fexp2(s[i] - m);
            l += sum;
        } else if (MODE == 1) {
#pragma unroll
            for (int i = 0; i < 16; ++i) s[i] = fexp2(s[i] - m) * inv;
            {
                float av[4], hb[4];
#pragma unroll
                for (int gi = 0; gi < 4; ++gi) {
                    hb[gi] = 0.5f * s[4 * gi + 3]; av[gi] = s[4 * gi] + s[4 * gi + 1] + s[4 * gi + 2] + hb[gi];
                    av[gi] += __shfl_xor(av[gi], 8); av[gi] += __shfl_xor(av[gi], 16);
                    hb[gi] += __shfl_xor(hb[gi], 8); hb[gi] += __shfl_xor(hb[gi], 16);
                }
                float ph[4];
#pragma unroll
                for (int gi = 0; gi < 4; ++gi) ph[gi] = __shfl_xor(hb[gi], 32);
                float val[4];
#pragma unroll
                for (int gi = 0; gi < 4; ++gi) val[gi] = av[gi] + (hi ? ph[gi] : (gi ? ph[gi - 1] : carry));
                carry = ph[3];
                if ((r >> 3) == 0) {
                    float* ip = imp + tl * 129 + 16 * j + 8 * kt + hi;
#pragma unroll
                    for (int gi = 0; gi < 4; ++gi) ip[2 * gi] = val[gi];
                }
            }
            bf16x8 pf[2]; pack_p(s, pf); pvmma<2>(vf, pf, O);
        } else {
            osm_update<2>(s, m, l, O);
            bf16x8 pf[2]; pack_p(s, pf); pvmma<2>(vf, pf, O);
        }
    }
}

template <int MODE>
DEV void nsa_branch(char* Ks, char* Vs, float* imp, const bf16_t* kbase, int kld, const bf16_t* vbase, int vld,
                    unsigned tm0, unsigned tm1, unsigned tm2, unsigned tm3, unsigned mk0, unsigned mk1, unsigned mk2, unsigned mk3,
                    const bf16x8 (&qf)[4], int t, int tl, float slope2, float& m, float& l, float inv, f32x16 (&O)[2]) {
    const int tid = ltid(), lane = tid & 63, r = lane & 31, hi = lane >> 5, krow = tid >> 3, kch = tid & 7;
    const u32x4 z4 = (u32x4){0u, 0u, 0u, 0u};
    u32x4 rkA = z4, rvA = z4, rkB = z4, rvB = z4, rkC = z4, rvC = z4; int jA, jB, jC;
    float carry = 0.f;
    int jn = first_bit4(tm0, tm1, tm2, tm3, 0);
#define NSA_LDT(rk, rv, jr) do { jr = jn; if (jn >= 0) { \
        rk = *(const u32x4*)(kbase + (size_t)(64 * jn + krow) * kld + kch * 8); \
        if (MODE != 0) rv = *(const u32x4*)(vbase + (size_t)krow * vld + 64 * jn + kch * 8); \
        jn = first_bit4(tm0, tm1, tm2, tm3, jn + 1); } } while (0)
#define NSA_STEP(rk, rv, jr) do { const int j = jr; \
        __syncthreads(); \
        *(u32x4*)(Ks + swz(krow, kch)) = rk; \
        if (MODE != 0) store_vt_chunk(Vs, krow, kch, rv); \
        __syncthreads(); \
        NSA_LDT(rk, rv, jr); \
        nsa_tile<MODE>(Ks, Vs, imp, j, mk0, mk1, mk2, mk3, qf, t, tl, slope2, m, l, inv, O, r, hi, carry); } while (0)
    NSA_LDT(rkA, rvA, jA); NSA_LDT(rkB, rvB, jB); NSA_LDT(rkC, rvC, jC);
    for (;;) {
        if (jA < 0) break; NSA_STEP(rkA, rvA, jA);
        if (jB < 0) break; NSA_STEP(rkB, rvB, jB);
        if (jC < 0) break; NSA_STEP(rkC, rvC, jC);
    }
#undef NSA_LDT
#undef NSA_STEP
}

constexpr int N_KS = 0, N_VS = 9216, N_IMP = 18432, N_SEL = N_IMP + 64 * 129 * 4  , N_UNI = N_SEL + 1024, N_OUT = 52736;

DEV void nsa_unit(const Params& p, char* lm, int b, int g, int qb, int pv = 0) {
    const int tid = ltid(), lane = tid & 63, w = tid >> 6, r = lane & 31, hi = lane >> 5, hh = r >> 3;
    const int head = g * 4 + hh, tl = 8 * w + (r & 7), t = 64 * qb + tl;
    const size_t row = (size_t)b * SEQ + t;
    const float slope2 = LOG2E / (float)(2 << head);
    char* Ks = lm + N_KS; char* Vs = lm + N_VS; float* imp = (float*)(lm + N_IMP);
    unsigned* selm = (unsigned*)(lm + N_SEL); unsigned* uni = (unsigned*)(lm + N_UNI);
    __syncthreads();
    for (int i = tid; i < 64 * 129; i += 512) imp[i] = 0.f;
    if (tid < 4) uni[tid] = 0u;
    const bf16_t* prow = p.proj + row * LD;
    bf16x8 qf[4];
#pragma unroll
    for (int s = 0; s < 4; ++s) qf[s] = *(const bf16x8*)(prow + QOFF + head * 64 + 16 * s + 8 * hi);
    float gt[3];
#pragma unroll
    for (int c3 = 0; c3 < 3; ++c3) gt[c3] = sigmoidf_(bf2f(prow[GTOFF + head * 3 + c3]));
    float* outl = (float*)(lm + N_OUT) + tid;
    f32x16 O[2];
#pragma unroll
    for (int dt = 0; dt < 2; ++dt)
#pragma unroll
        for (int i = 0; i < 16; ++i) O[dt][i] = 0.f;

    {
        int ncmp = 4 * qb + 3; if (ncmp > 511) ncmp = 511;
        const int ntc = (ncmp + 63) >> 6;
        const unsigned tm0 = (1u << ntc) - 1u;
        const bf16_t* kb = p.kc + (size_t)((b * 2 + g) * 512) * 64;
        const bf16_t* vb = p.vcT + (size_t)((b * 2 + g) * 64) * 512;
        float m = -1e30f, l = 0.f;
        if (pv != 21) nsa_branch<0>(Ks, Vs, imp, kb, 64, vb, 512, tm0, 0u, 0u, 0u, 0u, 0u, 0u, 0u, qf, t, tl, slope2, m, l, 0.f, O);
        const float lt = l + __shfl_xor(l, 32);
        const float inv = 1.0f / fmaxf(lt, 1e-30f);
        if (pv != 21 && pv != 24) nsa_branch<1>(Ks, Vs, imp, kb, 64, vb, 512, tm0, 0u, 0u, 0u, 0u, 0u, 0u, 0u, qf, t, tl, slope2, m, l, inv, O);
#pragma unroll
        for (int dt = 0; dt < 2; ++dt)
#pragma unroll
            for (int i = 0; i < 16; ++i) { outl[(16 * dt + i) * 512] = gt[0] * O[dt][i]; O[dt][i] = 0.f; }
    }
    __syncthreads();
    if (qb + 1 <= 16) {
        if (tid < 64) { const unsigned s0 = range_mask32(0, qb, 0); selm[tid * 4 + 0] = s0; selm[tid * 4 + 1] = 0u; selm[tid * 4 + 2] = 0u; selm[tid * 4 + 3] = 0u; }
        if (tid == 0) uni[0] = range_mask32(0, qb, 0);
    } else {
        if (tid < 64) { imp[tid * 129] += 1e4f; imp[tid * 129 + qb] += 1e4f; imp[tid * 129 + qb - 1] += 1e4f; }
        if (tid < 256) selm[tid] = 0u;
        __syncthreads();
        const int tok = tid >> 3, j0 = tid & 7;
        float vj[16]; int rk[16];
#pragma unroll
        for (int jj = 0; jj < 16; ++jj) { const int j = j0 + 8 * jj; vj[jj] = (j <= qb) ? imp[tok * 129 + j] : -INFINITY; rk[jj] = 0; }
        for (int k = 0; k <= qb; ++k) {
            const float vk = imp[tok * 129 + k];
#pragma unroll
            for (int jj = 0; jj < 16; ++jj) { const int j = j0 + 8 * jj; rk[jj] += ((vk > vj[jj]) || (vk == vj[jj] && k < j)) ? 1 : 0; }
        }
        unsigned s0 = 0u, s1 = 0u, s2 = 0u, s3 = 0u;
#pragma unroll
        for (int jj = 0; jj < 16; ++jj) {
            const int j = j0 + 8 * jj;
            if (j <= qb && rk[jj] < 16) { const unsigned bit = 1u << (j & 31); if (jj < 4) s0 |= bit; else if (jj < 8) s1 |= bit; else if (jj < 12) s2 |= bit; else s3 |= bit; }
        }
        if (s0) { atomicOr(&selm[tok * 4 + 0], s0); atomicOr(&uni[0], s0); }
        if (s1) { atomicOr(&selm[tok * 4 + 1], s1); atomicOr(&uni[1], s1); }
        if (s2) { atomicOr(&selm[tok * 4 + 2], s2); atomicOr(&uni[2], s2); }
        if (s3) { atomicOr(&selm[tok * 4 + 3], s3); atomicOr(&uni[3], s3); }
    }
    __syncthreads();
    {
        const unsigned u0 = uni[0], u1 = uni[1], u2 = uni[2], u3 = uni[3];
        const unsigned mk0 = selm[tl * 4 + 0], mk1 = selm[tl * 4 + 1], mk2 = selm[tl * 4 + 2], mk3 = selm[tl * 4 + 3];
        const bf16_t* kb = p.proj + (size_t)b * SEQ * LD + KSOFF + g * 64;
        const bf16_t* vb = p.vselT + (size_t)(b * 128 + g * 64) * SEQ;
        float m = -1e30f, l = 0.f;
        if (pv != 22) nsa_branch<2>(Ks, Vs, imp, kb, LD, vb, SEQ, u0, u1, u2, u3, mk0, mk1, mk2, mk3, qf, t, tl, slope2, m, l, 0.f, O);
        const float lt = l + __shfl_xor(l, 32);
        const float sc = gt[1] / fmaxf(lt, 1e-30f);
#pragma unroll
        for (int dt = 0; dt < 2; ++dt)
#pragma unroll
            for (int i = 0; i < 16; ++i) { outl[(16 * dt + i) * 512] += sc * O[dt][i]; O[dt][i] = 0.f; }
    }
    {
        const int jlo = qb - 8 < 0 ? 0 : qb - 8;
        const unsigned w0 = range_mask32(jlo, qb, 0), w1 = range_mask32(jlo, qb, 32), w2 = range_mask32(jlo, qb, 64), w3 = range_mask32(jlo, qb, 96);
        const bf16_t* kb = p.proj + (size_t)b * SEQ * LD + KWOFF + g * 64;
        const bf16_t* vb = p.vwinT + (size_t)(b * 128 + g * 64) * SEQ;
        float m = -1e30f, l = 0.f;
        if (pv != 23) nsa_branch<3>(Ks, Vs, imp, kb, LD, vb, SEQ, w0, w1, w2, w3, 0u, 0u, 0u, 0u, qf, t, tl, slope2, m, l, 0.f, O);
        const float lt = l + __shfl_xor(l, 32);
        const float sc = gt[2] / fmaxf(lt, 1e-30f);
#pragma unroll
        for (int dt = 0; dt < 2; ++dt)
#pragma unroll
            for (int i = 0; i < 16; ++i) O[dt][i] = outl[(16 * dt + i) * 512] + sc * O[dt][i];
    }
    bf16_t* orow = p.ocat + row * DM + head * 64;
#pragma unroll
    for (int dt = 0; dt < 2; ++dt)
#pragma unroll
        for (int gi = 0; gi < 4; ++gi) {
            u32x2 v; v.x = cvt_pk_bf16(O[dt][4 * gi], O[dt][4 * gi + 1]); v.y = cvt_pk_bf16(O[dt][4 * gi + 2], O[dt][4 * gi + 3]);
            *(u32x2*)(orow + 32 * dt + 8 * gi + 4 * hi) = v;
        }
}

constexpr int D_K1 = 0, D_K2 = 9216, D_VS = 18432, D_XS = 132;
DEV void diff_unit(const Params& p, char* lm, int b, int h, int qblk, int pv = 0) {
    const int tid = ltid(), lane = tid & 63, w = tid >> 6, r = lane & 31, hi = lane >> 5, mp = w >> 2, qs = w & 3;
    const int krow = tid >> 3, kch = tid & 7;
    const int ql = 32 * qs + r, t = 128 * qblk + ql;
    const size_t row = (size_t)b * SEQ + t;
    const float slope2 = LOG2E / (float)(1 << (2 * (h + 1)));
    const float sc2 = 0.125f * LOG2E;
    char* K1s = lm + D_K1; char* K2s = lm + D_K2; char* Vs = lm + D_VS;
    const char* myK = mp ? K2s : K1s;
    const bf16_t* prow = p.proj + row * LD;
    bf16x8 qf[4];
#pragma unroll
    for (int s = 0; s < 4; ++s) qf[s] = *(const bf16x8*)(prow + DQOFF + h * 128 + mp * 64 + 16 * s + 8 * hi);
    f32x16 O[4];
#pragma unroll
    for (int dt = 0; dt < 4; ++dt)
#pragma unroll
        for (int i = 0; i < 16; ++i) O[dt][i] = 0.f;
    float m = -1e30f, l = 0.f;
    const bf16_t* kb = p.proj + (size_t)b * SEQ * LD + DKOFF + h * 128;
    const bf16_t* vb = p.dvT + (size_t)(b * 512 + h * 128) * SEQ;
    const int ntl = 2 * qblk + 2;
    float qn2 = 0.f;
#pragma unroll
    for (int s4 = 0; s4 < 4; ++s4)
#pragma unroll
        for (int e = 0; e < 8; ++e) { const float qv = bf2f((bf16_t)qf[s4][e]); qn2 += qv * qv; }
    qn2 += __shfl_xor(qn2, 32);
    const float kmax2 = __uint_as_float(p.ctrl[CT_KMAX + 64 * (b * 8 + h * 2 + mp)]);
    const float ubase = sqrtf(qn2 * kmax2) * sc2 * 1.001f + 1.0f;
    unsigned* dflag = (unsigned*)(lm + D_VS + 16384);
    bool stop = false;
    const u32x4 z4 = (u32x4){0u, 0u, 0u, 0u};
    u32x4 a1 = z4, a2 = z4, a3 = z4, a4 = z4, b1 = z4, b2 = z4, b3 = z4, b4 = z4, c1 = z4, c2 = z4, c3 = z4, c4 = z4;
#define DIFF_LDT(k1, k2, v0, v1, jj) do { if ((jj) < ntl) { const int k0_ = 64 * (ntl - 1 - (jj)); \
        k1 = *(const u32x4*)(kb + (size_t)(k0_ + krow) * LD + kch * 8); k2 = *(const u32x4*)(kb + (size_t)(k0_ + krow) * LD + 64 + kch * 8); \
        v0 = *(const u32x4*)(vb + (size_t)krow * SEQ + k0_ + kch * 8); v1 = *(const u32x4*)(vb + (size_t)(krow + 64) * SEQ + k0_ + kch * 8); } } while (0)
#define DIFF_STEP(k1, k2, v0, v1, jj) do { const int j_ = ntl - 1 - (jj); \
        { const float ub = ubase - slope2 * (float)(t - (64 * j_ + 63)); const bool dead = __all(ub - m < -152.0f); if (lane == 0) dflag[w] = dead ? 1u : 0u; } \
        __syncthreads(); \
        { const u32x4 f0 = *(const u32x4*)dflag, f1 = *(const u32x4*)(dflag + 4); stop = (f0.x & f0.y & f0.z & f0.w & f1.x & f1.y & f1.z & f1.w) != 0u; } \
        if (!stop) { \
        *(u32x4*)(K1s + swz(krow, kch)) = k1; *(u32x4*)(K2s + swz(krow, kch)) = k2; \
        store_vt_chunk(Vs, krow, kch, v0); store_vt_chunk(Vs, krow + 64, kch, v1); \
        __syncthreads(); \
        DIFF_LDT(k1, k2, v0, v1, (jj) + 3); \
        { const f32x16 qa0 = qk32(myK, 0, qf, r, hi); const f32x16 qa1 = qk32(myK, 1, qf, r, hi); \
          { float s[16]; make_scores<1, false>(qa0, s, t - (64 * j_ + 4 * hi), slope2, true); osm_update<4>(s, m, l, O); \
            bf16x8 pf[2]; pack_p(s, pf); pv32<4>(Vs, 0, pf, O, r, hi); } \
          { float s[16]; make_scores<1, false>(qa1, s, t - (64 * j_ + 32 + 4 * hi), slope2, true); osm_update<4>(s, m, l, O); \
            bf16x8 pf[2]; pack_p(s, pf); pv32<4>(Vs, 1, pf, O, r, hi); } } } } while (0)
    DIFF_LDT(a1, a2, a3, a4, 0); DIFF_LDT(b1, b2, b3, b4, 1); DIFF_LDT(c1, c2, c3, c4, 2);
    for (int j = 0; j < ntl; j += 3) {
        DIFF_STEP(a1, a2, a3, a4, j); if (stop) break;
        if (j + 1 < ntl) { DIFF_STEP(b1, b2, b3, b4, j + 1); if (stop) break; }
        if (j + 2 < ntl) { DIFF_STEP(c1, c2, c3, c4, j + 2); if (stop) break; }
    }
#undef DIFF_LDT
#undef DIFF_STEP
    const float lt = l + __shfl_xor(l, 32);
    const float inv = 1.0f / fmaxf(lt, 1e-30f);
    __syncthreads();
    float* X = (float*)lm;
    if (mp == 1) {
#pragma unroll
        for (int dt = 0; dt < 4; ++dt)
#pragma unroll
            for (int i = 0; i < 16; ++i) X[ql * D_XS + 32 * dt + crow(i, hi)] = O[dt][i] * inv;
    }
    __syncthreads();
    if (mp == 0) {
        const float lam = p.misc[0];
        float ss = 0.f;
#pragma unroll
        for (int dt = 0; dt < 4; ++dt)
#pragma unroll
            for (int i = 0; i < 16; ++i) { const float o = O[dt][i] * inv - lam * X[ql * D_XS + 32 * dt + crow(i, hi)]; O[dt][i] = o; ss += o * o; }
        ss += __shfl_xor(ss, 32);
        const float rs = rsqrtf(ss * (1.0f / 128.0f) + RMS_EPS) * 0.8f;
        bf16_t* orow = p.ocat + row * DM + 512 + h * 128;
#pragma unroll
        for (int dt = 0; dt < 4; ++dt)
#pragma unroll
            for (int gi = 0; gi < 4; ++gi) {
                const int d0 = 32 * dt + 8 * gi + 4 * hi;
                const f32x4 gv = *(const f32x4*)(p.diff_subln + d0);
                u32x2 v; v.x = cvt_pk_bf16(O[dt][4 * gi] * rs * gv[0], O[dt][4 * gi + 1] * rs * gv[1]);
                v.y = cvt_pk_bf16(O[dt][4 * gi + 2] * rs * gv[2], O[dt][4 * gi + 3] * rs * gv[3]);
                *(u32x2*)(orow + d0) = v;
            }
    }
    __syncthreads();
}

struct BLoadIn {
    const float* w; int n0;
    DEV f32x4 ld(int k, int n) const {
        const int cp = n0 + n; int cg;
        if (cp < 1280) cg = cp; else if (cp < 2816) cg = cp + 24; else if (cp < 2840) cg = cp - 2816 + 1280; else return (f32x4){0.f, 0.f, 0.f, 0.f};
        return *(const f32x4*)(w + (size_t)k * 2840 + cg);
    }
};
struct BLqPlain {
    const bf16_t* wt;
    DEV u32x4 ldq(int n, int ks, int ch) const { return *(const u32x4*)(wt + (size_t)n * 1024 + ks * 64 + ch * 8); }
};
DEV int pcol(int nl) { return (nl & ~31) + 8 * ((nl >> 2) & 3) + 4 * ((nl >> 4) & 1) + (nl & 3); }
struct BLqPerm {
    const bf16_t* wt;
    DEV u32x4 ldq(int n, int ks, int ch) const { return *(const u32x4*)(wt + (size_t)pcol(n) * 1024 + ks * 64 + ch * 8); }
};
struct BLqRouter {
    const bf16_t* wt;
    DEV u32x4 ldq(int n, int ks, int ch) const { const int seg = ks >> 4, kk = ks & 15; return *(const u32x4*)(wt + (size_t)((seg == 2 ? 256 : 0) + n) * 1024 + kk * 64 + ch * 8); }
};
struct BLoadPlain { const float* w; int ldb; DEV f32x4 ld(int k, int n) const { return *(const f32x4*)(w + (size_t)k * ldb + n); } };
struct BLoadRouter {
    const float* w;
    DEV f32x4 ld(int k, int n) const {
        const int seg = k >> 10, kk = k & 1023;
        f32x4 v = *(const f32x4*)(w + (size_t)kk * 256 + n);
        if (seg == 2) {
#pragma unroll
            for (int i = 0; i < 4; ++i) v[i] = v[i] - bf2f(f2bf(v[i]));
        }
        return v;
    }
};
struct BLoadGU {
    const float* w; int nt;
    DEV f32x4 ld(int k, int n) const {
        const int col = ((n >> 5) & 1) * 256 + 64 * nt + 32 * (n >> 6) + 8 * ((n >> 2) & 3) + 4 * ((n >> 4) & 1);
        return *(const f32x4*)(w + (size_t)k * 512 + col);
    }
};

template <int NM> struct EpiProj {
    bf16_t* o; int row0, col0;
    DEV void operator()(const f32x4 (&acc)[NM][4], int r0, int c0, int rowlim, int c, int q) const {
#pragma unroll
        for (int mi = 0; mi < NM; ++mi) {
            if (r0 + 16 * mi < rowlim) {
#pragma unroll
                for (int ni = 0; ni < 4; ++ni) {
                    const f32x4 v = acc[mi][ni]; u32x2 u; u.x = cvt_pk_bf16(v[0], v[1]); u.y = cvt_pk_bf16(v[2], v[3]);
                    *(u32x2*)(o + (size_t)(row0 + r0 + 16 * mi + c) * LD + col0 + c0 + 16 * ni + 4 * q) = u;
                }
            }
        }
    }
};
template <int NM> struct EpiVT {
    bf16_t* vt; int row0, vbase, bstride;
    DEV void operator()(const f32x4 (&acc)[NM][4], int r0, int c0, int rowlim, int c, int q) const {
#pragma unroll
        for (int mi = 0; mi < NM; ++mi) {
            if (r0 + 16 * mi < rowlim) {
                const int rg = row0 + r0 + 16 * mi + 4 * q, bb = rg >> 13, tt = rg & (SEQ - 1);
#pragma unroll
                for (int ni = 0; ni < 4; ++ni) {
                    const f32x4 v = acc[mi][ni]; u32x2 u; u.x = cvt_pk_bf16(v[0], v[1]); u.y = cvt_pk_bf16(v[2], v[3]);
                    *(u32x2*)(vt + (size_t)(vbase + bb * bstride + c0 + 16 * ni + c) * SEQ + tt) = u;
                }
            }
        }
    }
};
template <int NM> struct EpiF32 {
    float* o; int ldo, row0, col0;
    DEV void operator()(const f32x4 (&acc)[NM][4], int r0, int c0, int rowlim, int c, int q) const {
#pragma unroll
        for (int mi = 0; mi < NM; ++mi) {
            if (r0 + 16 * mi < rowlim) {
#pragma unroll
                for (int ni = 0; ni < 4; ++ni)
                    *(f32x4*)(o + (size_t)(row0 + r0 + 16 * mi + c) * ldo + col0 + c0 + 16 * ni + 4 * q) = acc[mi][ni];
            }
        }
    }
};
template <int NM> struct EpiSwiglu {
    bf16_t* H; const int* rslot; const float* rwt; int nt;
    DEV void operator()(const f32x4 (&acc)[NM][4], int r0, int c0, int rowlim, int c, int q) const {
#pragma unroll
        for (int mi = 0; mi < NM; ++mi) {
            if (r0 + 16 * mi < rowlim) {
                const int rr = r0 + 16 * mi + c; const int slot = rslot[rr];
                if (slot >= 0) {
                    const float wt = rwt[rr];
                    float hv[8];
#pragma unroll
                    for (int nh = 0; nh < 2; ++nh) {
                        const f32x4 a = acc[mi][nh], g = acc[mi][nh + 2];
#pragma unroll
                        for (int i = 0; i < 4; ++i) hv[4 * nh + i] = a[i] / (1.0f + __expf(-a[i])) * g[i] * wt;
                    }
                    u32x4 u; u.x = cvt_pk_bf16(hv[0], hv[1]); u.y = cvt_pk_bf16(hv[2], hv[3]); u.z = cvt_pk_bf16(hv[4], hv[5]); u.w = cvt_pk_bf16(hv[6], hv[7]);
                    *(u32x4*)(H + (size_t)slot * 256 + 64 * nt + (c0 >> 1) + 8 * q) = u;
                }
            }
        }
    }
};

template <int MS, bool TRANS, bool BF, int PD, class AS, class BL, class EP>
DEV void gemm_ws(char* lm, int nk, int nsub, const AS& as, const BL& bl, const EP& ep) {
    const int tid = ltid(), lane = tid & 63, w = __builtin_amdgcn_readfirstlane(tid >> 6);
    const int* rowoff = (const int*)(lm + G_ROWOFF);
    const int rowlim = 128 * nsub;
    if (w < 4) {
        const int ar0 = tid >> 3, akc = tid & 7;
        const int bn4 = 8 * w + (lane & 7), bk0 = lane >> 3;
        u32x4 ra[PD][4 * MS]; f32x4 rb[BF ? 1 : PD][8]; u32x4 rq[BF ? PD : 1][4];
#define WS_LOAD(s_, ks_) do { \
        _Pragma("unroll") for (int i = 0; i < 4 * MS; ++i) if (32 * i < rowlim) ra[s_][i] = as.ld(rowoff[ar0 + 32 * i] + akc * 8, (ks_)); \
        if constexpr (BF) { _Pragma("unroll") for (int i = 0; i < 4; ++i) rq[s_][i] = bl.ldq(ar0 + 32 * i, (ks_), akc); } \
        else { _Pragma("unroll") for (int jq = 0; jq < 2; ++jq) _Pragma("unroll") for (int i = 0; i < 4; ++i) rb[s_][4 * jq + i] = bl.ld((ks_) * 64 + 4 * (bk0 + 8 * jq) + i, 4 * bn4); } } while (0)
#define WS_STORE(s_, buf_) do { char* As_ = lm + G_AS + (buf_) * G_ASZ; char* Bs_ = lm + G_BS + (buf_) * G_BSZ; \
        _Pragma("unroll") for (int i = 0; i < 4 * MS; ++i) if (32 * i < rowlim) *(u32x4*)(As_ + swz(ar0 + 32 * i, akc)) = ra[s_][i]; \
        if constexpr (BF) { _Pragma("unroll") for (int i = 0; i < 4; ++i) *(u32x4*)(Bs_ + swz(ar0 + 32 * i, akc)) = rq[s_][i]; } \
        else { _Pragma("unroll") for (int jq = 0; jq < 2; ++jq) _Pragma("unroll") for (int cc = 0; cc < 4; ++cc) { \
            u32x2 v; v.x = cvt_pk_bf16(rb[s_][4 * jq][cc], rb[s_][4 * jq + 1][cc]); v.y = cvt_pk_bf16(rb[s_][4 * jq + 2][cc], rb[s_][4 * jq + 3][cc]); \
            *(u32x2*)(Bs_ + swz(4 * bn4 + cc, (bk0 + 8 * jq) >> 1) + ((bk0 + 8 * jq) & 1) * 8) = v; } } } while (0)
#pragma unroll
        for (int s = 0; s < PD; ++s) {
#pragma unroll
            for (int i = 0; i < 4 * MS; ++i) ra[s][i] = (u32x4){0u, 0u, 0u, 0u};
            if constexpr (BF) {
#pragma unroll
                for (int i = 0; i < 4; ++i) rq[s][i] = (u32x4){0u, 0u, 0u, 0u};
            } else {
#pragma unroll
                for (int i = 0; i < 8; ++i) rb[s][i] = (f32x4){0.f, 0.f, 0.f, 0.f};
            }
            if (s < nk) WS_LOAD(s, s);
        }
        __syncthreads();
        WS_STORE(0, 0);
        if (PD < nk) WS_LOAD(0, PD);
        __syncthreads();
        for (int ks0 = 0; ks0 < nk; ks0 += PD) {
#pragma unroll
            for (int s = 0; s < PD; ++s) {
                const int ks = ks0 + s;
                if (ks < nk) {
                    const int sn = (s + 1) % PD;
                    if (ks + 1 < nk) { WS_STORE(sn, (ks + 1) & 1); if (ks + 1 + PD < nk) WS_LOAD(sn, ks + 1 + PD); }
                    __syncthreads();
                }
            }
        }
#undef WS_LOAD
#undef WS_STORE
    } else {
        const int cw = w - 4, c = lane & 15, q = lane >> 4;
        f32x4 acc[2 * MS][8];
#pragma unroll
        for (int mi = 0; mi < 2 * MS; ++mi)
#pragma unroll
            for (int ni = 0; ni < 8; ++ni) acc[mi][ni] = (f32x4){0.f, 0.f, 0.f, 0.f};
        __syncthreads();
        __syncthreads();
        for (int ks = 0; ks < nk; ++ks) {
            const char* As = lm + G_AS + (ks & 1) * G_ASZ; const char* Bs = lm + G_BS + (ks & 1) * G_BSZ;
            bf16x8 bq[2][8]; bf16x8 af[4 * MS];
#pragma unroll
            for (int ni = 0; ni < 8; ++ni) bq[0][ni] = *(const bf16x8*)(Bs + swz(16 * ni + c, q));
            af[0] = *(const bf16x8*)(As + swz(32 * MS * cw + c, q));
            af[1] = *(const bf16x8*)(As + swz(32 * MS * cw + 16 + c, q));
            __builtin_amdgcn_sched_barrier(0);
#pragma unroll
            for (int g = 0; g < 4 * MS; ++g) {
                const int kk = g / (2 * MS), mi = g % (2 * MS);
                if (g + 2 < 4 * MS) { const int kk2 = (g + 2) / (2 * MS), mi2 = (g + 2) % (2 * MS); af[g + 2] = *(const bf16x8*)(As + swz(32 * MS * cw + 16 * mi2 + c, 4 * kk2 + q)); }
                if (kk == 0 && mi < 4) {
                    bq[1][2 * mi] = *(const bf16x8*)(Bs + swz(16 * (2 * mi) + c, 4 + q));
                    bq[1][2 * mi + 1] = *(const bf16x8*)(Bs + swz(16 * (2 * mi + 1) + c, 4 + q));
                }
                if (32 * MS * cw + 16 * mi < rowlim) {
#pragma unroll
                    for (int ni = 0; ni < 8; ++ni)
                        acc[mi][ni] = TRANS ? __builtin_amdgcn_mfma_f32_16x16x32_bf16(bq[kk][ni], af[g], acc[mi][ni], 0, 0, 0)
                                            : __builtin_amdgcn_mfma_f32_16x16x32_bf16(af[g], bq[kk][ni], acc[mi][ni], 0, 0, 0);
                }
                __builtin_amdgcn_sched_barrier(0);
            }
            __syncthreads();
        }
        ep(acc, 32 * MS * cw, rowlim, c, q);
    }
}
template <int NM> struct EpiF32W {
    float* o; int ldo, row0, col0;
    DEV void operator()(const f32x4 (&acc)[NM][8], int r0, int rowlim, int c, int q) const {
#pragma unroll
        for (int mi = 0; mi < NM; ++mi) {
            if (r0 + 16 * mi < rowlim) {
#pragma unroll
                for (int ni = 0; ni < 8; ++ni)
                    *(f32x4*)(o + (size_t)(row0 + r0 + 16 * mi + c) * ldo + col0 + 16 * ni + 4 * q) = acc[mi][ni];
            }
        }
    }
};
template <int NM> struct EpiProjW {
    bf16_t* o; int row0, col0;
    DEV void operator()(const f32x4 (&acc)[NM][8], int r0, int rowlim, int c, int q) const {
#pragma unroll
        for (int mi = 0; mi < NM; ++mi) {
            if (r0 + 16 * mi < rowlim) {
#pragma unroll
                for (int pr = 0; pr < 4; ++pr) {
                    const f32x4 v0 = acc[mi][2 * pr], v1 = acc[mi][2 * pr + 1]; u32x4 u;
                    u.x = cvt_pk_bf16(v0[0], v0[1]); u.y = cvt_pk_bf16(v0[2], v0[3]); u.z = cvt_pk_bf16(v1[0], v1[1]); u.w = cvt_pk_bf16(v1[2], v1[3]);
                    *(u32x4*)(o + (size_t)(row0 + r0 + 16 * mi + c) * LD + col0 + 32 * pr + 8 * q) = u;
                }
            }
        }
    }
};
template <int NM> struct EpiVTW {
    bf16_t* vt; int row0, vbase, bstride;
    DEV void operator()(const f32x4 (&acc)[NM][8], int r0, int rowlim, int c, int q) const {
#pragma unroll
        for (int mi = 0; mi < NM; ++mi) {
            if (r0 + 16 * mi < rowlim) {
                const int rg = row0 + r0 + 16 * mi + 4 * q, bb = rg >> 13, tt = rg & (SEQ - 1);
#pragma unroll
                for (int ni = 0; ni < 8; ++ni) {
                    const f32x4 v = acc[mi][ni]; u32x2 u; u.x = cvt_pk_bf16(v[0], v[1]); u.y = cvt_pk_bf16(v[2], v[3]);
                    *(u32x2*)(vt + (size_t)(vbase + bb * bstride + pcol(16 * ni + c)) * SEQ + tt) = u;
                }
            }
        }
    }
};
struct BLoadGUW {
    const float* w; int nt;
    DEV f32x4 ld(int k, int n) const { return *(const f32x4*)(w + (size_t)k * 512 + (n >> 6) * 256 + 64 * nt + (n & 63)); }
};
template <int NM> struct EpiSwigluW {
    bf16_t* H; const int* rslot; const float* rwt; int nt;
    DEV void operator()(const f32x4 (&acc)[NM][8], int r0, int rowlim, int c, int q) const {
#pragma unroll
        for (int mi = 0; mi < NM; ++mi) {
            if (r0 + 16 * mi < rowlim) {
                const int rr = r0 + 16 * mi + c; const int slot = rslot[rr];
                if (slot >= 0) {
                    const float wt = rwt[rr];
#pragma unroll
                    for (int nh = 0; nh < 4; ++nh) {
                        const f32x4 a = acc[mi][nh], g = acc[mi][nh + 4]; float hv[4];
#pragma unroll
                        for (int i = 0; i < 4; ++i) hv[i] = a[i] / (1.0f + __expf(-a[i])) * g[i] * wt;
                        u32x2 u; u.x = cvt_pk_bf16(hv[0], hv[1]); u.y = cvt_pk_bf16(hv[2], hv[3]);
                        *(u32x2*)(H + (size_t)slot * 256 + 64 * nt + 16 * nh + 4 * q) = u;
                    }
                }
            }
        }
    }
};

DEV int entry_cnt(const unsigned* cnt, int e) { if (e >= 256) return 2048; const unsigned n = cnt[e]; return n > (unsigned)CAP ? CAP : (int)n; }

template <int STAGE>
DEV void moe_phase(const Params& p, char* lds, unsigned xcc, int rep) {
    char* lm = lds + L_MAIN;
    int* pre = (int*)(lm + G_PRE);
    int* rowoff = (int*)(lm + G_ROWOFF);
    int* rslot = (int*)(lm + G_RSLOT);
    float* rwt = (float*)(lm + G_RWT);
    int* bc = (int*)(lds + L_CTRL + 16);
    const unsigned* cnt = p.ctrl + CT_CNT;
    const int tid = ltid();
    constexpr int NT = (STAGE == 1) ? 4 : 8;
    __syncthreads();
    if (tid < 8) {
        int s = 0;
        for (int k = 0; k < 33; ++k) { pre[tid * 34 + k] = s; const int n = entry_cnt(cnt, tid + 8 * k); s += ((n + 383) / 384) * NT; }
        pre[tid * 34 + 33] = s;
    }
    __syncthreads();
    for (int xo = 0; xo < 8; ++xo) {
        const int x = (int)((xcc + xo) & 7u);
        unsigned* qc = p.ctrl + CT_Q + 64 * ((STAGE == 1 ? 16 : 32) + 8 * rep + x);
        const int total = pre[x * 34 + 33];
        for (;;) {
            __syncthreads();
            if (tid == 0) {
                const int u = (int)atomicAdd(qc, 1u);
                int k = -1;
                if (u < total) { k = 0; while (pre[x * 34 + k + 1] <= u) ++k; }
                bc[0] = u; bc[1] = k;
            }
            __syncthreads();
            const int u = bc[0], k = bc[1];
            if (k < 0) break;
            const int e = x + 8 * k, local = u - pre[x * 34 + k];
            const int n_e = entry_cnt(cnt, e);
            const int ngrp = (n_e + 383) / 384;
            const int nt = local / ngrp, mg = local % ngrp;
            int rows = n_e - mg * 384; if (rows > 384) rows = 384;
            const int nsub = (rows + 127) >> 7;
            {
                const int idx = mg * 384 + tid; int slot = -1; float wt = 0.f;
                if (tid < rows) {
                    if (e < 256) { const uint2 en = p.bucket[(size_t)e * CAP + idx]; slot = (int)en.x; wt = __uint_as_float(en.y); if ((unsigned)slot >= (unsigned)(T_TOK * 9)) slot = -1; }
                    else { slot = ((e - 256) * 2048 + idx) * 9 + 8; wt = 1.0f; }
                }
                rslot[tid] = slot; rwt[tid] = wt;
                rowoff[tid] = slot < 0 ? 0 : (STAGE == 1 ? (slot / 9) * 1024 : slot * 256);
            }
            __syncthreads();
            {
                ASrcPlain as; as.base = p.hhi;
                BLoadGU bl; bl.w = e < 256 ? p.w_gate_up + (size_t)e * 1024 * 512 : p.ws_gate_up; bl.nt = nt;
                EpiSwiglu<6> ep; ep.H = p.H; ep.rslot = rslot; ep.rwt = rwt; ep.nt = nt;
                gemm_big<3, true, 1, ASrcPlain, BLoadGU, EpiSwiglu<6>, 2>(lm, 16, nsub, as, bl, ep, (PROBE_PH == 9 && rep == 0) ? PROBE_VAR : 0);
            }
        }
    }
}

constexpr int DN_BS = 131072, DN_RSLOT = DN_BS + 18432, DN_PRE = DN_RSLOT + 1024;
DEV void moe_down_phase(const Params& p, char* lds, unsigned xcc, int rep) {
    char* lm = lds + L_MAIN;
    char* Bs = lm + DN_BS;
    int* rslot = (int*)(lm + DN_RSLOT);
    int* pre = (int*)(lm + DN_PRE);
    int* bc = (int*)(lds + L_CTRL + 16);
    const unsigned* cnt = p.ctrl + CT_CNT;
    const int tid = ltid(), lane = tid & 63, w = tid >> 6, wm = w >> 1, wn = w & 1, c = lane & 15, q = lane >> 4;
    const int bn4 = 8 * (w & 3) + (lane & 7), bkq = 8 * (w >> 2) + (lane >> 3);
    const int gc0 = 4 * bn4, prow0 = (gc0 & 64) + 16 * (2 * ((gc0 >> 5) & 1) + ((gc0 >> 2) & 1)) + 4 * ((gc0 >> 3) & 3);
    __syncthreads();
    if (tid < 8) {
        int sacc = 0;
        for (int k = 0; k < 33; ++k) { pre[tid * 34 + k] = sacc; const int n = entry_cnt(cnt, tid + 8 * k); sacc += (n + 255) >> 8; }
        pre[tid * 34 + 33] = sacc;
    }
    __syncthreads();
    for (int xo = 0; xo < 8; ++xo) {
        const int x = (int)((xcc + xo) & 7u);
        unsigned* qc = p.ctrl + CT_Q + 64 * (32 + 8 * rep + x);
        const int total = pre[x * 34 + 33];
        for (;;) {
            __syncthreads();
            if (tid == 0) {
                const int u = (int)atomicAdd(qc, 1u);
                int k = -1;
                if (u < total) { k = 0; while (pre[x * 34 + k + 1] <= u) ++k; }
                bc[0] = u; bc[1] = k;
            }
            __syncthreads();
            const int u = bc[0], k = bc[1];
            if (k < 0) break;
            const int e = x + 8 * k, mg = u - pre[x * 34 + k];
            const int n_e = entry_cnt(cnt, e);
            int rows = n_e - mg * 256; if (rows > 256) rows = 256;
            const int nsub = (rows + 127) >> 7;
            if (tid < 256) {
                const int idx = mg * 256 + tid; int slot = -1;
                if (tid < rows) {
                    if (e < 256) { slot = (int)p.bucket[(size_t)e * CAP + idx].x; if ((unsigned)slot >= (unsigned)(T_TOK * 9)) slot = -1; }
                    else slot = ((e - 256) * 2048 + idx) * 9 + 8;
                }
                rslot[tid] = slot;
            }
            __syncthreads();
#pragma unroll
            for (int hb = 0; hb < 2; ++hb) {
                u32x4 v[8];
#pragma unroll
                for (int i = 0; i < 8; ++i) {
                    const int id = tid + 512 * (8 * hb + i), row = id >> 5, kc = id & 31;
                    const int slot = rslot[row];
                    v[i] = *(const u32x4*)(p.H + (size_t)(slot < 0 ? 0 : slot) * 256 + kc * 8);
                }
#pragma unroll
                for (int i = 0; i < 8; ++i) {
                    const int id = tid + 512 * (8 * hb + i), row = id >> 5, kc = id & 31;
                    const int tile = (row >> 7) * 4 + (kc >> 3), rr = row & 127;
                    *(u32x4*)(lm + tile * 16384 + swz(rr, kc & 7)) = v[i];
                }
            }
            const float* wd = (e < 256 ? p.w_down + (size_t)e * 256 * 1024 : p.ws_down);
            f32x4 rb[2][4];
#pragma unroll
            for (int s2 = 0; s2 < 2; ++s2)
#pragma unroll
                for (int i = 0; i < 4; ++i) rb[s2][i] = *(const f32x4*)(wd + (size_t)(s2 * 64 + 4 * bkq + i) * 1024 + 4 * bn4);
            f32x4 acc[4][4];
#pragma unroll 1
            for (int nt = 0; nt < 8; ++nt) {
#pragma unroll
                for (int mi = 0; mi < 4; ++mi)
#pragma unroll
                    for (int ni = 0; ni < 4; ++ni) acc[mi][ni] = (f32x4){0.f, 0.f, 0.f, 0.f};
#pragma unroll 1
                for (int ksp = 0; ksp < 2; ++ksp) {
#pragma unroll
                    for (int k2 = 0; k2 < 2; ++k2) {
                        const int ks = 2 * ksp + k2;
                        __syncthreads();
#pragma unroll
                        for (int cc = 0; cc < 4; ++cc) {
                            u32x2 v; v.x = cvt_pk_bf16(rb[k2][0][cc], rb[k2][1][cc]); v.y = cvt_pk_bf16(rb[k2][2][cc], rb[k2][3][cc]);
                            *(u32x2*)(Bs + swz(prow0 + cc, bkq >> 1) + (bkq & 1) * 8) = v;
                        }
                        __syncthreads();
                        {
                            const int st2 = nt * 4 + ks + 2;
                            if (st2 < 32) {
                                const int nt2 = st2 >> 2, ks2 = st2 & 3;
#pragma unroll
                                for (int i = 0; i < 4; ++i) rb[k2][i] = *(const f32x4*)(wd + (size_t)(ks2 * 64 + 4 * bkq + i) * 1024 + 128 * nt2 + 4 * bn4);
                            }
                        }
                        if (64 * wm < rows) {
                            const char* As = lm + ((64 * wm) >> 7) * 4 * 16384 + ks * 16384;
                            const int rb0 = (64 * wm) & 127;
                            bf16x8 bq[2][4]; bf16x8 af[8];
#pragma unroll
                            for (int ni = 0; ni < 4; ++ni) bq[0][ni] = *(const bf16x8*)(Bs + swz(64 * wn + 16 * ni + c, q));
                            af[0] = *(const bf16x8*)(As + swz(rb0 + c, q));
                            af[1] = *(const bf16x8*)(As + swz(rb0 + 16 + c, q));
                            __builtin_amdgcn_sched_barrier(0);
#pragma unroll
                            for (int g = 0; g < 8; ++g) {
                                const int kk = g >> 2, mi = g & 3;
                                if (g + 2 < 8) { const int kk2 = (g + 2) >> 2, mi2 = (g + 2) & 3; af[g + 2] = *(const bf16x8*)(As + swz(rb0 + 16 * mi2 + c, 4 * kk2 + q)); }
                                if (kk == 0 && mi < 2) { bq[1][2 * mi] = *(const bf16x8*)(Bs + swz(64 * wn + 16 * (2 * mi) + c, 4 + q)); bq[1][2 * mi + 1] = *(const bf16x8*)(Bs + swz(64 * wn + 16 * (2 * mi + 1) + c, 4 + q)); }
#pragma unroll
                                for (int ni = 0; ni < 4; ++ni) acc[mi][ni] = __builtin_amdgcn_mfma_f32_16x16x32_bf16(bq[kk][ni], af[g], acc[mi][ni], 0, 0, 0);
                                __builtin_amdgcn_sched_barrier(0);
                            }
                        }
                    }
                }
#pragma unroll
                for (int mi = 0; mi < 4; ++mi) {
                    const int slot = rslot[64 * wm + 16 * mi + c];
                    if (slot >= 0) {
#pragma unroll
                        for (int pr = 0; pr < 2; ++pr) {
                            const f32x4 v0 = acc[mi][2 * pr], v1 = acc[mi][2 * pr + 1]; u32x4 uu;
                            uu.x = cvt_pk_bf16(v0[0], v0[1]); uu.y = cvt_pk_bf16(v0[2], v0[3]); uu.z = cvt_pk_bf16(v1[0], v1[1]); uu.w = cvt_pk_bf16(v1[2], v1[3]);
                            *(u32x4*)(p.yslot + (size_t)slot * 1024 + 128 * nt + 64 * wn + 32 * pr + 8 * q) = uu;
                        }
                    }
                }
            }
        }
    }
}

template <int MODE>
DEV void wt_tile(const float* src, int ldn, bf16_t* dstbase, int ntile, int ktile, float* tl, int tid) {
    __syncthreads();
#pragma unroll
    for (int j = 0; j < 2; ++j) {
        const int idx = tid + 512 * j, kk = idx >> 4, n4 = idx & 15;
        const int cp = ntile * 64 + n4 * 4; int cg = cp;
        if (MODE == 1) { if (cp < 1280) cg = cp; else if (cp < 2816) cg = cp + 24; else if (cp < 2840) cg = cp - 2816 + 1280; else cg = -1; }
        f32x4 v = (f32x4){0.f, 0.f, 0.f, 0.f};
        if (cg >= 0) v = *(const f32x4*)(src + (size_t)(ktile * 64 + kk) * ldn + cg);
        tl[kk * 65 + n4 * 4 + 0] = v[0]; tl[kk * 65 + n4 * 4 + 1] = v[1]; tl[kk * 65 + n4 * 4 + 2] = v[2]; tl[kk * 65 + n4 * 4 + 3] = v[3];
    }
    __syncthreads();
    const int n = tid >> 3, kc = tid & 7;
    float f[8];
#pragma unroll
    for (int e = 0; e < 8; ++e) f[e] = tl[(kc * 8 + e) * 65 + n];
    u32x4 o; o.x = cvt_pk_bf16(f[0], f[1]); o.y = cvt_pk_bf16(f[2], f[3]); o.z = cvt_pk_bf16(f[4], f[5]); o.w = cvt_pk_bf16(f[6], f[7]);
    bf16_t* dst = dstbase + (size_t)(ntile * 64 + n) * 1024 + ktile * 64 + kc * 8;
    *(u32x4*)dst = o;
    if (MODE == 2) {
#pragma unroll
        for (int e = 0; e < 8; ++e) f[e] = f[e] - bf2f(f2bf(f[e]));
        o.x = cvt_pk_bf16(f[0], f[1]); o.y = cvt_pk_bf16(f[2], f[3]); o.z = cvt_pk_bf16(f[4], f[5]); o.w = cvt_pk_bf16(f[6], f[7]);
        *(u32x4*)(dst + (size_t)256 * 1024) = o;
    }
}

#ifndef STOP_AFTER
#define STOP_AFTER 99
#endif
DEV void dump_out(const Params& p, int k) {
    const size_t n = (size_t)T_TOK * DM;
    for (size_t i = (size_t)blockIdx.x * 512 + threadIdx.x; i < n; i += (size_t)gridDim.x * 512) {
        float v = 0.f;
        if (k == 1) v = bf2f(p.hmix[i]);
        else if (k == 0) v = i < 12288 ? p.mod[i] : i < 12288 + 192 ? p.misc[i - 12288] : 0.f;
        else if (k == 2) v = (i % 2944 < 896 || (i % 2944 >= 1024 && i % 2944 < 1152) || (i % 2944 >= 1280 && i % 2944 < 2304) || i % 2944 >= 2816) ? bf2f(p.proj[i]) : 0.f;
        else if (k == 3) v = i < 131072 ? bf2f(p.kc[i]) : i < 262144 ? bf2f(p.vcT[i - 131072]) : i < 262144 + 12582912 ? bf2f(p.vselT[i - 262144]) : 0.f;
        else if (k == 4) v = bf2f(p.ocat[i]);
        else if (k == 5) v = p.y[i];
        else if (k == 6) v = bf2f(p.hhi[i]) + 64.f * bf2f(p.hlo[i]);
        else if (k == 7) v = i < (size_t)T_TOK * 256 ? p.logits[i] : 0.f;
        else if (k == 8) v = i < 256 ? (float)p.ctrl[CT_CNT + i] : 0.f;
        else if (k == 9) v = bf2f(p.H[i]) + bf2f(p.H[i + n]);
        else if (k == 10) v = bf2f(p.yslot[i]) + bf2f(p.yslot[i + 4 * n]) + bf2f(p.yslot[i + 8 * n]);
        p.out[i] = v;
    }
}
#define STOP_AT(k) do { if (STOP_AFTER == (k)) { dump_out(p, (k)); return; } } while (0)
__global__ void __launch_bounds__(512, 2) fwd_kernel(Params p) {
    extern __shared__ __attribute__((aligned(16))) char lds[];
    const int tid = ltid(), lane = tid & 63, w = tid >> 6;
    const int nb = gridDim.x, bid = blockIdx.x;
    char* lm = lds + L_MAIN;
    if (tid < 16) ((unsigned*)lds)[tid] = 0u;
    __syncthreads();
    XcdBarrier bar = xcd_barrier_post(p.ctrl, (volatile LAS unsigned*)lds);
    const unsigned xcc = bar.x & 7u;
    if (AMP_PH >= 0 && blockIdx.x == 0 && threadIdx.x == 0) ((volatile unsigned long long*)(p.ctrl + 15360))[0] = wall_clock64();
    int* bc = (int*)(lds + L_CTRL + 16);

    {
    const int tid = ltid(), lane = tid & 63, w = tid >> 6; (void)lane; (void)w;
        float* sc = (float*)lm;
        float* red = (float*)(lm + 8192);
        for (int i = tid; i < 2048; i += 512) { const float v = p.c[i]; sc[i] = v / (1.0f + __expf(-v)); }
        __syncthreads();
        for (int cb = bid; cb < 256; cb += nb) {
            if (tid < 480) {
                const int j = tid % 24, ks = tid / 24; const int col = cb * 24 + j;
                float a0 = 0.f, a1 = 0.f;
                for (int k = ks; k < 1024; k += 20) { const float wv = p.w_ada[(size_t)k * 6144 + col]; a0 += sc[k] * wv; a1 += sc[1024 + k] * wv; }
                red[(ks * 24 + j) * 2] = a0; red[(ks * 24 + j) * 2 + 1] = a1;
            }
            __syncthreads();
            if (tid < 48) {
                const int j = tid >> 1, bb = tid & 1; float s = 0.f;
                for (int ks = 0; ks < 20; ++ks) s += red[(ks * 24 + j) * 2 + bb];
                const int col = cb * 24 + j;
                p.mod[bb * 6144 + col] = s + p.b_ada[col];
            }
            __syncthreads();
        }
        for (int cb = bid; cb < 256; cb += nb) {
            if (tid < 64) {
                const int kv = cb >> 7, chunk = cb & 127; float a = 0.f;
#pragma unroll
                for (int kk = 0; kk < 16; ++kk) { const int k = chunk * 16 + kk; a += p.pe_cmp[kv * 2048 + k] * p.w_cmp1[((size_t)kv * 2048 + k) * 64 + tid]; }
                p.misc[1024 + cb * 64 + tid] = a;
            }
        }
        {
            float* tl = (float*)(lm + 16384);
            for (int u = bid; u < 736; u += nb) wt_tile<1>(p.w_in, 2840, p.wT, u >> 4, u & 15, tl, tid);
            for (int u = bid; u < 256; u += nb) wt_tile<0>(p.w_out, 1024, p.wT + (size_t)2944 * 1024, u >> 4, u & 15, tl, tid);
            for (int u = bid; u < 64; u += nb) wt_tile<2>(p.w_router, 256, p.wT + (size_t)3968 * 1024, u >> 4, u & 15, tl, tid);
            __syncthreads();
        }
        if (bid == (2 % nb) && tid == 0) {
            float s01 = 0.f, s23 = 0.f;
            for (int i = 0; i < 64; ++i) { s01 += p.diff_lambda[i] * p.diff_lambda[64 + i]; s23 += p.diff_lambda[128 + i] * p.diff_lambda[192 + i]; }
            p.misc[0] = __expf(s01) - __expf(s23) + 0.2f;
        }
        if (bid == (3 % nb)) {
            for (int i = tid; i < 4 * 64; i += 512) { const int bg = i >> 6, d = i & 63; p.kc[((size_t)bg * 512 + 511) * 64 + d] = 0; p.vcT[((size_t)bg * 64 + d) * 512 + 511] = 0; }
        }
    }
    xcd_barrier(bar);
    if (AMP_PH >= 0 && blockIdx.x == 0 && threadIdx.x == 0) ((volatile unsigned long long*)(p.ctrl + 15360))[1] = wall_clock64();
    STOP_AT(0);

    for (int rep_ = 0; rep_ < REPS(1); ++rep_) {
    const int tid = ltid(), lane = tid & 63, w = tid >> 6; (void)lane; (void)w;
    for (int row = bid * 8 + w; row < T_TOK; row += nb * 8) {
        const int bb = row >> 13; const float* xr = p.x + (size_t)row * DM;
        f32x4 v[4]; float ss = 0.f;
#pragma unroll
        for (int j = 0; j < 4; ++j) { v[j] = *(const f32x4*)(xr + lane * 4 + 256 * j); ss += v[j][0] * v[j][0] + v[j][1] * v[j][1] + v[j][2] * v[j][2] + v[j][3] * v[j][3]; }
        ss = wave_sum(ss);
        const float rs = rsqrtf(ss * (1.0f / 1024.0f) + RMS_EPS);
#pragma unroll
        for (int j = 0; j < 4; ++j) {
            const int col = lane * 4 + 256 * j;
            const f32x4 g = *(const f32x4*)(p.norm_g + col), s1 = *(const f32x4*)(p.mod + bb * 6144 + 1024 + col), h1 = *(const f32x4*)(p.mod + bb * 6144 + col);
            float o[4];
#pragma unroll
            for (int i = 0; i < 4; ++i) o[i] = v[j][i] * rs * g[i] * (1.0f + s1[i]) + h1[i];
            u32x2 u; u.x = cvt_pk_bf16(o[0], o[1]); u.y = cvt_pk_bf16(o[2], o[3]);
            *(u32x2*)(p.hmix + (size_t)row * DM + col) = u;
        }
    }
    xcd_barrier(bar);
    if (AMP_PH >= 0 && blockIdx.x == 0 && threadIdx.x == 0) ((volatile unsigned long long*)(p.ctrl + 15360))[2] = wall_clock64();
    }
    STOP_AT(1);

    for (int rep_ = 0; rep_ < REPS(2); ++rep_) {
    const int tid = ltid(), lane = tid & 63, w = tid >> 6; (void)lane; (void)w;
    for (int xo = 0; xo < 8; ++xo) {
        const int x = (int)((xcc + xo) & 7u);
        unsigned* qc = p.ctrl + CT_Q + 64 * (48 + 8 * rep_ + x);
        for (;;) {
            __syncthreads();
            if (tid == 0) bc[0] = (int)atomicAdd(qc, 1u);
            __syncthreads();
            const int v = bc[0];
            if (v >= 184) break;
            const int mg = x + 8 * (v / 23), nt = v % 23;
            ((int*)(lm + G_ROWOFF))[tid & 255] = (mg * 256 + (tid & 255)) * DM;
            __syncthreads();
            ASrcPlain as; as.base = p.hmix;
            BLqPerm bl; bl.wt = p.wT + (size_t)nt * 128 * 1024;
            const bool vt = (nt == 7) || (nt == 9) || (nt >= 18 && nt <= 21);
            if (!vt) {
                EpiProjW<4> ep; ep.o = p.proj; ep.row0 = mg * 256; ep.col0 = nt * 128;
                gemm_ws<2, true, true, 2>(lm, 16, 2, as, bl, ep);
            } else {
                EpiVTW<4> ep; ep.row0 = mg * 256; ep.vt = p.vselT;
                ep.vbase = (nt == 7) ? 0 : (nt == 9) ? 256 : 512 + (nt - 18) * 128; ep.bstride = (nt >= 18) ? 512 : 128;
                gemm_ws<2, false, true, 2>(lm, 16, 2, as, bl, ep);
            }
        }
    }
    xcd_barrier(bar);
    if (AMP_PH >= 0 && blockIdx.x == 0 && threadIdx.x == 0) ((volatile unsigned long long*)(p.ctrl + 15360))[3] = wall_clock64();
    }
    STOP_AT(2);

    for (int rep_ = 0; rep_ < REPS(3); ++rep_) {
    const int tid = ltid(), lane = tid & 63, w = tid >> 6; (void)lane; (void)w;
    for (int u2 = bid; u2 < 256; u2 += nb) {
        const int tokr = u2 * 64 + (tid >> 3), part = tid & 7;
        const bf16_t* kp = p.proj + (size_t)tokr * LD + DKOFF + part * 64;
        float sq = 0.f;
#pragma unroll
        for (int c8 = 0; c8 < 8; ++c8) {
            const u32x4 v = *(const u32x4*)(kp + c8 * 8);
            const float e0 = bflo(v.x), e1 = bfhi(v.x), e2 = bflo(v.y), e3 = bfhi(v.y), e4 = bflo(v.z), e5 = bfhi(v.z), e6 = bflo(v.w), e7 = bfhi(v.w);
            sq += e0 * e0 + e1 * e1 + e2 * e2 + e3 * e3 + e4 * e4 + e5 * e5 + e6 * e6 + e7 * e7;
        }
        sq = fmaxf(sq, __shfl_xor(sq, 8)); sq = fmaxf(sq, __shfl_xor(sq, 16)); sq = fmaxf(sq, __shfl_xor(sq, 32));
        float* kred = (float*)lm;
        __syncthreads();
        if (lane < 8) kred[w * 8 + lane] = sq;
        __syncthreads();
        if (tid < 8) {
            float mx = kred[tid];
#pragma unroll
            for (int w2 = 1; w2 < 8; ++w2) mx = fmaxf(mx, kred[w2 * 8 + tid]);
            atomicMax(p.ctrl + CT_KMAX + 64 * ((u2 >> 7) * 8 + tid), __float_as_uint(mx));
        }
    }
    for (int u = bid; u < 256; u += nb) {
        const int kv = u >> 7, bb = (u >> 6) & 1, g = (u >> 5) & 1, ch = u & 31, n0 = ch * 16;
        bf16_t* raw = (bf16_t*)lm;
        float* hid = (float*)(lm + 272 * 128);
        __syncthreads();
        for (int i = tid; i < 272 * 8; i += 512) {
            const int tk = i >> 3, chn = i & 7; const int tok = 16 * n0 + tk;
            u32x4 v = (u32x4){0u, 0u, 0u, 0u};
            if (tok < SEQ) v = *(const u32x4*)(p.proj + ((size_t)bb * SEQ + tok) * LD + (kv ? VCOFF : KCOFF) + g * 64 + chn * 8);
            *(u32x4*)((char*)raw + tk * 128 + ((chn ^ ((tk >> 4) & 7)) << 4)) = v;
        }
        __syncthreads();
        const int rr = tid >> 5, c2 = tid & 31;
        float* wl = (float*)(lm + 272 * 128 + 4096);
        float a0 = 0.f, a1 = 0.f;
        {
            const int n = tid & 63, part = tid >> 6; float sacc = 0.f;
#pragma unroll
            for (int jq = 0; jq < 16; ++jq) sacc += p.misc[1024 + (kv * 128 + part * 16 + jq) * 64 + n];
            hid[part * 64 + n] = sacc;
            __syncthreads();
#pragma unroll
            for (int pp = 0; pp < 8; ++pp) { a0 += hid[pp * 64 + 2 * c2]; a1 += hid[pp * 64 + 2 * c2 + 1]; }
        }
        const float* w1g = p.w_cmp1 + (size_t)kv * 2048 * 64;
        char* wt = (char*)wl;
        const int wn4 = 8 * (w & 1) + (lane & 7), wkq = 8 * (w >> 1) + (lane >> 3);
        const int fni = w & 3, fkk = w >> 2, fc = lane & 15, fq = lane >> 4;
        f32x4 wv[8];
#pragma unroll
        for (int hq = 0; hq < 2; ++hq)
#pragma unroll
            for (int i = 0; i < 4; ++i) wv[4 * hq + i] = *(const f32x4*)(w1g + (size_t)(4 * (wkq + 32 * hq) + i) * 64 + 4 * wn4);
        f32x4 hacc = (f32x4){0.f, 0.f, 0.f, 0.f};
#pragma unroll 1
        for (int chk = 0; chk < 8; ++chk) {
            __syncthreads();
#pragma unroll
            for (int hq = 0; hq < 2; ++hq)
#pragma unroll
                for (int cc = 0; cc < 4; ++cc) {
                    const int k0 = 4 * (wkq + 32 * hq);
                    u32x2 v; v.x = cvt_pk_bf16(wv[4 * hq][cc], wv[4 * hq + 1][cc]); v.y = cvt_pk_bf16(wv[4 * hq + 2][cc], wv[4 * hq + 3][cc]);
                    *(u32x2*)(wt + (k0 >> 6) * 8192 + swz(4 * wn4 + cc, (k0 & 63) >> 3) + ((k0 >> 2) & 1) * 8) = v;
                }
            __syncthreads();
            if (chk + 1 < 8) {
#pragma unroll
                for (int hq = 0; hq < 2; ++hq)
#pragma unroll
                    for (int i = 0; i < 4; ++i) wv[4 * hq + i] = *(const f32x4*)(w1g + (size_t)((chk + 1) * 256 + 4 * (wkq + 32 * hq) + i) * 64 + 4 * wn4);
            }
#pragma unroll
            for (int sb = 0; sb < 4; ++sb) {
                const int ipos = chk * 4 + sb, trow = 16 * fc + ipos;
                const bf16x8 af = *(const bf16x8*)((const char*)raw + trow * 128 + (((4 * fkk + fq) ^ ((trow >> 4) & 7)) << 4));
                const bf16x8 bfv = *(const bf16x8*)(wt + sb * 8192 + swz(16 * fni + fc, 4 * fkk + fq));
                hacc = __builtin_amdgcn_mfma_f32_16x16x32_bf16(bfv, af, hacc, 0, 0, 0);
            }
        }
        __syncthreads();
        {
            float* part = (float*)wt;
            *(f32x4*)(part + (fkk * 16 + fc) * 64 + 16 * fni + 4 * fq) = hacc;
            __syncthreads();
            a0 += part[rr * 64 + 2 * c2] + part[(16 + rr) * 64 + 2 * c2];
            a1 += part[rr * 64 + 2 * c2 + 1] + part[(16 + rr) * 64 + 2 * c2 + 1];
        }
        __syncthreads();
        {
            const float k0 = 0.7978845608028654f, k1 = 0.044715f;
            const float t0 = tanhf(k0 * (a0 + k1 * a0 * a0 * a0)), t1 = tanhf(k0 * (a1 + k1 * a1 * a1 * a1));
            hid[rr * 64 + 2 * c2] = 0.5f * a0 * (1.0f + t0); hid[rr * 64 + 2 * c2 + 1] = 0.5f * a1 * (1.0f + t1);
        }
        __syncthreads();
        for (int i = tid; i < 1024; i += 512) *(f32x4*)(wl + i * 4) = *(const f32x4*)(p.w_cmp2 + (size_t)kv * 4096 + i * 4);
        __syncthreads();
        float o0 = 0.f, o1 = 0.f;
#pragma unroll 8
        for (int jx = 0; jx < 64; ++jx) { const float hv = hid[rr * 64 + jx]; const float2 wv = *(const float2*)(wl + jx * 64 + 2 * c2); o0 += hv * wv.x; o1 += hv * wv.y; }
        const int n = n0 + rr;
        if (n < 511) {
            if (kv == 0) { *(unsigned*)(p.kc + ((size_t)(bb * 2 + g) * 512 + n) * 64 + 2 * c2) = cvt_pk_bf16(o0, o1); }
            else { p.vcT[((size_t)(bb * 2 + g) * 64 + 2 * c2) * 512 + n] = f2bf(o0); p.vcT[((size_t)(bb * 2 + g) * 64 + 2 * c2 + 1) * 512 + n] = f2bf(o1); }
        }
    }
    xcd_barrier(bar);
    if (AMP_PH >= 0 && blockIdx.x == 0 && threadIdx.x == 0) ((volatile unsigned long long*)(p.ctrl + 15360))[4] = wall_clock64();
    }
    STOP_AT(3);

    for (int rep_ = 0; rep_ < REPS(4); ++rep_) {
    const int tid = ltid(), lane = tid & 63, w = tid >> 6; (void)lane; (void)w;
    {
        int u;
        for (;;) {
            __syncthreads();
            if (tid == 0) bc[0] = (int)atomicAdd(p.ctrl + CT_Q + 64 * rep_, 1u);
            __syncthreads();
            u = bc[0];
            if (u >= 512) break;
            const int qk = 63 - (u >> 3), bh = u & 7;
            if (!(PROBE_PH == 4 && rep_ == 0 && (PROBE_VAR == 2 || PROBE_VAR >= 20))) diff_unit(p, lm, bh >> 2, bh & 3, qk, (PROBE_PH == 4 && rep_ == 0) ? PROBE_VAR : 0);
        }
        while (u < 1024) {
            const int v = u - 512; const int qb = 127 - (v >> 2), bg = v & 3;
            if (!(PROBE_PH == 4 && rep_ == 0 && (PROBE_VAR == 1 || (PROBE_VAR >= 11 && PROBE_VAR < 20)))) nsa_unit(p, lm, bg >> 1, bg & 1, qb, (PROBE_PH == 4 && rep_ == 0) ? PROBE_VAR : 0);
            __syncthreads();
            if (tid == 0) bc[0] = (int)atomicAdd(p.ctrl + CT_Q + 64 * rep_, 1u);
            __syncthreads();
            u = bc[0];
        }
    }
    xcd_barrier(bar);
    if (AMP_PH >= 0 && blockIdx.x == 0 && threadIdx.x == 0) ((volatile unsigned long long*)(p.ctrl + 15360))[5] = wall_clock64();
    }
    STOP_AT(4);

    for (int rep_ = 0; rep_ < REPS(5); ++rep_) {
    const int tid = ltid(), lane = tid & 63, w = tid >> 6; (void)lane; (void)w;
    for (int xo = 0; xo < 8; ++xo) {
        const int x = (int)((xcc + xo) & 7u);
        unsigned* qc = p.ctrl + 13312 + 64 * (8 * rep_ + x);
        for (;;) {
            __syncthreads();
            if (tid == 0) bc[0] = (int)atomicAdd(qc, 1u);
            __syncthreads();
            const int v = bc[0];
            if (v >= 64) break;
            const int mg = x + 8 * (v >> 3), nt = v & 7;
            ((int*)(lm + G_ROWOFF))[tid & 255] = (mg * 256 + (tid & 255)) * DM;
            __syncthreads();
            ASrcPlain as; as.base = p.ocat;
            BLqPlain bl; bl.wt = p.wT + (size_t)(2944 + nt * 128) * 1024;
            EpiF32W<4> ep; ep.o = p.y; ep.ldo = 1024; ep.row0 = mg * 256; ep.col0 = nt * 128;
            gemm_ws<2, true, true, 2>(lm, 16, 2, as, bl, ep);
        }
    }
    xcd_barrier(bar);
    if (AMP_PH >= 0 && blockIdx.x == 0 && threadIdx.x == 0) ((volatile unsigned long long*)(p.ctrl + 15360))[6] = wall_clock64();
    }
    STOP_AT(5);

    for (int rep_ = 0; rep_ < REPS(6); ++rep_) {
    const int tid = ltid(), lane = tid & 63, w = tid >> 6; (void)lane; (void)w;
    for (int row0 = bid * 8 + w; row0 < T_TOK; row0 += nb * 16) {
        const int row1r = row0 + nb * 8; const bool has1 = row1r < T_TOK; const int row1 = has1 ? row1r : row0;
        f32x4 yv[2][4], xv[2][4]; float ss[2] = {0.f, 0.f};
#pragma unroll
        for (int j = 0; j < 4; ++j) {
            yv[0][j] = *(const f32x4*)(p.y + (size_t)row0 * DM + lane * 4 + 256 * j); yv[1][j] = *(const f32x4*)(p.y + (size_t)row1 * DM + lane * 4 + 256 * j);
            xv[0][j] = *(const f32x4*)(p.x + (size_t)row0 * DM + lane * 4 + 256 * j); xv[1][j] = *(const f32x4*)(p.x + (size_t)row1 * DM + lane * 4 + 256 * j);
        }
#pragma unroll
        for (int rr = 0; rr < 2; ++rr)
#pragma unroll
            for (int j = 0; j < 4; ++j) ss[rr] += yv[rr][j][0] * yv[rr][j][0] + yv[rr][j][1] * yv[rr][j][1] + yv[rr][j][2] * yv[rr][j][2] + yv[rr][j][3] * yv[rr][j][3];
        ss[0] = wave_sum(ss[0]); ss[1] = wave_sum(ss[1]);
        float ss2[2] = {0.f, 0.f};
#pragma unroll
        for (int rr = 0; rr < 2; ++rr) {
            const int row = rr ? row1 : row0; const float* md = p.mod + (row >> 13) * 6144;
            const float rs = rsqrtf(ss[rr] * (1.0f / 1024.0f) + RMS_EPS);
#pragma unroll
            for (int j = 0; j < 4; ++j) {
                const int col = lane * 4 + 256 * j;
                const f32x4 g = *(const f32x4*)(p.norm_g + 1024 + col), g1 = *(const f32x4*)(md + 2048 + col);
#pragma unroll
                for (int i = 0; i < 4; ++i) { xv[rr][j][i] = xv[rr][j][i] + g1[i] * (yv[rr][j][i] * rs * g[i]); ss2[rr] += xv[rr][j][i] * xv[rr][j][i]; }
                if (rr == 0 || has1) *(f32x4*)(p.out + (size_t)row * DM + col) = xv[rr][j];
            }
        }
        ss2[0] = wave_sum(ss2[0]); ss2[1] = wave_sum(ss2[1]);
#pragma unroll
        for (int rr = 0; rr < 2; ++rr) {
            const int row = rr ? row1 : row0; const float* md = p.mod + (row >> 13) * 6144;
            const float rs2 = rsqrtf(ss2[rr] * (1.0f / 1024.0f) + RMS_EPS);
            if (rr == 0 || has1) {
#pragma unroll
                for (int j = 0; j < 4; ++j) {
                    const int col = lane * 4 + 256 * j;
                    const f32x4 g = *(const f32x4*)(p.norm_g + 2048 + col), s2 = *(const f32x4*)(md + 4096 + col), h2 = *(const f32x4*)(md + 3072 + col);
                    float hv[4], lo[4];
#pragma unroll
                    for (int i = 0; i < 4; ++i) { hv[i] = xv[rr][j][i] * rs2 * g[i] * (1.0f + s2[i]) + h2[i]; lo[i] = hv[i] - bf2f(f2bf(hv[i])); }
                    u32x2 uh, ul; uh.x = cvt_pk_bf16(hv[0], hv[1]); uh.y = cvt_pk_bf16(hv[2], hv[3]); ul.x = cvt_pk_bf16(lo[0], lo[1]); ul.y = cvt_pk_bf16(lo[2], lo[3]);
                    *(u32x2*)(p.hhi + (size_t)row * DM + col) = uh; *(u32x2*)(p.hlo + (size_t)row * DM + col) = ul;
                }
            }
        }
    }
    xcd_barrier(bar);
    if (AMP_PH >= 0 && blockIdx.x == 0 && threadIdx.x == 0) ((volatile unsigned long long*)(p.ctrl + 15360))[7] = wall_clock64();
    }
    STOP_AT(6);

    for (int rep_ = 0; rep_ < REPS(7); ++rep_) {
    const int tid = ltid(), lane = tid & 63, w = tid >> 6; (void)lane; (void)w;
    for (int u = bid; u < 256; u += nb) {
        const int nt = u / 128, mt = u % 128;
        __syncthreads();
        if (tid < 128) ((int*)(lm + G_ROWOFF))[tid] = (mt * 128 + tid) * DM;
        __syncthreads();
        ASrcRouter as; as.hi = p.hhi; as.lo = p.hlo;
        BLqRouter bl; bl.wt = p.wT + (size_t)(2944 + 1024 + nt * 128) * 1024;
        EpiF32<2> ep; ep.o = p.logits; ep.ldo = 256; ep.row0 = mt * 128; ep.col0 = nt * 128;
        gemm_big<1, true, 4, ASrcRouter, BLqRouter, EpiF32<2>, 4, true>(lm, 48, 1, as, bl, ep);
    }
    xcd_barrier(bar);
    if (AMP_PH >= 0 && blockIdx.x == 0 && threadIdx.x == 0) ((volatile unsigned long long*)(p.ctrl + 15360))[8] = wall_clock64();
    }
    STOP_AT(7);

    {
    const int tid = ltid(), lane = tid & 63, w = tid >> 6; (void)lane; (void)w;
    int* lhist = (int*)lm;
    __syncthreads();
    if (tid < 256) lhist[tid] = 0;
    __syncthreads();
    for (int tok = bid * 8 + w; tok < T_TOK; tok += nb * 8) {
        const f32x4 lg = *(const f32x4*)(p.logits + (size_t)tok * 256 + lane * 4);
        const f32x4 rb = *(const f32x4*)(p.router_bias + lane * 4);
        float aff[4], ch[4];
#pragma unroll
        for (int i = 0; i < 4; ++i) { aff[i] = 1.0f / (1.0f + __expf(-lg[i])); ch[i] = aff[i] + rb[i]; }
        float m1 = fmaxf(ch[0], ch[1]), m2 = fminf(ch[0], ch[1]);
#pragma unroll
        for (int i = 2; i < 4; ++i) { const float v = ch[i]; if (v > m1) { m2 = m1; m1 = v; } else if (v > m2) m2 = v; }
        { float o1 = dppf<0xB1>(m1), o2 = dppf<0xB1>(m2); float n1 = fmaxf(m1, o1), n2 = fmaxf(fminf(m1, o1), fmaxf(m2, o2)); m1 = n1; m2 = n2;
          o1 = dppf<0x4E>(m1); o2 = dppf<0x4E>(m2); n1 = fmaxf(m1, o1); n2 = fmaxf(fminf(m1, o1), fmaxf(m2, o2)); m1 = n1; m2 = n2;
          o1 = dppf<0x141>(m1); o2 = dppf<0x141>(m2); n1 = fmaxf(m1, o1); n2 = fmaxf(fminf(m1, o1), fmaxf(m2, o2)); m1 = n1; m2 = n2; }
        const float gs = m1 + m2; const int grp = lane >> 3;
        int rank = 0;
#pragma unroll
        for (int g2 = 0; g2 < 8; ++g2) { const float og = __builtin_bit_cast(float, __builtin_amdgcn_readlane(__builtin_bit_cast(int, gs), g2 * 8)); if (og > gs || (og == gs && g2 < grp)) ++rank; }
        const bool gsel = rank < 4;
#pragma unroll
        for (int i = 0; i < 4; ++i) if (!gsel) ch[i] = -INFINITY;
        int myidx = 0; float myaff = 0.f, asum = 0.f;
        for (int it = 0; it < 8; ++it) {
            float bv = ch[0]; int bi = lane * 4;
#pragma unroll
            for (int i = 1; i < 4; ++i) if (ch[i] > bv) { bv = ch[i]; bi = lane * 4 + i; }
            const float M = wave_max_dpp(bv);
            const unsigned long long bal = __ballot(bv == M);
            const int L = (int)__builtin_ctzll(bal);
            bi = __builtin_amdgcn_readlane(bi, L);
            float av = 0.f;
            if (L == lane) {
#pragma unroll
                for (int i = 0; i < 4; ++i) if ((bi & 3) == i) { av = aff[i]; ch[i] = -INFINITY; }
            }
            av = __builtin_bit_cast(float, __builtin_amdgcn_readlane(__builtin_bit_cast(int, av), L));
            asum += av;
            if (lane == it) { myidx = bi; myaff = av; }
        }
        if (lane < 8) {
            const float wt = myaff / asum * 2.5f;
            const int rk = atomicAdd(&lhist[myidx], 1);
            uint2 en; en.x = (unsigned)myidx | ((unsigned)rk << 16); en.y = __float_as_uint(wt);
            p.asg[(size_t)tok * 8 + lane] = en;
        }
    }
    __syncthreads();
    if (tid < 256) { p.bh[tid * 256 + (bid & 255)] = lhist[tid]; for (int b2 = bid + nb; b2 < 256; b2 += nb) p.bh[tid * 256 + b2] = 0; }
    }
    xcd_barrier(bar);
    {
    const int tid = ltid(), lane = tid & 63, w = tid >> 6; (void)lane; (void)w;
    int* loff = (int*)lm;
    __syncthreads();
    for (int e = w; e < 256; e += 8) {
        const int4 c4 = *(const int4*)(p.bh + e * 256 + lane * 4);
        const int b0 = lane * 4;
        int below = (b0 < bid ? c4.x : 0) + (b0 + 1 < bid ? c4.y : 0) + (b0 + 2 < bid ? c4.z : 0) + (b0 + 3 < bid ? c4.w : 0);
        int tot = c4.x + c4.y + c4.z + c4.w;
        below = wave_sum_i(below); tot = wave_sum_i(tot);
        if (lane == 0) { loff[e] = below; if (bid == 0) p.ctrl[CT_CNT + e] = (unsigned)tot; }
    }
    __syncthreads();
    for (int tok = bid * 8 + w; tok < T_TOK; tok += nb * 8) {
        if (lane < 8) {
            const uint2 en = p.asg[(size_t)tok * 8 + lane];
            const int e = (int)(en.x & 0xffffu), rk = (int)(en.x >> 16);
            uint2 o; o.x = (unsigned)(tok * 9 + lane); o.y = en.y;
            p.bucket[(size_t)e * CAP + loff[e] + rk] = o;
        }
    }
    }
    xcd_barrier(bar);
    if (AMP_PH >= 0 && blockIdx.x == 0 && threadIdx.x == 0) ((volatile unsigned long long*)(p.ctrl + 15360))[9] = wall_clock64();
    STOP_AT(8);

    for (int rep_ = 0; rep_ < REPS(9); ++rep_) {
    const int tid = ltid(), lane = tid & 63, w = tid >> 6; (void)lane; (void)w;
    moe_phase<1>(p, lds, xcc, rep_);
    xcd_barrier(bar);
    if (AMP_PH >= 0 && blockIdx.x == 0 && threadIdx.x == 0) ((volatile unsigned long long*)(p.ctrl + 15360))[10] = wall_clock64();
    }
    STOP_AT(9);
    for (int rep_ = 0; rep_ < REPS(10); ++rep_) {
    moe_down_phase(p, lds, xcc, rep_);
    xcd_barrier(bar);
    if (AMP_PH >= 0 && blockIdx.x == 0 && threadIdx.x == 0) ((volatile unsigned long long*)(p.ctrl + 15360))[11] = wall_clock64();
    }
    STOP_AT(10);

    {
    const int tid = ltid(), lane = tid & 63, w = tid >> 6; (void)lane; (void)w;
    for (int row = bid * 8 + w; row < T_TOK; row += nb * 8) {
        const int bb = row >> 13; const float* md = p.mod + bb * 6144;
        float acc[16];
#pragma unroll
        for (int i = 0; i < 16; ++i) acc[i] = 0.f;
        const bf16_t* sp = p.yslot + (size_t)row * 9 * 1024;
        for (int k = 0; k < 9; ++k) {
#pragma unroll
            for (int j = 0; j < 2; ++j) {
                const u32x4 v = *(const u32x4*)(sp + (size_t)k * 1024 + lane * 8 + 512 * j);
                acc[8 * j + 0] += bflo(v.x); acc[8 * j + 1] += bfhi(v.x); acc[8 * j + 2] += bflo(v.y); acc[8 * j + 3] += bfhi(v.y);
                acc[8 * j + 4] += bflo(v.z); acc[8 * j + 5] += bfhi(v.z); acc[8 * j + 6] += bflo(v.w); acc[8 * j + 7] += bfhi(v.w);
            }
        }
        float ss = 0.f;
#pragma unroll
        for (int i = 0; i < 16; ++i) ss += acc[i] * acc[i];
        ss = wave_sum(ss);
        const float rs = rsqrtf(ss * (1.0f / 1024.0f) + RMS_EPS);
#pragma unroll
        for (int j = 0; j < 2; ++j)
#pragma unroll
            for (int hf = 0; hf < 2; ++hf) {
                const int col = lane * 8 + 512 * j + 4 * hf;
                const f32x4 g = *(const f32x4*)(p.norm_g + 3072 + col), g2 = *(const f32x4*)(md + 5120 + col);
                f32x4 x1 = *(const f32x4*)(p.out + (size_t)row * DM + col);
#pragma unroll
                for (int i = 0; i < 4; ++i) x1[i] += g2[i] * (acc[8 * j + 4 * hf + i] * rs * g[i]);
                *(f32x4*)(p.out + (size_t)row * DM + col) = x1;
            }
    }
    }
    if (AMP_PH >= 0 && blockIdx.x == 0 && threadIdx.x == 0) {
        volatile unsigned long long* ts = (volatile unsigned long long*)(p.ctrl + 15360);
        const unsigned long long tend = wall_clock64();
        const unsigned long long a = ts[AMP_PH], b = (AMP_PH + 1 <= 11) ? ts[AMP_PH + 1] : tend;
        const unsigned long long dt = (b - a) * AMP_MUL, t0 = wall_clock64();
        while (wall_clock64() - t0 < dt) __builtin_amdgcn_s_sleep(8);
    }
}

static inline size_t al256(size_t v) { return (v + 255) & ~(size_t)255; }

extern "C" void kernel_launch(void* const* d_in, const int* in_sizes, int n_in, void* d_out, int out_size, void* d_ws, size_t ws_size, hipStream_t stream) {
    (void)in_sizes; (void)n_in; (void)out_size;
    Params p{};
    p.x = (const float*)d_in[0]; p.c = (const float*)d_in[1]; p.w_ada = (const float*)d_in[2]; p.b_ada = (const float*)d_in[3];
    p.norm_g = (const float*)d_in[4]; p.w_in = (const float*)d_in[5]; p.w_cmp1 = (const float*)d_in[6]; p.w_cmp2 = (const float*)d_in[7];
    p.pe_cmp = (const float*)d_in[8]; p.diff_lambda = (const float*)d_in[9]; p.diff_subln = (const float*)d_in[10]; p.w_out = (const float*)d_in[11];
    p.w_router = (const float*)d_in[12]; p.router_bias = (const float*)d_in[13]; p.w_gate_up = (const float*)d_in[14]; p.w_down = (const float*)d_in[15];
    p.ws_gate_up = (const float*)d_in[16]; p.ws_down = (const float*)d_in[17];
    p.out = (float*)d_out;
    char* ws = (char*)d_ws; size_t off = 0;
    auto take = [&](size_t bytes) { char* r = ws + off; off = al256(off + bytes); return r; };
    p.ctrl = (unsigned*)take((size_t)CT_WORDS * 4);
    p.mod = (float*)take(2 * 6144 * 4);
    p.misc = (float*)take((1024 + 256 * 64) * 4);
    p.wT = (bf16_t*)take((size_t)(2944 + 1024 + 512) * 1024 * 2);
    p.hmix = (bf16_t*)take((size_t)T_TOK * DM * 2);
    p.proj = (bf16_t*)take((size_t)T_TOK * LD * 2);
    p.vselT = (bf16_t*)take((size_t)256 * SEQ * 2);
    p.vwinT = (bf16_t*)take((size_t)256 * SEQ * 2);
    p.dvT = (bf16_t*)take((size_t)1024 * SEQ * 2);
    p.kc = (bf16_t*)take((size_t)4 * 512 * 64 * 2);
    p.vcT = (bf16_t*)take((size_t)4 * 64 * 512 * 2);
    p.ocat = (bf16_t*)take((size_t)T_TOK * DM * 2);
    p.y = (float*)take((size_t)T_TOK * DM * 4);
    p.hhi = (bf16_t*)take((size_t)T_TOK * DM * 2);
    p.hlo = (bf16_t*)take((size_t)T_TOK * DM * 2);
    p.logits = (float*)take((size_t)T_TOK * 256 * 4);
    p.bucket = (uint2*)take((size_t)NEXP * CAP * 8);
    p.asg = (uint2*)take((size_t)T_TOK * 8 * 8);
    p.bh = (int*)take((size_t)256 * 256 * 4);
    p.H = (bf16_t*)take((size_t)T_TOK * 9 * 256 * 2);
    p.yslot = (bf16_t*)take((size_t)T_TOK * 9 * 1024 * 2);

    if (ws_size < off) { fprintf(stderr, "workspace too small: %zu < %zu\n", ws_size, off); return; }
    static int grid = 0;
    if (!grid) {
        int dev = 0, cus = 0, per_cu = 0;
        hipGetDevice(&dev);
        hipDeviceGetAttribute(&cus, hipDeviceAttributeMultiprocessorCount, dev);
        hipFuncSetAttribute((const void*)fwd_kernel, hipFuncAttributeMaxDynamicSharedMemorySize, LDS_BYTES);
        hipOccupancyMaxActiveBlocksPerMultiprocessor(&per_cu, fwd_kernel, 512, LDS_BYTES);
        if (per_cu < 1) fprintf(stderr, "occupancy query says the kernel does not fit\n");
        grid = cus > 0 ? cus : 256;
    }
    hipMemsetAsync(p.ctrl, 0, (size_t)CT_WORDS * 4, stream);
    hipLaunchKernelGGL(fwd_kernel, dim3(grid), dim3(512), LDS_BYTES, stream, p);
}
```

```cpp
#include <hip/hip_runtime.h>
#include <stdint.h>
#include <stdio.h>
#ifndef PROBE_PH
#define PROBE_PH -1
#endif
#define REPS(k) ((PROBE_PH == (k)) ? 2 : 1)
#ifndef AMP_PH
#define AMP_PH -1
#endif
#define AMP_MUL 1

typedef unsigned short bf16_t;
typedef short bf16x8 __attribute__((ext_vector_type(8)));
typedef short bf16x4 __attribute__((ext_vector_type(4)));
typedef float f32x4 __attribute__((ext_vector_type(4)));
typedef float f32x16 __attribute__((ext_vector_type(16)));
typedef unsigned u32x4 __attribute__((ext_vector_type(4)));
typedef unsigned u32x2 __attribute__((ext_vector_type(2)));

#define DEV __device__ __forceinline__

constexpr int T_TOK = 16384, SEQ = 8192, DM = 1024;
constexpr int LD = 2304;
constexpr int QOFF = 0, KCOFF = 512, VCOFF = 640, KSOFF = 768, KWOFF = 896, DQOFF = 1024, DKOFF = 1536, GTOFF = 2048;
constexpr int WN_ROWS = 2304, WV_ROWS = 768, WO_ROW0 = WN_ROWS + WV_ROWS, WR_ROW0 = WO_ROW0 + 1024, WT_ROWS = WR_ROW0 + 512;
constexpr int VT_SEL = 0, VT_WIN = 128, VT_DV = 256, VT_ROWS = 768;
constexpr int NEXP = 256, CAP = 16384;
constexpr float LOG2E = 1.4426950408889634f;
constexpr float RMS_EPS = 1e-6f;
DEV int swz(int row, int chunk) { return row * 128 + ((chunk ^ ((row >> 1) & 7)) << 4); }

typedef __bf16 bf16v2_t __attribute__((ext_vector_type(2)));
DEV unsigned cvt_pk_bf16(float lo, float hi) { bf16v2_t v; v[0] = (__bf16)lo; v[1] = (__bf16)hi; return __builtin_bit_cast(unsigned, v); }
DEV bf16_t f2bf(float f) { unsigned u = __float_as_uint(f); u += 0x7FFFu + ((u >> 16) & 1u); return (bf16_t)(u >> 16); }
DEV float bf2f(bf16_t b) { return __uint_as_float(((unsigned)b) << 16); }
DEV float bflo(unsigned w) { return __uint_as_float(w << 16); }
DEV float bfhi(unsigned w) { return __uint_as_float(w & 0xffff0000u); }
DEV float fexp2(float x) { return __builtin_amdgcn_exp2f(x); }
DEV float sigmoidf_(float x) { return 1.0f / (1.0f + __expf(-x)); }
DEV int ltid() { int t = threadIdx.x; asm volatile("" : "+v"(t)); return t; }
DEV unsigned pack_fp8x4(float a, float b, float c, float d) { int w = __builtin_amdgcn_cvt_pk_fp8_f32(a, b, 0, false); w = __builtin_amdgcn_cvt_pk_fp8_f32(c, d, w, true); return (unsigned)w; }
DEV void unpack_fp8x4(unsigned w, float (&o)[4]) {
    typedef float f2_t __attribute__((ext_vector_type(2)));
    const f2_t lo = __builtin_amdgcn_cvt_pk_f32_fp8((int)w, false), hi = __builtin_amdgcn_cvt_pk_f32_fp8((int)w, true);
    o[0] = lo[0]; o[1] = lo[1]; o[2] = hi[0]; o[3] = hi[1];
}
constexpr float YS_SCALE = 16.0f;
DEV int crow(int r, int hi) { return (r & 3) + 8 * (r >> 2) + 4 * hi; }
template <int CTRL> DEV float dppf(float v) { return __builtin_bit_cast(float, __builtin_amdgcn_update_dpp(0, __builtin_bit_cast(int, v), CTRL, 0xF, 0xF, true)); }
DEV float wave_max_dpp(float v) {
    v = fmaxf(v, dppf<0xB1>(v)); v = fmaxf(v, dppf<0x4E>(v)); v = fmaxf(v, dppf<0x141>(v)); v = fmaxf(v, dppf<0x140>(v));
    const float a = __builtin_bit_cast(float, __builtin_amdgcn_readlane(__builtin_bit_cast(int, v), 0)), b = __builtin_bit_cast(float, __builtin_amdgcn_readlane(__builtin_bit_cast(int, v), 16));
    const float c = __builtin_bit_cast(float, __builtin_amdgcn_readlane(__builtin_bit_cast(int, v), 32)), d = __builtin_bit_cast(float, __builtin_amdgcn_readlane(__builtin_bit_cast(int, v), 48));
    return fmaxf(fmaxf(a, b), fmaxf(c, d));
}
DEV float wave_sum(float v) {
    v += dppf<0xB1>(v); v += dppf<0x4E>(v); v += dppf<0x141>(v); v += dppf<0x140>(v);
    const float a = __builtin_bit_cast(float, __builtin_amdgcn_readlane(__builtin_bit_cast(int, v), 0)), b = __builtin_bit_cast(float, __builtin_amdgcn_readlane(__builtin_bit_cast(int, v), 16));
    const float c = __builtin_bit_cast(float, __builtin_amdgcn_readlane(__builtin_bit_cast(int, v), 32)), d = __builtin_bit_cast(float, __builtin_amdgcn_readlane(__builtin_bit_cast(int, v), 48));
    return (a + b) + (c + d);
}
DEV int wave_sum_i(int v) {
    v += __builtin_amdgcn_update_dpp(0, v, 0xB1, 0xF, 0xF, true); v += __builtin_amdgcn_update_dpp(0, v, 0x4E, 0xF, 0xF, true);
    v += __builtin_amdgcn_update_dpp(0, v, 0x141, 0xF, 0xF, true); v += __builtin_amdgcn_update_dpp(0, v, 0x140, 0xF, 0xF, true);
    return __builtin_amdgcn_readlane(v, 0) + __builtin_amdgcn_readlane(v, 16) + __builtin_amdgcn_readlane(v, 32) + __builtin_amdgcn_readlane(v, 48);
}

#define XB_TMO      128
#define XB_XCNT(j)  (256  + 64 * (j))
#define XB_XSUB(j)  (1280 + 64 * (j))
#define XB_XGEN(j)  (2304 + 64 * (j))
#define XB_TOP      3328
#define XB_TOPGEN   3392
#define XCD_BAR_WORDS 3456
#define XB_SPIN_CAP (1u << 20)
#define LAS __attribute__((address_space(3)))

__device__ __forceinline__ unsigned xb_ld(unsigned* p)              { return __hip_atomic_load(p, __ATOMIC_RELAXED, __HIP_MEMORY_SCOPE_AGENT); }
__device__ __forceinline__ unsigned xb_add(unsigned* p, unsigned v) { return __hip_atomic_fetch_add(p, v, __ATOMIC_RELAXED, __HIP_MEMORY_SCOPE_AGENT); }
__device__ __forceinline__ unsigned xb_xcc_id() { return (unsigned)__builtin_amdgcn_s_getreg((3 << 11) | 20) & 0xFu; }
#define XB_SPIN(cond, bar) do { unsigned _sp = 0; while (cond) { __builtin_amdgcn_s_sleep(1); \
    if ((++_sp & 255u) == 0u) { if (xb_ld(&(bar)[XB_TMO])) break; if (_sp > XB_SPIN_CAP) { atomicAdd(&(bar)[XB_TMO], 1u); break; } } } } while (0)

struct XcdBarrier {
    unsigned* bar; unsigned x;
    volatile LAS unsigned* st;
};
__device__ __forceinline__ XcdBarrier xcd_barrier_post(unsigned* bar, volatile LAS unsigned* st) {
    XcdBarrier b; b.bar = bar; b.x = xb_xcc_id(); b.st = st;
    if (threadIdx.x == 0) (void)xb_add(&bar[XB_XCNT(b.x)], 1u);
    return b;
}
__device__ __forceinline__ void xcd_barrier_complete(unsigned* bar, unsigned x, unsigned& nloc, unsigned& nx) {
    const unsigned G = gridDim.x * gridDim.y * gridDim.z;
    unsigned sum, cnt, mine, sp = 0u;
    for (;;) {
        sum = 0u; cnt = 0u; mine = 0u;
#pragma unroll
        for (unsigned j = 0; j < 16; ++j) { const unsigned c = xb_ld(&bar[XB_XCNT(j)]); sum += c; cnt += (c > 0u) ? 1u : 0u; mine = (j == x) ? c : mine; }
        if (sum == G) break;
        __builtin_amdgcn_s_sleep(1);
        if ((++sp & 255u) == 0u) { if (xb_ld(&bar[XB_TMO])) break; if (sp > XB_SPIN_CAP) { atomicAdd(&bar[XB_TMO], 1u); break; } }
    }
    nloc = mine > 0u ? mine : 1u; nx = cnt > 0u ? cnt : 1u;
}
__device__ __forceinline__ void xcd_barrier(const XcdBarrier& b) {
    asm volatile("s_waitcnt vmcnt(0)" ::: "memory");
    __syncthreads();
    if (threadIdx.x == 0) {
        unsigned* bar = b.bar; unsigned bx = b.x;
        asm volatile("" : "+s"(bar), "+s"(bx));
        __builtin_amdgcn_s_waitcnt(0);
        unsigned nloc = b.st[0], nx = b.st[1];
        if (nloc == 0u) { xcd_barrier_complete(bar, bx, nloc, nx); b.st[0] = nloc; b.st[1] = nx; }
        const unsigned old = xb_add(&bar[XB_XSUB(bx)], 1u);
        const unsigned gen = old / nloc;
        if (old + 1u == (gen + 1u) * nloc) {
            __builtin_amdgcn_fence(__ATOMIC_RELEASE, "agent");
            asm volatile("s_waitcnt vmcnt(0)" ::: "memory");
            const unsigned og = xb_add(&bar[XB_TOP], 1u);
            const unsigned tg = og / nx;
            if (og + 1u == (tg + 1u) * nx) xb_add(&bar[XB_TOPGEN], 1u);
            else XB_SPIN(xb_ld(&bar[XB_TOPGEN]) == tg, bar);
            __builtin_amdgcn_fence(__ATOMIC_ACQUIRE, "agent");
            xb_add(&bar[XB_XGEN(bx)], 1u);
            asm volatile("s_waitcnt vmcnt(0)" ::: "memory");
        } else {
            XB_SPIN(xb_ld(&bar[XB_XGEN(bx)]) == gen, bar);
            __builtin_amdgcn_fence(__ATOMIC_ACQUIRE, "agent");
            asm volatile("s_waitcnt vmcnt(0)" ::: "memory");
        }
    }
    __syncthreads();
}

struct Params {
    const float *x, *c, *w_ada, *b_ada, *norm_g, *w_in, *w_cmp1, *w_cmp2, *pe_cmp, *diff_lambda, *diff_subln,
                *w_out, *w_router, *router_bias, *w_gate_up, *w_down, *ws_gate_up, *ws_down;
    float* out;
    unsigned* ctrl;
    float* mod;
    float* misc;
    bf16_t* wT;
    bf16_t* hmix;
    bf16_t* proj;
    bf16_t* vT;
    bf16_t* kc;
    bf16_t* vcT;
    bf16_t* ocat;
    bf16_t* y;
    bf16_t* hhi;
    bf16_t* hlo;
    float* logits;
    uint2* bucket;
    uint2* asg;
    int* bh;
    bf16_t* H;
    unsigned char* yslot;
    float* nslot;
};
constexpr int CT_Q = 4096;
constexpr int CT_CNT = 8192;
constexpr int CT_KMAX = 12288;
constexpr int CT_NORMCNT = 16384;
constexpr int CT_WORDS = 16384 + 2048;

constexpr int L_CTRL = 0;
constexpr int L_MAIN = 64;
constexpr int LDS_BYTES = 64 + 131072 + 18432 + 4096;

constexpr int G_AS = 0, G_ASZ = 49152, G_BS = 98304, G_BSZ = 16384, G_ROWOFF = 131072, G_RSLOT = 133120, G_RWT = 135168, G_PRE = 137216;
#ifndef PROBE_VAR
#define PROBE_VAR 0
#endif
template <int MS, bool TRANS, int PD, class AS, class BL, class EP, int PDB = PD, bool BF = false>
DEV void gemm_big(char* lm, int nk, int nsub, const AS& as, const BL& bl, const EP& ep, int pvar = 0) {
    static_assert(PDB % PD == 0, "the B ring depth must be a multiple of the A ring depth");
    const int tid = ltid(), lane = tid & 63, w = tid >> 6, wm = w >> 1, wn = w & 1, c = lane & 15, q = lane >> 4;
    const int* rowoff = (const int*)(lm + G_ROWOFF);
    const int ar0 = tid >> 3, akc = tid & 7;
    const int bn4 = 8 * (w & 3) + (lane & 7), bkq = 8 * (w >> 2) + (lane >> 3);
    const int rowlim = 128 * nsub;
    u32x4 ra[PD][2 * MS]; f32x4 rb[BF ? 1 : PDB][4]; u32x4 rq[BF ? PDB : 1][2];
    f32x4 acc[2 * MS][4];
#pragma unroll
    for (int mi = 0; mi < 2 * MS; ++mi)
#pragma unroll
        for (int ni = 0; ni < 4; ++ni) acc[mi][ni] = (f32x4){0.f, 0.f, 0.f, 0.f};
#define GB_LOADA(s_, ks_) do { \
        _Pragma("unroll") for (int i = 0; i < 2 * MS; ++i) if ((i >> 1) < nsub) ra[s_][i] = as.ld(rowoff[ar0 + 64 * i] + akc * 8, (ks_)); } while (0)
#define GB_LOADB(s_, ks_) do { if constexpr (BF) { rq[s_][0] = bl.ldq(ar0, (ks_), akc); rq[s_][1] = bl.ldq(ar0 + 64, (ks_), akc); } else { \
        _Pragma("unroll") for (int i = 0; i < 4; ++i) rb[s_][i] = bl.ld((ks_) * 64 + 4 * bkq + i, 4 * bn4); } } while (0)
#define GB_STORE(sa_, sb_, buf_) do { char* As_ = lm + G_AS + (buf_) * G_ASZ; char* Bs_ = lm + G_BS + (buf_) * G_BSZ; \
        _Pragma("unroll") for (int i = 0; i < 2 * MS; ++i) if ((i >> 1) < nsub) *(u32x4*)(As_ + swz(ar0 + 64 * i, akc)) = ra[sa_][i]; \
        if constexpr (BF) { *(u32x4*)(Bs_ + swz(ar0, akc)) = rq[sb_][0]; *(u32x4*)(Bs_ + swz(ar0 + 64, akc)) = rq[sb_][1]; } else { \
        _Pragma("unroll") for (int cc = 0; cc < 4; ++cc) { u32x2 v; v.x = cvt_pk_bf16(rb[sb_][0][cc], rb[sb_][1][cc]); v.y = cvt_pk_bf16(rb[sb_][2][cc], rb[sb_][3][cc]); \
            *(u32x2*)(Bs_ + swz(4 * bn4 + cc, bkq >> 1) + (bkq & 1) * 8) = v; } } } while (0)
#pragma unroll
    for (int s = 0; s < PD; ++s) {
#pragma unroll
        for (int i = 0; i < 2 * MS; ++i) ra[s][i] = (u32x4){0u, 0u, 0u, 0u};
        if (s < nk) GB_LOADA(s, s);
    }
#pragma unroll
    for (int s = 0; s < PDB; ++s) {
        if constexpr (BF) { rq[s][0] = (u32x4){0u, 0u, 0u, 0u}; rq[s][1] = (u32x4){0u, 0u, 0u, 0u}; }
        else {
#pragma unroll
            for (int i = 0; i < 4; ++i) rb[s][i] = (f32x4){0.f, 0.f, 0.f, 0.f};
        }
        if (s < nk) GB_LOADB(s, s);
    }
    __syncthreads();
    GB_STORE(0, 0, 0);
    if (PD < nk) GB_LOADA(0, PD);
    if (PDB < nk) GB_LOADB(0, PDB);
    __syncthreads();
    for (int ks0 = 0; ks0 < nk; ks0 += PDB) {
#pragma unroll
        for (int s = 0; s < PDB; ++s) {
            const int ks = ks0 + s;
            if (ks < nk) {
                const int sna = (s + 1) % PD, snb = (s + 1) % PDB;
                const char* As = lm + G_AS + (ks & 1) * G_ASZ; const char* Bs = lm + G_BS + (ks & 1) * G_BSZ;
#define GB_STAGE() do { if (ks + 1 < nk && pvar != 3) { GB_STORE(sna, snb, (ks + 1) & 1); \
                    if (pvar != 2) { if (ks + 1 + PD < nk) GB_LOADA(sna, ks + 1 + PD); if (ks + 1 + PDB < nk) GB_LOADB(snb, ks + 1 + PDB); } } } while (0)
#define GB_COMPUTE() do { if (pvar != 1 && pvar != 3) { \
                  \
                bf16x8 bq[2][4]; bf16x8 af[4 * MS]; \
                _Pragma("unroll") for (int ni = 0; ni < 4; ++ni) bq[0][ni] = *(const bf16x8*)(Bs + swz(64 * wn + 16 * ni + c, q)); \
                af[0] = *(const bf16x8*)(As + swz(32 * MS * wm + c, q)); \
                af[1] = *(const bf16x8*)(As + swz(32 * MS * wm + 16 + c, q)); \
                __builtin_amdgcn_sched_barrier(0); \
                _Pragma("unroll") for (int g = 0; g < 4 * MS; ++g) { \
                    const int kk = g / (2 * MS), mi = g % (2 * MS); \
                    if (g + 2 < 4 * MS) { const int kk2 = (g + 2) / (2 * MS), mi2 = (g + 2) % (2 * MS); af[g + 2] = *(const bf16x8*)(As + swz(32 * MS * wm + 16 * mi2 + c, 4 * kk2 + q)); } \
                    if (kk == 0 && mi < 2) { bq[1][2 * mi] = *(const bf16x8*)(Bs + swz(64 * wn + 16 * (2 * mi) + c, 4 + q)); bq[1][2 * mi + 1] = *(const bf16x8*)(Bs + swz(64 * wn + 16 * (2 * mi + 1) + c, 4 + q)); } \
                    if (32 * MS * wm + 16 * mi < rowlim) { \
                        _Pragma("unroll") for (int ni = 0; ni < 4; ++ni) \
                            acc[mi][ni] = TRANS ? __builtin_amdgcn_mfma_f32_16x16x32_bf16(bq[kk][ni], af[g], acc[mi][ni], 0, 0, 0) \
                                                : __builtin_amdgcn_mfma_f32_16x16x32_bf16(af[g], bq[kk][ni], acc[mi][ni], 0, 0, 0); \
                    } \
                    __builtin_amdgcn_sched_barrier(0); \
                } } } while (0)
                if (w < 4) { GB_STAGE(); GB_COMPUTE(); } else { GB_COMPUTE(); GB_STAGE(); }
#undef GB_STAGE
#undef GB_COMPUTE
                __syncthreads();
            }
        }
    }
#undef GB_LOADA
#undef GB_LOADB
#undef GB_STORE
    ep(acc, 32 * MS * wm, 64 * wn, rowlim, c, q);
}

struct ASrcPlain { const bf16_t* base; DEV u32x4 ld(int off, int ks) const { return *(const u32x4*)(base + off + ks * 64); } };
struct ASrcRouter {
    const bf16_t *hi, *lo;
    DEV u32x4 ld(int off, int ks) const { const int seg = ks >> 4, kk = ks & 15; return *(const u32x4*)(((seg == 1) ? lo : hi) + off + kk * 64); }
};

DEV void store_vt_chunk(char* Vs, int row, int ch, const u32x4& v) {
    const int g2 = ch & ~1, e8 = (ch & 1) * 8;
    u32x2 lo; lo.x = v.x; lo.y = v.y; u32x2 hi; hi.x = v.z; hi.y = v.w;
    *(u32x2*)(Vs + swz(row, g2) + e8) = lo;
    *(u32x2*)(Vs + swz(row, g2 + 1) + e8) = hi;
}
DEV f32x16 qk32(const char* Ks, int kt, const bf16x8 (&qf)[4], int r, int hi, const f32x16& c0) {
    f32x16 a = c0;
#pragma unroll
    for (int s = 0; s < 4; ++s) {
        const bf16x8 kf = *(const bf16x8*)(Ks + swz(32 * kt + r, 2 * s + hi));
        a = __builtin_amdgcn_mfma_f32_32x32x16_bf16(kf, qf[s], a, 0, 0, 0);
    }
    return a;
}
template <int NDT>
DEV void pv32(const char* Vs, int kt, const bf16x8 (&pf)[2], f32x16 (&O)[NDT], int r, int hi) {
#pragma unroll
    for (int s2 = 0; s2 < 2; ++s2)
#pragma unroll
        for (int dt = 0; dt < NDT; ++dt) {
            const bf16x8 vf = *(const bf16x8*)(Vs + swz(32 * dt + r, 4 * kt + 2 * s2 + hi));
            O[dt] = __builtin_amdgcn_mfma_f32_32x32x16_bf16(vf, pf[s2], O[dt], 0, 0, 0);
        }
}
template <int NDT>
DEV void vload(const char* Vs, int kt, bf16x8 (&vf)[2 * NDT], int r, int hi) {
#pragma unroll
    for (int s2 = 0; s2 < 2; ++s2)
#pragma unroll
        for (int dt = 0; dt < NDT; ++dt) vf[s2 * NDT + dt] = *(const bf16x8*)(Vs + swz(32 * dt + r, 4 * kt + 2 * s2 + hi));
}
template <int NDT>
DEV void pvmma(const bf16x8 (&vf)[2 * NDT], const bf16x8 (&pf)[2], f32x16 (&O)[NDT]) {
#pragma unroll
    for (int s2 = 0; s2 < 2; ++s2)
#pragma unroll
        for (int dt = 0; dt < NDT; ++dt) O[dt] = __builtin_amdgcn_mfma_f32_32x32x16_bf16(vf[s2 * NDT + dt], pf[s2], O[dt], 0, 0, 0);
}
DEV void pack_p(const float (&pv)[16], bf16x8 (&pf)[2]) {
#pragma unroll
    for (int s2 = 0; s2 < 2; ++s2) {
        u32x4 u;
        u.x = cvt_pk_bf16(pv[8 * s2 + 0], pv[8 * s2 + 1]); u.y = cvt_pk_bf16(pv[8 * s2 + 2], pv[8 * s2 + 3]);
        u.z = cvt_pk_bf16(pv[8 * s2 + 4], pv[8 * s2 + 5]); u.w = cvt_pk_bf16(pv[8 * s2 + 6], pv[8 * s2 + 7]);
        pf[s2] = __builtin_bit_cast(bf16x8, u);
    }
}
DEV float xhalf_max(float v) {
    auto rr = __builtin_amdgcn_permlane32_swap(__float_as_uint(v), __float_as_uint(v), false, false);
    return fmaxf(__uint_as_float(rr[0]), __uint_as_float(rr[1]));
}
DEV float xsum8(float v) { return v + dppf<0x128>(v); }
DEV float xsum16(float v) {
    auto rr = __builtin_amdgcn_permlane16_swap(__float_as_uint(v), __float_as_uint(v), false, false);
    return __uint_as_float(rr[0]) + __uint_as_float(rr[1]);
}
DEV float xget32(float v, int hi) {
    auto rr = __builtin_amdgcn_permlane32_swap(__float_as_uint(v), __float_as_uint(v), false, false);
    return hi ? __uint_as_float(rr[0]) : __uint_as_float(rr[1]);
}
DEV float rowmax16(const float (&s)[16]) {
    float a = fmaxf(fmaxf(s[0], s[1]), s[2]), b = fmaxf(fmaxf(s[3], s[4]), s[5]);
    a = fmaxf(fmaxf(a, s[6]), s[7]); b = fmaxf(fmaxf(b, s[8]), s[9]);
    a = fmaxf(fmaxf(a, s[10]), s[11]); b = fmaxf(fmaxf(b, s[12]), s[13]);
    a = fmaxf(fmaxf(a, s[14]), s[15]);
    return xhalf_max(fmaxf(a, b));
}
constexpr float OSM_THR = 24.0f;
template <int NDT>
DEV void osm_update(float (&s)[16], float& m, float& l, f32x16 (&O)[NDT]) {
    const float mx = rowmax16(s);
    if (__any(mx > m + OSM_THR)) {
        const float mn = fmaxf(m, mx);
        const float alpha = fexp2(m - mn);
        l *= alpha; m = mn;
#pragma unroll
        for (int dt = 0; dt < NDT; ++dt)
#pragma unroll
            for (int i = 0; i < 16; ++i) O[dt][i] *= alpha;
    }
    float sum = 0.f;
#pragma unroll
    for (int i = 0; i < 16; ++i) { s[i] = fexp2(s[i] - m); sum += s[i]; }
    l += sum;
}
DEV float osm_ref(float m) { return m < -1e29f ? 0.f : m; }
template <int NDT>
DEV void osm_update_rel(float (&s)[16], float& m, float& l, f32x16 (&O)[NDT]) {
    const float mx = rowmax16(s);
    const bool first = m < -1e29f;
    const bool need = first ? (mx > -INFINITY) : (mx > OSM_THR);
    if (__any(need)) {
        const float d = need ? mx : 0.f;
        const float alpha = first ? 0.f : fexp2(-d);
        l *= alpha; m = need ? ((first ? 0.f : m) + d) : m;
#pragma unroll
        for (int dt = 0; dt < NDT; ++dt)
#pragma unroll
            for (int i = 0; i < 16; ++i) O[dt][i] *= alpha;
#pragma unroll
        for (int i = 0; i < 16; ++i) s[i] -= d;
    }
    float sum = 0.f;
#pragma unroll
    for (int i = 0; i < 16; ++i) { s[i] = fexp2(s[i]); sum += s[i]; }
    l += sum;
}
DEV float max16_local(const float (&s)[16]) {
    float a = fmaxf(fmaxf(s[0], s[1]), s[2]), b = fmaxf(fmaxf(s[3], s[4]), s[5]);
    a = fmaxf(fmaxf(a, s[6]), s[7]); b = fmaxf(fmaxf(b, s[8]), s[9]);
    a = fmaxf(fmaxf(a, s[10]), s[11]); b = fmaxf(fmaxf(b, s[12]), s[13]);
    a = fmaxf(fmaxf(a, s[14]), s[15]);
    return fmaxf(a, b);
}
template <int NDT>
DEV void osm_update_rel2(float (&s0)[16], float (&s1)[16], float& m, float& l, f32x16 (&O)[NDT], bool calm = false) {
    if (!calm) {
    const float mx = xhalf_max(fmaxf(max16_local(s0), max16_local(s1)));
    const bool first = m < -1e29f;
    const bool need = first ? (mx > -INFINITY) : (mx > OSM_THR);
    if (__any(need)) {
        const float d = need ? mx : 0.f;
        const float alpha = first ? 0.f : fexp2(-d);
        l *= alpha; m = need ? ((first ? 0.f : m) + d) : m;
#pragma unroll
        for (int dt = 0; dt < NDT; ++dt)
#pragma unroll
            for (int i = 0; i < 16; ++i) O[dt][i] *= alpha;
#pragma unroll
        for (int i = 0; i < 16; ++i) { s0[i] -= d; s1[i] -= d; }
    }
    }
    float sum0 = 0.f, sum1 = 0.f;
#pragma unroll
    for (int i = 0; i < 16; ++i) { s0[i] = fexp2(s0[i]); sum0 += s0[i]; }
#pragma unroll
    for (int i = 0; i < 16; ++i) { s1[i] = fexp2(s1[i]); sum1 += s1[i]; }
    l += sum0 + sum1;
}
DEV f32x16 score_cbias(float slope2, int ks) {
    f32x16 c;
#pragma unroll
    for (int i = 0; i < 16; ++i) c[i] = slope2 * (float)(ks * ((i & 3) + 8 * (i >> 2)));
    return c;
}
template <int KS, bool WIN>
DEV void make_scores(const f32x16& a, float (&s)[16], int D0, float slope2, bool selb, float mref = 0.f) {
    const float nb0 = selb ? (-slope2 * (float)D0 - mref) : -INFINITY;
#pragma unroll
    for (int i = 0; i < 16; ++i) s[i] = a[i] + nb0;
    if (__any(D0 < 27 * KS || (WIN && D0 >= 512))) {
#pragma unroll
        for (int i = 0; i < 16; ++i) {
            const int dist = D0 - KS * ((i & 3) + 8 * (i >> 2));
            const bool valid = selb && dist >= 0 && (!WIN || dist < 512);
            s[i] = valid ? s[i] : -INFINITY;
        }
    }
}
DEV int first_bit4(unsigned a, unsigned b, unsigned c, unsigned d, int from) {
    if (from < 32)  { const unsigned v = a & (0xffffffffu << from); if (v) return __builtin_ctz(v); from = 32; }
    if (from < 64)  { const unsigned v = b & (0xffffffffu << (from - 32)); if (v) return 32 + __builtin_ctz(v); from = 64; }
    if (from < 96)  { const unsigned v = c & (0xffffffffu << (from - 64)); if (v) return 64 + __builtin_ctz(v); from = 96; }
    if (from < 128) { const unsigned v = d & (0xffffffffu << (from - 96)); if (v) return 96 + __builtin_ctz(v); }
    return -1;
}
DEV unsigned range_mask32(int lo, int hi, int base) {
    int a = lo - base, b = hi - base; if (a < 0) a = 0; if (b > 31) b = 31; if (a > b) return 0u;
    const unsigned up = (b == 31) ? 0xffffffffu : ((1u << (b + 1)) - 1u);
    return up & (0xffffffffu << a);
}

constexpr int NSA_B1 = 118784;
template <int MODE>
DEV void nsa_tile(const char* Ks, const char* Vs, float* imp, int j, unsigned mk0, unsigned mk1, unsigned mk2, unsigned mk3,
                  const bf16x8 (&qf)[4], int t, int tl, float slope2, float& m, float& l, float inv, f32x16 (&O)[2], int r, int hi, float& carry, const f32x16& cb) {
    bool selb = true;
    if (MODE == 2) { const unsigned wsel = (j < 32) ? mk0 : (j < 64) ? mk1 : (j < 96) ? mk2 : mk3; selb = (wsel >> (j & 31)) & 1u; }
    if (MODE == 2 && !__any(selb)) return;
    if (MODE >= 2) {
        const f32x16 a0 = qk32(Ks, 0, qf, r, hi, cb); const f32x16 a1 = qk32(Ks, 1, qf, r, hi, cb);
        bf16x8 vf[4];
        vload<2>(Vs, 0, vf, r, hi);
        float s0[16], s1[16]; const float mr = osm_ref(m);
        if (MODE == 2) { make_scores<1, false>(a0, s0, t - (64 * j + 4 * hi), slope2, selb, mr); make_scores<1, false>(a1, s1, t - (64 * j + 32 + 4 * hi), slope2, selb, mr); }
        else { make_scores<1, true>(a0, s0, t - (64 * j + 4 * hi), slope2, true, mr); make_scores<1, true>(a1, s1, t - (64 * j + 32 + 4 * hi), slope2, true, mr); }
        osm_update_rel2<2>(s0, s1, m, l, O);
        { bf16x8 pf[2]; pack_p(s0, pf); pvmma<2>(vf, pf, O); }
        vload<2>(Vs, 1, vf, r, hi);
        { bf16x8 pf[2]; pack_p(s1, pf); pvmma<2>(vf, pf, O); }
        return;
    }
#pragma unroll
    for (int kt = 0; kt < 2; ++kt) {
        const f32x16 a = qk32(Ks, kt, qf, r, hi, cb);
        bf16x8 vf[4];
        if (MODE != 0) vload<2>(Vs, kt, vf, r, hi);
        float s[16];
        if (MODE <= 1) make_scores<16, false>(a, s, t - 31 - 16 * (64 * j + 32 * kt + 4 * hi), slope2, true, MODE == 0 ? osm_ref(m) : m + inv);
        else if (MODE == 2) make_scores<1, false>(a, s, t - (64 * j + 32 * kt + 4 * hi), slope2, selb, osm_ref(m));
        else make_scores<1, true>(a, s, t - (64 * j + 32 * kt + 4 * hi), slope2, true, osm_ref(m));
        if (MODE == 0) {
            const float mx = rowmax16(s);
            const bool first = m < -1e29f;
            const bool need = first ? (mx > -INFINITY) : (mx > OSM_THR);
            if (__any(need)) {
                const float d = need ? mx : 0.f;
                l *= first ? 0.f : fexp2(-d); m = need ? ((first ? 0.f : m) + d) : m;
#pragma unroll
                for (int i = 0; i < 16; ++i) s[i] -= d;
            }
            float sum = 0.f;
#pragma unroll
            for (int i = 0; i < 16; ++i) sum += fexp2(s[i]);
            l += sum;
        } else if (MODE == 1) {
#pragma unroll
            for (int i = 0; i < 16; ++i) s[i] = fexp2(s[i]);
            {
                float av[4], hb[4];
#pragma unroll
                for (int gi = 0; gi < 4; ++gi) {
                    hb[gi] = 0.5f * s[4 * gi + 3]; av[gi] = s[4 * gi] + s[4 * gi + 1] + s[4 * gi + 2] + hb[gi];
                    av[gi] = xsum16(xsum8(av[gi]));
                    hb[gi] = xsum16(xsum8(hb[gi]));
                }
                float ph[4];
#pragma unroll
                for (int gi = 0; gi < 4; ++gi) ph[gi] = xget32(hb[gi], hi);
                float val[4];
#pragma unroll
                for (int gi = 0; gi < 4; ++gi) val[gi] = av[gi] + (hi ? ph[gi] : (gi ? ph[gi - 1] : carry));
                carry = ph[3];
                if ((r >> 3) == 0) {
                    float* ip = imp + tl * 129 + 16 * j + 8 * kt + hi;
#pragma unroll
                    for (int gi = 0; gi < 4; ++gi) ip[2 * gi] = val[gi];
                }
            }
            bf16x8 pf[2]; pack_p(s, pf); pvmma<2>(vf, pf, O);
        } else {
            osm_update_rel<2>(s, m, l, O);
            bf16x8 pf[2]; pack_p(s, pf); pvmma<2>(vf, pf, O);
        }
    }
}

template <int MODE>
DEV void nsa_branch(char* Ks, char* Vs, float* imp, const bf16_t* kbase, int kld, const bf16_t* vbase, int vld,
                    unsigned tm0, unsigned tm1, unsigned tm2, unsigned tm3, unsigned mk0, unsigned mk1, unsigned mk2, unsigned mk3,
                    const bf16x8 (&qf)[4], int t, int tl, float slope2, float& m, float& l, float inv, f32x16 (&O)[2]) {
    const int tid = ltid(), lane = tid & 63, r = lane & 31, hi = lane >> 5, krow = tid >> 3, kch = tid & 7;
    const u32x4 z4 = (u32x4){0u, 0u, 0u, 0u};
    u32x4 rkA = z4, rvA = z4, rkB = z4, rvB = z4, rkC = z4, rvC = z4; int jA, jB, jC;
    float carry = 0.f;
    const f32x16 cb = score_cbias(slope2, MODE <= 1 ? 16 : 1);
    int jn = first_bit4(tm0, tm1, tm2, tm3, 0);
#define NSA_LDT(rk, rv, jr) do { jr = jn; if (jn >= 0) { \
        rk = *(const u32x4*)(kbase + (size_t)(64 * jn + krow) * kld + kch * 8); \
        if (MODE != 0) rv = *(const u32x4*)(vbase + (size_t)krow * vld + 64 * jn + kch * 8); \
        jn = first_bit4(tm0, tm1, tm2, tm3, jn + 1); } } while (0)
#define NSA_STORE(rk, rv, bsel) do { char* Kd_ = Ks + (bsel) * NSA_B1; char* Vd_ = Vs + (bsel) * NSA_B1; \
        *(u32x4*)(Kd_ + swz(krow, kch)) = rk; if (MODE == 1) store_vt_chunk(Vd_, krow, kch, rv); else if (MODE != 0) *(u32x4*)(Vd_ + swz(krow, kch)) = rv; } while (0)
#define NSA_PHASE(rk, rv, jr) { const int jnx_ = jr; \
        if (jnx_ >= 0) { NSA_STORE(rk, rv, bsel ^ 1); NSA_LDT(rk, rv, jr); } \
        nsa_tile<MODE>(Ks + bsel * NSA_B1, Vs + bsel * NSA_B1, imp, jc, mk0, mk1, mk2, mk3, qf, t, tl, slope2, m, l, inv, O, r, hi, carry, cb); \
        __syncthreads(); \
        if (jnx_ < 0) break; jc = jnx_; bsel ^= 1; }
    NSA_LDT(rkA, rvA, jA); NSA_LDT(rkB, rvB, jB); NSA_LDT(rkC, rvC, jC);
    if (jA >= 0) {
        int jc = jA, bsel = 0;
        __syncthreads();
        NSA_STORE(rkA, rvA, 0);
        NSA_LDT(rkA, rvA, jA);
        __syncthreads();
        for (;;) {
            NSA_PHASE(rkB, rvB, jB)
            NSA_PHASE(rkC, rvC, jC)
            NSA_PHASE(rkA, rvA, jA)
        }
    }
#undef NSA_STORE
#undef NSA_PHASE
#undef NSA_LDT
}

constexpr int N_KS = 0, N_VS = 9216, N_IMP = 18432, N_SEL = N_IMP + 64 * 129 * 4  , N_UNI = N_SEL + 1024, N_OUT = 52736;

DEV void nsa_unit(const Params& p, char* lm, int b, int g, int qb, int pv = 0) {
    const int tid = ltid(), lane = tid & 63, w = tid >> 6, r = lane & 31, hi = lane >> 5, hh = r >> 3;
    const int head = g * 4 + hh, tl = 8 * w + (r & 7), t = 64 * qb + tl;
    const size_t row = (size_t)b * SEQ + t;
    const float slope2 = LOG2E / (float)(2 << head);
    char* Ks = lm + N_KS; char* Vs = lm + N_VS; float* imp = (float*)(lm + N_IMP);
    unsigned* selm = (unsigned*)(lm + N_SEL); unsigned* uni = (unsigned*)(lm + N_UNI);
    __syncthreads();
    for (int i = tid; i < 64 * 129; i += 512) imp[i] = 0.f;
    if (tid < 4) uni[tid] = 0u;
    const bf16_t* prow = p.proj + row * LD;
    bf16x8 qf[4];
#pragma unroll
    for (int s = 0; s < 4; ++s) qf[s] = *(const bf16x8*)(prow + QOFF + head * 64 + 16 * s + 8 * hi);
    float gt[3];
#pragma unroll
    for (int c3 = 0; c3 < 3; ++c3) gt[c3] = sigmoidf_(bf2f(prow[GTOFF + head * 3 + c3]));
    float* outl = (float*)(lm + N_OUT) + tid;
    f32x16 O[2];
#pragma unroll
    for (int dt = 0; dt < 2; ++dt)
#pragma unroll
        for (int i = 0; i < 16; ++i) O[dt][i] = 0.f;

    {
        int ncmp = 4 * qb + 3; if (ncmp > 511) ncmp = 511;
        const int ntc = (ncmp + 63) >> 6;
        const unsigned tm0 = (1u << ntc) - 1u;
        const bf16_t* kb = p.kc + (size_t)((b * 2 + g) * 512) * 64;
        const bf16_t* vb = p.vcT + (size_t)((b * 2 + g) * 64) * 512;
        float m = -1e30f, l = 0.f;
        if (pv != 21) nsa_branch<0>(Ks, Vs, imp, kb, 64, vb, 512, tm0, 0u, 0u, 0u, 0u, 0u, 0u, 0u, qf, t, tl, slope2, m, l, 0.f, O);
        const float lt = l + __shfl_xor(l, 32);
        const float inv = __log2f(fmaxf(lt, 1e-30f));
        if (pv != 21 && pv != 24) nsa_branch<1>(Ks, Vs, imp, kb, 64, vb, 512, tm0, 0u, 0u, 0u, 0u, 0u, 0u, 0u, qf, t, tl, slope2, m, l, inv, O);
#pragma unroll
        for (int dt = 0; dt < 2; ++dt)
#pragma unroll
            for (int i = 0; i < 16; ++i) { outl[(16 * dt + i) * 512] = gt[0] * O[dt][i]; O[dt][i] = 0.f; }
    }
    __syncthreads();
    if (qb + 1 <= 16) {
        if (tid < 64) { const unsigned s0 = range_mask32(0, qb, 0); selm[tid * 4 + 0] = s0; selm[tid * 4 + 1] = 0u; selm[tid * 4 + 2] = 0u; selm[tid * 4 + 3] = 0u; }
        if (tid == 0) uni[0] = range_mask32(0, qb, 0);
    } else {
        if (tid < 64) { imp[tid * 129] += 1e4f; imp[tid * 129 + qb] += 1e4f; imp[tid * 129 + qb - 1] += 1e4f; }
        if (tid < 256) selm[tid] = 0u;
        __syncthreads();
        const int tok = tid >> 3, j0 = tid & 7;
        unsigned vb[16];
#pragma unroll
        for (int jj = 0; jj < 16; ++jj) { const int j = j0 + 8 * jj; vb[jj] = (j <= qb) ? __float_as_uint(imp[tok * 129 + j]) : 0u; }
        unsigned T = 0u;
#pragma unroll 1
        for (int bit = 30; bit >= 0; --bit) {
            const unsigned trial = T | (1u << bit);
            int cnt = 0;
#pragma unroll
            for (int jj = 0; jj < 16; ++jj) cnt += (vb[jj] >= trial) ? 1 : 0;
            cnt += __builtin_amdgcn_update_dpp(0, cnt, 0xB1, 0xF, 0xF, true); cnt += __builtin_amdgcn_update_dpp(0, cnt, 0x4E, 0xF, 0xF, true);
            cnt += __builtin_amdgcn_update_dpp(0, cnt, 0x141, 0xF, 0xF, true);
            if (cnt >= 16) T = trial;
        }
        int cgt = 0;
#pragma unroll
        for (int jj = 0; jj < 16; ++jj) cgt += (vb[jj] > T) ? 1 : 0;
        cgt += __builtin_amdgcn_update_dpp(0, cgt, 0xB1, 0xF, 0xF, true); cgt += __builtin_amdgcn_update_dpp(0, cgt, 0x4E, 0xF, 0xF, true);
        cgt += __builtin_amdgcn_update_dpp(0, cgt, 0x141, 0xF, 0xF, true);
        const int need = 16 - cgt;
        int running = 0;
        unsigned s0 = 0u, s1 = 0u, s2 = 0u, s3 = 0u;
#pragma unroll
        for (int jj = 0; jj < 16; ++jj) {
            const int j = j0 + 8 * jj;
            const bool eq = vb[jj] == T;
            const unsigned grp = (unsigned)(__ballot(eq) >> (lane & 56)) & 0xffu;
            const int before = running + __builtin_popcount(grp & ((1u << j0) - 1u));
            running += __builtin_popcount(grp);
            if (j <= qb && (vb[jj] > T || (eq && before < need))) { const unsigned bit = 1u << (j & 31); if (jj < 4) s0 |= bit; else if (jj < 8) s1 |= bit; else if (jj < 12) s2 |= bit; else s3 |= bit; }
        }
#define NSA_OR8(v_) do { v_ |= (unsigned)__builtin_amdgcn_update_dpp(0, (int)v_, 0xB1, 0xF, 0xF, true); v_ |= (unsigned)__builtin_amdgcn_update_dpp(0, (int)v_, 0x4E, 0xF, 0xF, true); \
        v_ |= (unsigned)__builtin_amdgcn_update_dpp(0, (int)v_, 0x141, 0xF, 0xF, true); } while (0)
#define NSA_ORW(v_) ((unsigned)(__builtin_amdgcn_readlane((int)(v_ | (unsigned)__builtin_amdgcn_update_dpp(0, (int)v_, 0x140, 0xF, 0xF, true)), 0) | \
        __builtin_amdgcn_readlane((int)(v_ | (unsigned)__builtin_amdgcn_update_dpp(0, (int)v_, 0x140, 0xF, 0xF, true)), 16) | \
        __builtin_amdgcn_readlane((int)(v_ | (unsigned)__builtin_amdgcn_update_dpp(0, (int)v_, 0x140, 0xF, 0xF, true)), 32) | \
        __builtin_amdgcn_readlane((int)(v_ | (unsigned)__builtin_amdgcn_update_dpp(0, (int)v_, 0x140, 0xF, 0xF, true)), 48)))
        NSA_OR8(s0); NSA_OR8(s1); NSA_OR8(s2); NSA_OR8(s3);
        if (j0 == 0) { selm[tok * 4 + 0] = s0; selm[tok * 4 + 1] = s1; selm[tok * 4 + 2] = s2; selm[tok * 4 + 3] = s3; }
        { const unsigned w0 = NSA_ORW(s0), w1 = NSA_ORW(s1), w2 = NSA_ORW(s2), w3 = NSA_ORW(s3);
          if (lane == 0) { if (w0) atomicOr(&uni[0], w0); if (w1) atomicOr(&uni[1], w1); if (w2) atomicOr(&uni[2], w2); if (w3) atomicOr(&uni[3], w3); } }
#undef NSA_OR8
#undef NSA_ORW
    }
    __syncthreads();
    {
        const unsigned u0 = uni[0], u1 = uni[1], u2 = uni[2], u3 = uni[3];
        const unsigned mk0 = selm[tl * 4 + 0], mk1 = selm[tl * 4 + 1], mk2 = selm[tl * 4 + 2], mk3 = selm[tl * 4 + 3];
        const bf16_t* kb = p.proj + (size_t)b * SEQ * LD + KSOFF + g * 64;
        const bf16_t* vb = p.vT + (size_t)(b * VT_ROWS + VT_SEL + g * 64) * SEQ;
        float m = -1e30f, l = 0.f;
        if (pv != 22) nsa_branch<2>(Ks, Vs, imp, kb, LD, vb, SEQ, u0, u1, u2, u3, mk0, mk1, mk2, mk3, qf, t, tl, slope2, m, l, 0.f, O);
        const float lt = l + __shfl_xor(l, 32);
        const float sc = gt[1] / fmaxf(lt, 1e-30f);
#pragma unroll
        for (int dt = 0; dt < 2; ++dt)
#pragma unroll
            for (int i = 0; i < 16; ++i) { outl[(16 * dt + i) * 512] += sc * O[dt][i]; O[dt][i] = 0.f; }
    }
    {
        const int jlo = qb - 8 < 0 ? 0 : qb - 8;
        const unsigned w0 = range_mask32(jlo, qb, 0), w1 = range_mask32(jlo, qb, 32), w2 = range_mask32(jlo, qb, 64), w3 = range_mask32(jlo, qb, 96);
        const bf16_t* kb = p.proj + (size_t)b * SEQ * LD + KWOFF + g * 64;
        const bf16_t* vb = p.vT + (size_t)(b * VT_ROWS + VT_WIN + g * 64) * SEQ;
        float m = -1e30f, l = 0.f;
        if (pv != 23) nsa_branch<3>(Ks, Vs, imp, kb, LD, vb, SEQ, w0, w1, w2, w3, 0u, 0u, 0u, 0u, qf, t, tl, slope2, m, l, 0.f, O);
        const float lt = l + __shfl_xor(l, 32);
        const float sc = gt[2] / fmaxf(lt, 1e-30f);
#pragma unroll
        for (int dt = 0; dt < 2; ++dt)
#pragma unroll
            for (int i = 0; i < 16; ++i) O[dt][i] = outl[(16 * dt + i) * 512] + sc * O[dt][i];
    }
    bf16_t* orow = p.ocat + row * DM + head * 64;
#pragma unroll
    for (int dt = 0; dt < 2; ++dt)
#pragma unroll
        for (int gi = 0; gi < 4; ++gi) {
            u32x2 v; v.x = cvt_pk_bf16(O[dt][4 * gi], O[dt][4 * gi + 1]); v.y = cvt_pk_bf16(O[dt][4 * gi + 2], O[dt][4 * gi + 3]);
            *(u32x2*)(orow + 32 * dt + 8 * gi + 4 * hi) = v;
        }
}

constexpr int D_SLOT = 32768, D_NSLOT = 3, D_FLAG = D_NSLOT * D_SLOT, D_XS = 132;
DEV void diff_unit(const Params& p, char* lm, int b, int h, int qblk, int pv = 0) {
    const int tid = ltid(), lane = tid & 63, w = tid >> 6, r = lane & 31, hi = lane >> 5, mp = w >> 2, qs = w & 3;
    const int ql = 32 * qs + r, t = 128 * qblk + ql;
    const size_t row = (size_t)b * SEQ + t;
    const float slope2 = LOG2E / (float)(1 << (2 * (h + 1)));
    const bf16_t* prow = p.proj + row * LD;
    bf16x8 qf[4];
#pragma unroll
    for (int s = 0; s < 4; ++s) qf[s] = *(const bf16x8*)(prow + DQOFF + h * 128 + mp * 64 + 16 * s + 8 * hi);
    f32x16 O[4];
#pragma unroll
    for (int dt = 0; dt < 4; ++dt)
#pragma unroll
        for (int i = 0; i < 16; ++i) O[dt][i] = 0.f;
    float m = -1e30f, l = 0.f;
    const bf16_t* kb = p.proj + (size_t)b * SEQ * LD + DKOFF + h * 128;
    const bf16_t* vb = p.vT + (size_t)(b * VT_ROWS + VT_DV + h * 128) * SEQ;
    const int ntl = 2 * qblk + 2;
    const float kmax2 = __uint_as_float(p.ctrl[CT_KMAX + 64 * (b * 8 + h * 2 + mp)]);
    const f32x16 cb = score_cbias(slope2, 1);
    unsigned* dflag = (unsigned*)(lm + D_FLAG);
    bool stop = false;
    const int wu = __builtin_amdgcn_readfirstlane(w);
    const int kr = 8 * wu + (lane >> 3), vr0 = 16 * wu + (lane >> 3), vr1 = vr0 + 8;
    const unsigned offK = (unsigned)(kr * LD + (((lane & 7) ^ ((kr >> 1) & 7)) << 3));
    const unsigned offV0 = (unsigned)(vr0 * SEQ + (((lane & 7) ^ ((vr0 >> 1) & 7)) << 3));
    const unsigned offV1 = (unsigned)(vr1 * SEQ + (((lane & 7) ^ ((vr1 >> 1) & 7)) << 3));
    LAS char* ring = (LAS char*)lm;
#define DIFF_DMA(jj, sboff) do { if ((jj) < ntl) { const int k0_ = 64 * (ntl - 1 - (jj)); \
        const bf16_t* kt_ = kb + (size_t)k0_ * LD; const bf16_t* vt_ = vb + k0_; \
        LAS char* sl_ = ring + (sboff) + wu * 1024; \
        __builtin_amdgcn_global_load_lds((const unsigned*)(kt_ + offK), (LAS unsigned*)(sl_), 16, 0, 0); \
        __builtin_amdgcn_global_load_lds((const unsigned*)(kt_ + offK + 64), (LAS unsigned*)(sl_ + 8192), 16, 0, 0); \
        __builtin_amdgcn_global_load_lds((const unsigned*)(vt_ + offV0), (LAS unsigned*)(sl_ + 16384 + wu * 1024), 16, 0, 0); \
        __builtin_amdgcn_global_load_lds((const unsigned*)(vt_ + offV1), (LAS unsigned*)(sl_ + 17408 + wu * 1024), 16, 0, 0); } } while (0)
#define DIFF_PV(Vp, pf) do { _Pragma("unroll") for (int c4 = 0; c4 < 4; ++c4) { \
        _Pragma("unroll") for (int dt = 0; dt < 4; ++dt) { const bf16x8 vf = *(const bf16x8*)((Vp) + swz(32 * dt + r, 2 * c4 + hi)); O[dt] = __builtin_amdgcn_mfma_f32_32x32x16_bf16(vf, (pf)[c4], O[dt], 0, 0, 0); } } } while (0)
#define DIFF_QKSM(Kp, pf) do { const f32x16 qa0 = qk32((Kp), 0, qf, r, hi, cb); const f32x16 qa1 = qk32((Kp), 1, qf, r, hi, cb); \
        float s0[16], s1[16]; const float mr_ = osm_ref(m); \
        make_scores<1, false>(qa0, s0, t - (64 * j_ + 4 * hi), slope2, true, mr_); make_scores<1, false>(qa1, s1, t - (64 * j_ + 32 + 4 * hi), slope2, true, mr_); \
        osm_update_rel2<4>(s0, s1, m, l, O, calm); \
        { bf16x8 pa_[2], pb_[2]; pack_p(s0, pa_); pack_p(s1, pb_); (pf)[0] = pa_[0]; (pf)[1] = pa_[1]; (pf)[2] = pb_[0]; (pf)[3] = pb_[1]; } } while (0)
    int sb = 0, sb2 = 2 * D_SLOT;
    DIFF_DMA(0, 0); DIFF_DMA(1, D_SLOT);
    float qn2 = 0.f;
#pragma unroll
    for (int s4 = 0; s4 < 4; ++s4)
#pragma unroll
        for (int e = 0; e < 8; ++e) { const float qv = bf2f((bf16_t)qf[s4][e]); qn2 += qv * qv; }
    qn2 += __shfl_xor(qn2, 32);
    const float ubase = sqrtf(qn2 * kmax2) * 1.001f + 1.0f;
    for (int jj = 0; jj < ntl; ++jj) {
        const int j_ = ntl - 1 - jj;
        const float ub = ubase - slope2 * (float)(t - (64 * j_ + 63));
        const bool chk = (jj & 7) == 0;
        if (chk) { const bool dead = __all(ub - m < -152.0f); if (lane == 0) dflag[w] = dead ? 1u : 0u; }
        const bool calm = __all(m > -1e29f && ub - m <= OSM_THR);
        if (jj + 1 < ntl) asm volatile("s_waitcnt vmcnt(4) lgkmcnt(0)" ::: "memory"); else asm volatile("s_waitcnt vmcnt(0) lgkmcnt(0)" ::: "memory");
        __builtin_amdgcn_s_barrier(); asm volatile("" ::: "memory");
        if (chk) { const u32x4 f0 = *(const u32x4*)dflag, f1 = *(const u32x4*)(dflag + 4); stop = (f0.x & f0.y & f0.z & f0.w & f1.x & f1.y & f1.z & f1.w) != 0u; }
        if (stop) break;
        DIFF_DMA(jj + 2, sb2);
        const char* Kp = lm + sb + mp * 8192; const char* Vp = lm + sb + 16384;
        { bf16x8 pf[4];
          DIFF_QKSM(Kp, pf);
          DIFF_PV(Vp, pf); }
        sb = (sb == 2 * D_SLOT) ? 0 : sb + D_SLOT; sb2 = (sb2 == 2 * D_SLOT) ? 0 : sb2 + D_SLOT;
    }
    asm volatile("s_waitcnt vmcnt(0)" ::: "memory");
#undef DIFF_DMA
#undef DIFF_PV
#undef DIFF_QKSM
    const float lt = l + __shfl_xor(l, 32);
    const float inv = 1.0f / fmaxf(lt, 1e-30f);
    __syncthreads();
    float* X = (float*)lm;
    if (mp == 1) {
#pragma unroll
        for (int dt = 0; dt < 4; ++dt)
#pragma unroll
            for (int i = 0; i < 16; ++i) X[ql * D_XS + 32 * dt + crow(i, hi)] = O[dt][i] * inv;
    }
    __syncthreads();
    if (mp == 0) {
        const float lam = p.misc[0];
        f32x4 gvs[16];
#pragma unroll
        for (int dg = 0; dg < 16; ++dg) gvs[dg] = *(const f32x4*)(p.diff_subln + 32 * (dg >> 2) + 8 * (dg & 3) + 4 * hi);
        float ss = 0.f;
#pragma unroll
        for (int dt = 0; dt < 4; ++dt)
#pragma unroll
            for (int i = 0; i < 16; ++i) { const float o = O[dt][i] * inv - lam * X[ql * D_XS + 32 * dt + crow(i, hi)]; O[dt][i] = o; ss += o * o; }
        ss += __shfl_xor(ss, 32);
        const float rs = rsqrtf(ss * (1.0f / 128.0f) + RMS_EPS) * 0.8f;
        bf16_t* orow = p.ocat + row * DM + 512 + h * 128;
#pragma unroll
        for (int dt = 0; dt < 4; ++dt)
#pragma unroll
            for (int gi = 0; gi < 4; ++gi) {
                const int d0 = 32 * dt + 8 * gi + 4 * hi;
                const f32x4 gv = gvs[4 * dt + gi];
                u32x2 v; v.x = cvt_pk_bf16(O[dt][4 * gi] * rs * gv[0], O[dt][4 * gi + 1] * rs * gv[1]);
                v.y = cvt_pk_bf16(O[dt][4 * gi + 2] * rs * gv[2], O[dt][4 * gi + 3] * rs * gv[3]);
                *(u32x2*)(orow + d0) = v;
            }
    }
    __syncthreads();
}

struct BLoadIn {
    const float* w; int n0;
    DEV f32x4 ld(int k, int n) const {
        const int cp = n0 + n; int cg;
        if (cp < 1280) cg = cp; else if (cp < 2816) cg = cp + 24; else if (cp < 2840) cg = cp - 2816 + 1280; else return (f32x4){0.f, 0.f, 0.f, 0.f};
        return *(const f32x4*)(w + (size_t)k * 2840 + cg);
    }
};
struct BLqPlain {
    const bf16_t* wt;
    DEV u32x4 ldq(int n, int ks, int ch) const { return *(const u32x4*)(wt + (size_t)n * 1024 + ks * 64 + ch * 8); }
};
DEV int pcol(int nl) { return (nl & ~31) + 8 * ((nl >> 2) & 3) + 4 * ((nl >> 4) & 1) + (nl & 3); }
struct BLqPerm {
    const bf16_t* wt;
    DEV u32x4 ldq(int n, int ks, int ch) const { return *(const u32x4*)(wt + (size_t)pcol(n) * 1024 + ks * 64 + ch * 8); }
};
struct BLqRouter {
    const bf16_t* wt;
    DEV u32x4 ldq(int n, int ks, int ch) const { const int seg = ks >> 4, kk = ks & 15; return *(const u32x4*)(wt + (size_t)((seg == 2 ? 256 : 0) + n) * 1024 + kk * 64 + ch * 8); }
};
struct BLoadPlain { const float* w; int ldb; DEV f32x4 ld(int k, int n) const { return *(const f32x4*)(w + (size_t)k * ldb + n); } };
struct BLoadRouter {
    const float* w;
    DEV f32x4 ld(int k, int n) const {
        const int seg = k >> 10, kk = k & 1023;
        f32x4 v = *(const f32x4*)(w + (size_t)kk * 256 + n);
        if (seg == 2) {
#pragma unroll
            for (int i = 0; i < 4; ++i) v[i] = v[i] - bf2f(f2bf(v[i]));
        }
        return v;
    }
};
struct BLoadGU {
    const float* w; int nt;
    DEV f32x4 ld(int k, int n) const {
        const int col = ((n >> 5) & 1) * 256 + 64 * nt + 32 * (n >> 6) + 8 * ((n >> 2) & 3) + 4 * ((n >> 4) & 1);
        return *(const f32x4*)(w + (size_t)k * 512 + col);
    }
};

template <int NM> struct EpiProj {
    bf16_t* o; int row0, col0;
    DEV void operator()(const f32x4 (&acc)[NM][4], int r0, int c0, int rowlim, int c, int q) const {
#pragma unroll
        for (int mi = 0; mi < NM; ++mi) {
            if (r0 + 16 * mi < rowlim) {
#pragma unroll
                for (int ni = 0; ni < 4; ++ni) {
                    const f32x4 v = acc[mi][ni]; u32x2 u; u.x = cvt_pk_bf16(v[0], v[1]); u.y = cvt_pk_bf16(v[2], v[3]);
                    *(u32x2*)(o + (size_t)(row0 + r0 + 16 * mi + c) * LD + col0 + c0 + 16 * ni + 4 * q) = u;
                }
            }
        }
    }
};
template <int NM> struct EpiVT {
    bf16_t* vt; int row0, vbase, bstride;
    DEV void operator()(const f32x4 (&acc)[NM][4], int r0, int c0, int rowlim, int c, int q) const {
#pragma unroll
        for (int mi = 0; mi < NM; ++mi) {
            if (r0 + 16 * mi < rowlim) {
                const int rg = row0 + r0 + 16 * mi + 4 * q, bb = rg >> 13, tt = rg & (SEQ - 1);
#pragma unroll
                for (int ni = 0; ni < 4; ++ni) {
                    const f32x4 v = acc[mi][ni]; u32x2 u; u.x = cvt_pk_bf16(v[0], v[1]); u.y = cvt_pk_bf16(v[2], v[3]);
                    *(u32x2*)(vt + (size_t)(vbase + bb * bstride + c0 + 16 * ni + c) * SEQ + tt) = u;
                }
            }
        }
    }
};
template <int NM> struct EpiF32 {
    float* o; int ldo, row0, col0;
    DEV void operator()(const f32x4 (&acc)[NM][4], int r0, int c0, int rowlim, int c, int q) const {
#pragma unroll
        for (int mi = 0; mi < NM; ++mi) {
            if (r0 + 16 * mi < rowlim) {
#pragma unroll
                for (int ni = 0; ni < 4; ++ni)
                    *(f32x4*)(o + (size_t)(row0 + r0 + 16 * mi + c) * ldo + col0 + c0 + 16 * ni + 4 * q) = acc[mi][ni];
            }
        }
    }
};
template <int NM> struct EpiSwiglu {
    bf16_t* H; const int* rslot; const float* rwt; int nt;
    DEV void operator()(const f32x4 (&acc)[NM][4], int r0, int c0, int rowlim, int c, int q) const {
#pragma unroll
        for (int mi = 0; mi < NM; ++mi) {
            if (r0 + 16 * mi < rowlim) {
                const int rr = r0 + 16 * mi + c; const int slot = rslot[rr];
                if (slot >= 0) {
                    const float wt = rwt[rr];
                    float hv[8];
#pragma unroll
                    for (int nh = 0; nh < 2; ++nh) {
                        const f32x4 a = acc[mi][nh], g = acc[mi][nh + 2];
#pragma unroll
                        for (int i = 0; i < 4; ++i) hv[4 * nh + i] = a[i] * __builtin_amdgcn_rcpf(1.0f + __expf(-a[i])) * g[i] * wt;
                    }
                    u32x4 u; u.x = cvt_pk_bf16(hv[0], hv[1]); u.y = cvt_pk_bf16(hv[2], hv[3]); u.z = cvt_pk_bf16(hv[4], hv[5]); u.w = cvt_pk_bf16(hv[6], hv[7]);
                    *(u32x4*)(H + (size_t)slot * 256 + 64 * nt + (c0 >> 1) + 8 * q) = u;
                }
            }
        }
    }
};

template <int MS, bool TRANS, bool BF, int PD, class AS, class BL, class EP>
DEV void gemm_ws(char* lm, int nk, int nsub, const AS& as, const BL& bl, const EP& ep) {
    const int tid = ltid(), lane = tid & 63, w = __builtin_amdgcn_readfirstlane(tid >> 6);
    const int* rowoff = (const int*)(lm + G_ROWOFF);
    const int rowlim = 128 * nsub;
    if (w < 4) {
        const int ar0 = tid >> 3, akc = tid & 7;
        const int bn4 = 8 * w + (lane & 7), bk0 = lane >> 3;
        u32x4 ra[PD][4 * MS]; f32x4 rb[BF ? 1 : PD][8]; u32x4 rq[BF ? PD : 1][4];
#define WS_LOAD(s_, ks_) do { \
        _Pragma("unroll") for (int i = 0; i < 4 * MS; ++i) if (32 * i < rowlim) ra[s_][i] = as.ld(rowoff[ar0 + 32 * i] + akc * 8, (ks_)); \
        if constexpr (BF) { _Pragma("unroll") for (int i = 0; i < 4; ++i) rq[s_][i] = bl.ldq(ar0 + 32 * i, (ks_), akc); } \
        else { _Pragma("unroll") for (int jq = 0; jq < 2; ++jq) _Pragma("unroll") for (int i = 0; i < 4; ++i) rb[s_][4 * jq + i] = bl.ld((ks_) * 64 + 4 * (bk0 + 8 * jq) + i, 4 * bn4); } } while (0)
#define WS_STORE(s_, buf_) do { char* As_ = lm + G_AS + (buf_) * G_ASZ; char* Bs_ = lm + G_BS + (buf_) * G_BSZ; \
        _Pragma("unroll") for (int i = 0; i < 4 * MS; ++i) if (32 * i < rowlim) *(u32x4*)(As_ + swz(ar0 + 32 * i, akc)) = ra[s_][i]; \
        if constexpr (BF) { _Pragma("unroll") for (int i = 0; i < 4; ++i) *(u32x4*)(Bs_ + swz(ar0 + 32 * i, akc)) = rq[s_][i]; } \
        else { _Pragma("unroll") for (int jq = 0; jq < 2; ++jq) _Pragma("unroll") for (int cc = 0; cc < 4; ++cc) { \
            u32x2 v; v.x = cvt_pk_bf16(rb[s_][4 * jq][cc], rb[s_][4 * jq + 1][cc]); v.y = cvt_pk_bf16(rb[s_][4 * jq + 2][cc], rb[s_][4 * jq + 3][cc]); \
            *(u32x2*)(Bs_ + swz(4 * bn4 + cc, (bk0 + 8 * jq) >> 1) + ((bk0 + 8 * jq) & 1) * 8) = v; } } } while (0)
#pragma unroll
        for (int s = 0; s < PD; ++s) {
#pragma unroll
            for (int i = 0; i < 4 * MS; ++i) ra[s][i] = (u32x4){0u, 0u, 0u, 0u};
            if constexpr (BF) {
#pragma unroll
                for (int i = 0; i < 4; ++i) rq[s][i] = (u32x4){0u, 0u, 0u, 0u};
            } else {
#pragma unroll
                for (int i = 0; i < 8; ++i) rb[s][i] = (f32x4){0.f, 0.f, 0.f, 0.f};
            }
            if (s < nk) WS_LOAD(s, s);
        }
        __syncthreads();
        WS_STORE(0, 0);
        if (PD < nk) WS_LOAD(0, PD);
        __syncthreads();
        for (int ks0 = 0; ks0 < nk; ks0 += PD) {
#pragma unroll
            for (int s = 0; s < PD; ++s) {
                const int ks = ks0 + s;
                if (ks < nk) {
                    const int sn = (s + 1) % PD;
                    if (ks + 1 < nk) { WS_STORE(sn, (ks + 1) & 1); if (ks + 1 + PD < nk) WS_LOAD(sn, ks + 1 + PD); }
                    __syncthreads();
                }
            }
        }
#undef WS_LOAD
#undef WS_STORE
    } else {
        const int cw = w - 4, c = lane & 15, q = lane >> 4;
        f32x4 acc[2 * MS][8];
#pragma unroll
        for (int mi = 0; mi < 2 * MS; ++mi)
#pragma unroll
            for (int ni = 0; ni < 8; ++ni) acc[mi][ni] = (f32x4){0.f, 0.f, 0.f, 0.f};
        __syncthreads();
        __syncthreads();
        for (int ks = 0; ks < nk; ++ks) {
            const char* As = lm + G_AS + (ks & 1) * G_ASZ; const char* Bs = lm + G_BS + (ks & 1) * G_BSZ;
            bf16x8 bq[2][8]; bf16x8 af[4 * MS];
#pragma unroll
            for (int ni = 0; ni < 8; ++ni) bq[0][ni] = *(const bf16x8*)(Bs + swz(16 * ni + c, q));
            af[0] = *(const bf16x8*)(As + swz(32 * MS * cw + c, q));
            af[1] = *(const bf16x8*)(As + swz(32 * MS * cw + 16 + c, q));
            __builtin_amdgcn_sched_barrier(0);
#pragma unroll
            for (int g = 0; g < 4 * MS; ++g) {
                const int kk = g / (2 * MS), mi = g % (2 * MS);
                if (g + 2 < 4 * MS) { const int kk2 = (g + 2) / (2 * MS), mi2 = (g + 2) % (2 * MS); af[g + 2] = *(const bf16x8*)(As + swz(32 * MS * cw + 16 * mi2 + c, 4 * kk2 + q)); }
                if (kk == 0 && mi < 4) {
                    bq[1][2 * mi] = *(const bf16x8*)(Bs + swz(16 * (2 * mi) + c, 4 + q));
                    bq[1][2 * mi + 1] = *(const bf16x8*)(Bs + swz(16 * (2 * mi + 1) + c, 4 + q));
                }
                if (32 * MS * cw + 16 * mi < rowlim) {
#pragma unroll
                    for (int ni = 0; ni < 8; ++ni)
                        acc[mi][ni] = TRANS ? __builtin_amdgcn_mfma_f32_16x16x32_bf16(bq[kk][ni], af[g], acc[mi][ni], 0, 0, 0)
                                            : __builtin_amdgcn_mfma_f32_16x16x32_bf16(af[g], bq[kk][ni], acc[mi][ni], 0, 0, 0);
                }
                __builtin_amdgcn_sched_barrier(0);
            }
            __syncthreads();
        }
        ep(acc, 32 * MS * cw, rowlim, c, q);
    }
}
template <int NM> struct EpiF32W {
    float* o; int ldo, row0, col0;
    DEV void operator()(const f32x4 (&acc)[NM][8], int r0, int rowlim, int c, int q) const {
#pragma unroll
        for (int mi = 0; mi < NM; ++mi) {
            if (r0 + 16 * mi < rowlim) {
#pragma unroll
                for (int ni = 0; ni < 8; ++ni)
                    *(f32x4*)(o + (size_t)(row0 + r0 + 16 * mi + c) * ldo + col0 + 16 * ni + 4 * q) = acc[mi][ni];
            }
        }
    }
};
template <int NM> struct EpiProjW {
    bf16_t* o; int row0, col0;
    DEV void operator()(const f32x4 (&acc)[NM][8], int r0, int rowlim, int c, int q) const {
#pragma unroll
        for (int mi = 0; mi < NM; ++mi) {
            if (r0 + 16 * mi < rowlim) {
#pragma unroll
                for (int pr = 0; pr < 4; ++pr) {
                    const f32x4 v0 = acc[mi][2 * pr], v1 = acc[mi][2 * pr + 1]; u32x4 u;
                    u.x = cvt_pk_bf16(v0[0], v0[1]); u.y = cvt_pk_bf16(v0[2], v0[3]); u.z = cvt_pk_bf16(v1[0], v1[1]); u.w = cvt_pk_bf16(v1[2], v1[3]);
                    *(u32x4*)(o + (size_t)(row0 + r0 + 16 * mi + c) * LD + col0 + 32 * pr + 8 * q) = u;
                }
            }
        }
    }
};
template <int NM> struct EpiBf16W {
    bf16_t* o; int ldo, row0, col0;
    DEV void operator()(const f32x4 (&acc)[NM][8], int r0, int rowlim, int c, int q) const {
#pragma unroll
        for (int mi = 0; mi < NM; ++mi) {
            if (r0 + 16 * mi < rowlim) {
#pragma unroll
                for (int pr = 0; pr < 4; ++pr) {
                    const f32x4 v0 = acc[mi][2 * pr], v1 = acc[mi][2 * pr + 1]; u32x4 u;
                    u.x = cvt_pk_bf16(v0[0], v0[1]); u.y = cvt_pk_bf16(v0[2], v0[3]); u.z = cvt_pk_bf16(v1[0], v1[1]); u.w = cvt_pk_bf16(v1[2], v1[3]);
                    *(u32x4*)(o + (size_t)(row0 + r0 + 16 * mi + c) * ldo + col0 + 32 * pr + 8 * q) = u;
                }
            }
        }
    }
};
template <int NM> struct EpiVTW {
    bf16_t* vt; int row0, vbase, bstride;
    DEV void operator()(const f32x4 (&acc)[NM][8], int r0, int rowlim, int c, int q) const {
#pragma unroll
        for (int mi = 0; mi < NM; ++mi) {
            if (r0 + 16 * mi < rowlim) {
                const int rg = row0 + r0 + 16 * mi + 4 * q, bb = rg >> 13, tt = rg & (SEQ - 1);
#pragma unroll
                for (int ni = 0; ni < 8; ++ni) {
                    const f32x4 v = acc[mi][ni]; u32x2 u; u.x = cvt_pk_bf16(v[0], v[1]); u.y = cvt_pk_bf16(v[2], v[3]);
                    *(u32x2*)(vt + (size_t)(vbase + bb * bstride + pcol(16 * ni + c)) * SEQ + tt) = u;
                }
            }
        }
    }
};
struct BLoadGUW {
    const float* w; int nt;
    DEV f32x4 ld(int k, int n) const { return *(const f32x4*)(w + (size_t)k * 512 + (n >> 6) * 256 + 64 * nt + (n & 63)); }
};
template <int NM> struct EpiSwigluW {
    bf16_t* H; const int* rslot; const float* rwt; int nt;
    DEV void operator()(const f32x4 (&acc)[NM][8], int r0, int rowlim, int c, int q) const {
#pragma unroll
        for (int mi = 0; mi < NM; ++mi) {
            if (r0 + 16 * mi < rowlim) {
                const int rr = r0 + 16 * mi + c; const int slot = rslot[rr];
                if (slot >= 0) {
                    const float wt = rwt[rr];
#pragma unroll
                    for (int nh = 0; nh < 4; ++nh) {
                        const f32x4 a = acc[mi][nh], g = acc[mi][nh + 4]; float hv[4];
#pragma unroll
                        for (int i = 0; i < 4; ++i) hv[i] = a[i] / (1.0f + __expf(-a[i])) * g[i] * wt;
                        u32x2 u; u.x = cvt_pk_bf16(hv[0], hv[1]); u.y = cvt_pk_bf16(hv[2], hv[3]);
                        *(u32x2*)(H + (size_t)slot * 256 + 64 * nt + 16 * nh + 4 * q) = u;
                    }
                }
            }
        }
    }
};

DEV int entry_cnt(const unsigned* cnt, int e) { if (e >= 256) return 2048; const unsigned n = cnt[e]; return n > (unsigned)CAP ? CAP : (int)n; }

template <int STAGE>
DEV void moe_phase(const Params& p, char* lds, unsigned xcc, int rep) {
    char* lm = lds + L_MAIN;
    int* pre = (int*)(lm + G_PRE);
    int* rowoff = (int*)(lm + G_ROWOFF);
    int* rslot = (int*)(lm + G_RSLOT);
    float* rwt = (float*)(lm + G_RWT);
    int* bc = (int*)(lds + L_CTRL + 16);
    const unsigned* cnt = p.ctrl + CT_CNT;
    const int tid = ltid();
    constexpr int NT = (STAGE == 1) ? 4 : 8;
    int* cntl = (int*)(lm + G_PRE + 1088);
    if (tid == 0) bc[2] = 0;
    __syncthreads();
    if (tid < 264) cntl[tid] = entry_cnt(cnt, tid);
    __syncthreads();
    if (tid < 8) {
        int s = 0;
        for (int k = 0; k < 33; ++k) { pre[tid * 34 + k] = s; const int n = cntl[tid + 8 * ((k + 32) % 33)]; s += ((n + 383) / 384) * NT; }
        pre[tid * 34 + 33] = s;
    }
    __syncthreads();
    int skipmask = 0;
    for (int xo = 0; xo < 8; ++xo) {
        const int x = (int)((xcc + xo) & 7u);
        unsigned* qc = p.ctrl + CT_Q + 64 * ((STAGE == 1 ? 16 : 32) + 8 * rep + x);
        const int total = pre[x * 34 + 33];
        if (xo == 1) {
            __syncthreads();
            if (tid < 8) { const unsigned cv = xb_ld(p.ctrl + CT_Q + 64 * ((STAGE == 1 ? 16 : 32) + 8 * rep + tid)); if ((int)cv >= pre[tid * 34 + 33]) atomicOr((unsigned*)&bc[2], 1u << tid); }
            __syncthreads();
            skipmask = bc[2];
        }
        if (xo >= 1 && ((skipmask >> x) & 1)) continue;
        for (;;) {
            __syncthreads();
            if (tid == 0) bc[0] = (int)atomicAdd(qc, 1u);
            __syncthreads();
            const int u = bc[0];
            if (u >= total) break;
            const int pe_ = ((tid & 63) < 33) ? pre[x * 34 + (tid & 63) + 1] : 0x7fffffff;
            const int k = (int)__builtin_popcountll(__ballot(pe_ <= u));
            const int e = x + 8 * ((k + 32) % 33), local = u - pre[x * 34 + k];
            const int n_e = cntl[e];
            const int ngrp = (n_e + 383) / 384;
            const int nt = local / ngrp, mg = local % ngrp;
            int rows = n_e - mg * 384; if (rows > 384) rows = 384;
            const int nsub = (rows + 127) >> 7;
            {
                const int idx = mg * 384 + tid; int slot = -1; float wt = 0.f;
                if (tid < rows) {
                    if (e < 256) { const uint2 en = p.bucket[(size_t)e * CAP + idx]; slot = (int)en.x; wt = __uint_as_float(en.y); if ((unsigned)slot >= (unsigned)(T_TOK * 9)) slot = -1; }
                    else { slot = ((e - 256) * 2048 + idx) * 9 + 8; wt = 1.0f; }
                }
                rslot[tid] = slot; rwt[tid] = wt;
                rowoff[tid] = slot < 0 ? 0 : (STAGE == 1 ? (slot / 9) * 1024 : slot * 256);
            }
            __syncthreads();
            {
                ASrcPlain as; as.base = p.hhi;
                BLoadGU bl; bl.w = e < 256 ? p.w_gate_up + (size_t)e * 1024 * 512 : p.ws_gate_up; bl.nt = nt;
                EpiSwiglu<6> ep; ep.H = p.H; ep.rslot = rslot; ep.rwt = rwt; ep.nt = nt;
                gemm_big<3, true, 1, ASrcPlain, BLoadGU, EpiSwiglu<6>, 2>(lm, 16, nsub, as, bl, ep, (PROBE_PH == 9 && rep == 0) ? PROBE_VAR : 0);
            }
        }
    }
}

constexpr int DN_BS = 131072, DN_RSLOT = DN_BS + 18432, DN_PRE = DN_RSLOT + 1024;
DEV void moe_down_phase(const Params& p, char* lds, unsigned xcc, int rep) {
    char* lm = lds + L_MAIN;
    char* Bs = lm + DN_BS;
    int* rslot = (int*)(lm + DN_RSLOT);
    int* pre = (int*)(lm + DN_PRE);
    int* bc = (int*)(lds + L_CTRL + 16);
    const unsigned* cnt = p.ctrl + CT_CNT;
    const int tid = ltid(), lane = tid & 63, w = tid >> 6, wm = w >> 1, wn = w & 1, c = lane & 15, q = lane >> 4;
    const int bn4 = 8 * (w & 3) + (lane & 7), bkq = 8 * (w >> 2) + (lane >> 3);
    const int gc0 = 4 * bn4, prow0 = (gc0 & 64) + 16 * ((gc0 >> 2) & 3) + 4 * ((gc0 >> 4) & 3);
    int* cntl = (int*)(lm + DN_PRE + 1088);
    if (tid == 0) bc[2] = 0;
    __syncthreads();
    if (tid < 264) cntl[tid] = entry_cnt(cnt, tid);
    __syncthreads();
    if (tid < 8) {
        int sacc = 0;
        for (int k = 0; k < 33; ++k) { pre[tid * 34 + k] = sacc; const int n = cntl[tid + 8 * ((k + 32) % 33)]; sacc += (n + 255) >> 8; }
        pre[tid * 34 + 33] = sacc;
    }
    __syncthreads();
    int skipmask = 0;
    for (int xo = 0; xo < 8; ++xo) {
        const int x = (int)((xcc + xo) & 7u);
        unsigned* qc = p.ctrl + CT_Q + 64 * (32 + 8 * rep + x);
        const int total = pre[x * 34 + 33];
        if (xo == 1) {
            __syncthreads();
            if (tid < 8) { const unsigned cv = xb_ld(p.ctrl + CT_Q + 64 * (32 + 8 * rep + tid)); if ((int)cv >= pre[tid * 34 + 33]) atomicOr((unsigned*)&bc[2], 1u << tid); }
            __syncthreads();
            skipmask = bc[2];
        }
        if (xo >= 1 && ((skipmask >> x) & 1)) continue;
        for (;;) {
            __syncthreads();
            if (tid == 0) bc[0] = (int)atomicAdd(qc, 1u);
            __syncthreads();
            const int u = bc[0];
            if (u >= total) break;
            const int pe_ = ((tid & 63) < 33) ? pre[x * 34 + (tid & 63) + 1] : 0x7fffffff;
            const int k = (int)__builtin_popcountll(__ballot(pe_ <= u));
            const int e = x + 8 * ((k + 32) % 33), mg = u - pre[x * 34 + k];
            const int n_e = cntl[e];
            int rows = n_e - mg * 256; if (rows > 256) rows = 256;
            const int nsub = (rows + 127) >> 7;
            const float* wd = (e < 256 ? p.w_down + (size_t)e * 256 * 1024 : p.ws_down);
            f32x4 rb[2][4];
#pragma unroll
            for (int s2 = 0; s2 < 2; ++s2)
#pragma unroll
                for (int i = 0; i < 4; ++i) rb[s2][i] = *(const f32x4*)(wd + (size_t)(s2 * 64 + 4 * bkq + i) * 1024 + 4 * bn4);
            if (tid < 256) {
                const int idx = mg * 256 + tid; int slot = -1;
                if (tid < rows) {
                    if (e < 256) { slot = (int)p.bucket[(size_t)e * CAP + idx].x; if ((unsigned)slot >= (unsigned)(T_TOK * 9)) slot = -1; }
                    else slot = ((e - 256) * 2048 + idx) * 9 + 8;
                }
                rslot[tid] = slot;
            }
            __syncthreads();
            {
                u32x4 v[16];
#pragma unroll
                for (int i = 0; i < 16; ++i) {
                    const int id = tid + 512 * i, row = id >> 5, kc = id & 31;
                    const int slot = rslot[row];
                    v[i] = *(const u32x4*)(p.H + (size_t)(slot < 0 ? 0 : slot) * 256 + kc * 8);
                }
#pragma unroll
                for (int i = 0; i < 16; ++i) {
                    const int id = tid + 512 * i, row = id >> 5, kc = id & 31;
                    const int tile = (row >> 7) * 4 + (kc >> 3), rr = row & 127;
                    *(u32x4*)(lm + tile * 16384 + swz(rr, kc & 7)) = v[i];
                }
            }
            f32x4 acc[4][4];
#pragma unroll 1
            for (int nt = 0; nt < 8; ++nt) {
#pragma unroll
                for (int mi = 0; mi < 4; ++mi)
#pragma unroll
                    for (int ni = 0; ni < 4; ++ni) acc[mi][ni] = (f32x4){0.f, 0.f, 0.f, 0.f};
#pragma unroll 1
                for (int ksp = 0; ksp < 2; ++ksp) {
#pragma unroll
                    for (int k2 = 0; k2 < 2; ++k2) {
                        const int ks = 2 * ksp + k2;
                        __syncthreads();
#pragma unroll
                        for (int cc = 0; cc < 4; ++cc) {
                            u32x2 v; v.x = cvt_pk_bf16(rb[k2][0][cc], rb[k2][1][cc]); v.y = cvt_pk_bf16(rb[k2][2][cc], rb[k2][3][cc]);
                            *(u32x2*)(Bs + swz(prow0 + cc, bkq >> 1) + (bkq & 1) * 8) = v;
                        }
                        __syncthreads();
                        {
                            const int st2 = nt * 4 + ks + 2;
                            if (st2 < 32) {
                                const int nt2 = st2 >> 2, ks2 = st2 & 3;
#pragma unroll
                                for (int i = 0; i < 4; ++i) rb[k2][i] = *(const f32x4*)(wd + (size_t)(ks2 * 64 + 4 * bkq + i) * 1024 + 128 * nt2 + 4 * bn4);
                            }
                        }
                        if (64 * wm < rows) {
                            const char* As = lm + ((64 * wm) >> 7) * 4 * 16384 + ks * 16384;
                            const int rb0 = (64 * wm) & 127;
                            bf16x8 bq[2][4]; bf16x8 af[8];
#pragma unroll
                            for (int ni = 0; ni < 4; ++ni) bq[0][ni] = *(const bf16x8*)(Bs + swz(64 * wn + 16 * ni + c, q));
                            af[0] = *(const bf16x8*)(As + swz(rb0 + c, q));
                            af[1] = *(const bf16x8*)(As + swz(rb0 + 16 + c, q));
                            __builtin_amdgcn_sched_barrier(0);
#pragma unroll
                            for (int g = 0; g < 8; ++g) {
                                const int kk = g >> 2, mi = g & 3;
                                if (g + 2 < 8) { const int kk2 = (g + 2) >> 2, mi2 = (g + 2) & 3; af[g + 2] = *(const bf16x8*)(As + swz(rb0 + 16 * mi2 + c, 4 * kk2 + q)); }
                                if (kk == 0 && mi < 2) { bq[1][2 * mi] = *(const bf16x8*)(Bs + swz(64 * wn + 16 * (2 * mi) + c, 4 + q)); bq[1][2 * mi + 1] = *(const bf16x8*)(Bs + swz(64 * wn + 16 * (2 * mi + 1) + c, 4 + q)); }
#pragma unroll
                                for (int ni = 0; ni < 4; ++ni) acc[mi][ni] = __builtin_amdgcn_mfma_f32_16x16x32_bf16(bq[kk][ni], af[g], acc[mi][ni], 0, 0, 0);
                                __builtin_amdgcn_sched_barrier(0);
                            }
                        }
                    }
                }
#pragma unroll
                for (int mi = 0; mi < 4; ++mi) {
                    const int slot = rslot[64 * wm + 16 * mi + c];
                    if (slot >= 0) {
                        u32x4 uu;
                        uu.x = pack_fp8x4(acc[mi][0][0] * YS_SCALE, acc[mi][0][1] * YS_SCALE, acc[mi][0][2] * YS_SCALE, acc[mi][0][3] * YS_SCALE);
                        uu.y = pack_fp8x4(acc[mi][1][0] * YS_SCALE, acc[mi][1][1] * YS_SCALE, acc[mi][1][2] * YS_SCALE, acc[mi][1][3] * YS_SCALE);
                        uu.z = pack_fp8x4(acc[mi][2][0] * YS_SCALE, acc[mi][2][1] * YS_SCALE, acc[mi][2][2] * YS_SCALE, acc[mi][2][3] * YS_SCALE);
                        uu.w = pack_fp8x4(acc[mi][3][0] * YS_SCALE, acc[mi][3][1] * YS_SCALE, acc[mi][3][2] * YS_SCALE, acc[mi][3][3] * YS_SCALE);
                        *(u32x4*)(p.yslot + (size_t)slot * 1024 + 128 * nt + 64 * wn + 16 * q) = uu;
                    }
                }
            }
        }
    }
}

template <int MODE>
DEV void wt_tile(const float* src, int ldn, bf16_t* dstbase, int ntile, int ktile, float* tl, int tid) {
    __syncthreads();
#pragma unroll
    for (int j = 0; j < 2; ++j) {
        const int idx = tid + 512 * j, kk = idx >> 4, n4 = idx & 15;
        const int cp = ntile * 64 + n4 * 4; int cg = cp;
        if (MODE == 1) {
            if (cp < 896) cg = cp; else if (cp < 1024) cg = cp + 128; else if (cp < 2048) cg = cp + 280; else if (cp < 2072) cg = cp - 2048 + 1280; else if (cp < 2304) cg = -1;
            else if (cp < 2432) cg = cp - 2304 + 896; else if (cp < 2560) cg = cp - 2432 + 1152; else cg = cp - 2560 + 2328; }
        f32x4 v = (f32x4){0.f, 0.f, 0.f, 0.f};
        if (cg >= 0) v = *(const f32x4*)(src + (size_t)(ktile * 64 + kk) * ldn + cg);
        if (MODE == 1 && (cp < 512 || (cp >= 1024 && cp < 1536))) v = v * (0.125f * LOG2E);
        tl[kk * 65 + n4 * 4 + 0] = v[0]; tl[kk * 65 + n4 * 4 + 1] = v[1]; tl[kk * 65 + n4 * 4 + 2] = v[2]; tl[kk * 65 + n4 * 4 + 3] = v[3];
    }
    __syncthreads();
    const int n = tid >> 3, kc = tid & 7;
    float f[8];
#pragma unroll
    for (int e = 0; e < 8; ++e) f[e] = tl[(kc * 8 + e) * 65 + n];
    u32x4 o; o.x = cvt_pk_bf16(f[0], f[1]); o.y = cvt_pk_bf16(f[2], f[3]); o.z = cvt_pk_bf16(f[4], f[5]); o.w = cvt_pk_bf16(f[6], f[7]);
    bf16_t* dst = dstbase + (size_t)(ntile * 64 + n) * 1024 + ktile * 64 + kc * 8;
    *(u32x4*)dst = o;
    if (MODE == 2) {
#pragma unroll
        for (int e = 0; e < 8; ++e) f[e] = f[e] - bf2f(f2bf(f[e]));
        o.x = cvt_pk_bf16(f[0], f[1]); o.y = cvt_pk_bf16(f[2], f[3]); o.z = cvt_pk_bf16(f[4], f[5]); o.w = cvt_pk_bf16(f[6], f[7]);
        *(u32x4*)(dst + (size_t)256 * 1024) = o;
    }
}


namespace pg8 {
#define PG8_LAS __attribute__((address_space(3)))
constexpr int BM = 256, BK = 64, HALF = 128, HTB = HALF * BK * 2  , STAGE_BYTES = 8 * HTB, NXCD = 8, WGM = 8;
DEV int lds_byte(int r, int c) { const int st = (r >> 4) * 2 + (c >> 5), rr = r & 15, cc = c & 31, ob = rr * 64 + cc * 2; return st * 1024 + (ob ^ (((ob >> 9) & 1) << 5)); }
DEV void stage_rc(int b, int& R, int& C) { const int st = b / 1024, sb = b % 1024, swz = sb ^ (((sb >> 9) & 1) << 5); R = (st >> 1) * 16 + swz / 64; C = (st & 1) * 32 + (swz % 64) / 2; }
DEV int perm32(int rho) { const int n = rho >> 4, i = rho & 15; return 8 * (i >> 2) + 4 * n + (i & 3); }
struct Unit { int pm, pn; };
struct Gemm { const bf16_t* A; const bf16_t* Bt; int M, N, K; };
struct StaticOrder {
    int nM, nN, nwg, G, c;
    DEV void init(int M, int N, int G_, int c_) { nM = M / BM; nN = N / BM; nwg = nM * nN; G = G_; c = c_; }
    DEV bool next(int i, Unit& u) const {
        const long L = (long)i * G + c; if (L >= nwg) return false;
        int wgid = (int)L; { const int q = nwg / NXCD, r = nwg % NXCD, xcd = wgid % NXCD, off = wgid / NXCD; wgid = (xcd < r ? xcd * (q + 1) : r * (q + 1) + (xcd - r) * q) + off; }
        const int nig = WGM * nN, gid = wgid / nig, fm = gid * WGM, gsz = (nM - fm) < WGM ? (nM - fm) : WGM;
        u.pm = fm + ((wgid % nig) % gsz); u.pn = (wgid % nig) / gsz; return true;
    }
};
struct EpiBf16 {
    bf16_t* O; int ldc; int split_cols; size_t split_stride;
    DEV void operator()(const f32x4 (&acc)[2][2][4][2], const Unit& u, int wr, int wc, int fr, int fq) const {
        const int row0 = u.pm * BM + wr * 64 + fr; int colt = u.pn * BM; bf16_t* base = O;
        if (split_cols) { const int t = colt / split_cols; base += (size_t)t * split_stride; colt -= t * split_cols; }
        const int col0 = colt + wc * 32 + 8 * fq;
#pragma unroll
        for (int ai = 0; ai < 2; ++ai)
#pragma unroll
            for (int m = 0; m < 4; ++m) { bf16_t* rowp = base + (size_t)(row0 + ai * HALF + m * 16) * ldc + col0;
#pragma unroll
                for (int bj = 0; bj < 2; ++bj) { const f32x4 v0 = acc[ai][bj][m][0], v1 = acc[ai][bj][m][1];
                    u32x4 w; w.x = cvt_pk_bf16(v0[0], v0[1]); w.y = cvt_pk_bf16(v0[2], v0[3]); w.z = cvt_pk_bf16(v1[0], v1[1]); w.w = cvt_pk_bf16(v1[2], v1[3]);
                    *(u32x4*)(rowp + bj * HALF) = w; } }
    }
};

struct EpiNormFfn {
    const float* x; float* out; bf16_t* hhi; bf16_t* hlo; const float* norm_g; const float* mod; float* nslot; unsigned* cnt;
    DEV void rowstat(const f32x4 (&v)[2][2][4][2], const Unit& u, int k, int wr, int wc, int fr, int fq, PG8_LAS unsigned char* lds, int wid, int lane) const {
        PG8_LAS float* P = (PG8_LAS float*)lds;
        PG8_LAS float* S = (PG8_LAS float*)(lds + 4096);
#pragma unroll
        for (int ai = 0; ai < 2; ++ai)
#pragma unroll
            for (int m = 0; m < 4; ++m) {
                float s = 0.f;
#pragma unroll
                for (int bj = 0; bj < 2; ++bj)
#pragma unroll
                    for (int n = 0; n < 2; ++n) { const f32x4 t = v[ai][bj][m][n]; s += (t[0] * t[0] + t[1] * t[1]) + (t[2] * t[2] + t[3] * t[3]); }
                s = xsum16(s); s += xget32(s, lane >> 5);
                if (fq == 0) P[(ai * HALF + wr * 64 + m * 16 + fr) * 4 + wc] = s;
            }
        asm volatile("s_waitcnt lgkmcnt(0)" ::: "memory"); __builtin_amdgcn_s_barrier(); asm volatile("" ::: "memory");
        const int row = wid * 32 + (lane & 31);
        float* slots = nslot + ((size_t)k * T_TOK + (size_t)u.pm * BM) * 4;
        unsigned* c = cnt + 16 * (2 * u.pm + k);
        if (lane < 32) {
            const float tot = (P[row * 4 + 0] + P[row * 4 + 1]) + (P[row * 4 + 2] + P[row * 4 + 3]);
            __hip_atomic_store(slots + row * 4 + u.pn, tot, __ATOMIC_RELAXED, __HIP_MEMORY_SCOPE_AGENT);
        }
        asm volatile("s_waitcnt vmcnt(0)" ::: "memory");
        if (lane == 0) __hip_atomic_fetch_add(c, 1u, __ATOMIC_RELAXED, __HIP_MEMORY_SCOPE_AGENT);
        if (wid == 0) {
            unsigned sp = 0;
            while ((unsigned)__builtin_amdgcn_readfirstlane(__hip_atomic_load(c, __ATOMIC_RELAXED, __HIP_MEMORY_SCOPE_AGENT)) < 32u) { __builtin_amdgcn_s_sleep(2); if (++sp > (1u << 22)) break; }
            __builtin_amdgcn_fence(__ATOMIC_ACQUIRE, "agent");
        }
        asm volatile("s_waitcnt vmcnt(0) lgkmcnt(0)" ::: "memory"); __builtin_amdgcn_s_barrier(); asm volatile("" ::: "memory");
        if (lane < 32) {
            float ss = 0.f;
#pragma unroll
            for (int t = 0; t < 4; ++t) ss += __hip_atomic_load(slots + row * 4 + t, __ATOMIC_RELAXED, __HIP_MEMORY_SCOPE_AGENT);
            S[row] = rsqrtf(ss * (1.0f / 1024.0f) + RMS_EPS);
        }
        asm volatile("s_waitcnt vmcnt(0) lgkmcnt(0)" ::: "memory"); __builtin_amdgcn_s_barrier(); asm volatile("" ::: "memory");
    }
    DEV void fused(f32x4 (&acc)[2][2][4][2], const Unit& u, int wr, int wc, int fr, int fq, PG8_LAS unsigned char* lds, int wid, int lane) const {
        const PG8_LAS float* S = (const PG8_LAS float*)(lds + 4096);
        const float* md = mod + ((u.pm * BM) >> 13) * 6144;
        const int col0 = u.pn * BM + wc * 32 + 8 * fq;
        f32x4 xs[4][2][2];
#define EN_XLOAD(ai_) do { _Pragma("unroll") for (int m = 0; m < 4; ++m) { const size_t off_ = (size_t)(u.pm * BM + (ai_) * HALF + wr * 64 + m * 16 + fr) * DM + col0; \
            _Pragma("unroll") for (int bj = 0; bj < 2; ++bj) _Pragma("unroll") for (int n = 0; n < 2; ++n) xs[m][bj][n] = *(const f32x4*)(x + off_ + bj * HALF + 4 * n); } } while (0)
        EN_XLOAD(0);
        rowstat(acc, u, 0, wr, wc, fr, fq, lds, wid, lane);
        {
            f32x4 gy[2][2], g1[2][2];
#pragma unroll
            for (int bj = 0; bj < 2; ++bj)
#pragma unroll
                for (int n = 0; n < 2; ++n) { gy[bj][n] = *(const f32x4*)(norm_g + 1024 + col0 + bj * HALF + 4 * n); g1[bj][n] = *(const f32x4*)(md + 2048 + col0 + bj * HALF + 4 * n); }
#pragma unroll
            for (int ai = 0; ai < 2; ++ai) {
                if (ai == 1) EN_XLOAD(1);
#pragma unroll
                for (int m = 0; m < 4; ++m) {
                    const int r = ai * HALF + wr * 64 + m * 16 + fr; const float rs = S[r]; const size_t off = (size_t)(u.pm * BM + r) * DM + col0;
#pragma unroll
                    for (int bj = 0; bj < 2; ++bj)
#pragma unroll
                        for (int n = 0; n < 2; ++n) {
                            const f32x4 xv = xs[m][bj][n]; f32x4 o;
#pragma unroll
                            for (int e = 0; e < 4; ++e) o[e] = xv[e] + g1[bj][n][e] * (acc[ai][bj][m][n][e] * rs * gy[bj][n][e]);
                            acc[ai][bj][m][n] = o; *(f32x4*)(out + off + bj * HALF + 4 * n) = o;
                        }
                    asm volatile("" : "+v"(acc[ai][0][m][0]), "+v"(acc[ai][0][m][1]), "+v"(acc[ai][1][m][0]), "+v"(acc[ai][1][m][1]));
                }
            }
        }
#undef EN_XLOAD
        rowstat(acc, u, 1, wr, wc, fr, fq, lds, wid, lane);
        {
            f32x4 g2[2][2], s2[2][2], h2[2][2];
#pragma unroll
            for (int bj = 0; bj < 2; ++bj)
#pragma unroll
                for (int n = 0; n < 2; ++n) { g2[bj][n] = *(const f32x4*)(norm_g + 2048 + col0 + bj * HALF + 4 * n); s2[bj][n] = *(const f32x4*)(md + 4096 + col0 + bj * HALF + 4 * n); h2[bj][n] = *(const f32x4*)(md + 3072 + col0 + bj * HALF + 4 * n); }
#pragma unroll
            for (int ai = 0; ai < 2; ++ai)
#pragma unroll
                for (int m = 0; m < 4; ++m) {
                    const int r = ai * HALF + wr * 64 + m * 16 + fr; const float rs2 = S[r]; const size_t off = (size_t)(u.pm * BM + r) * DM + col0;
#pragma unroll
                    for (int bj = 0; bj < 2; ++bj) {
                        float hv[8], lo[8];
#pragma unroll
                        for (int n = 0; n < 2; ++n)
#pragma unroll
                            for (int e = 0; e < 4; ++e) { const float h = acc[ai][bj][m][n][e] * rs2 * g2[bj][n][e] * (1.0f + s2[bj][n][e]) + h2[bj][n][e]; hv[4 * n + e] = h; lo[4 * n + e] = h - bf2f(f2bf(h)); }
                        u32x4 uh, ul;
                        uh.x = cvt_pk_bf16(hv[0], hv[1]); uh.y = cvt_pk_bf16(hv[2], hv[3]); uh.z = cvt_pk_bf16(hv[4], hv[5]); uh.w = cvt_pk_bf16(hv[6], hv[7]);
                        ul.x = cvt_pk_bf16(lo[0], lo[1]); ul.y = cvt_pk_bf16(lo[2], lo[3]); ul.z = cvt_pk_bf16(lo[4], lo[5]); ul.w = cvt_pk_bf16(lo[6], lo[7]);
                        *(u32x4*)(hhi + off + bj * HALF) = uh; *(u32x4*)(hlo + off + bj * HALF) = ul;
                    }
                }
        }
    }
};
template <bool KEYPERM, class Epi, class Sched, bool AFTER = false>
DEV void gemm_phase(PG8_LAS unsigned char* lds, const Gemm g, const Sched& S, const Epi& E) {
    const int tid = ltid(), wid = __builtin_amdgcn_readfirstlane(tid >> 6), lane = tid & 63, wr = wid >> 2, wc = wid & 3, fr = lane & 15, fq = lane >> 4;
    const int K = g.K, nt = K / BK;
    unsigned voffA[2], voffB[2];
#pragma unroll
    for (int i = 0; i < 2; ++i) { int R, C; stage_rc(tid * 16 + i * 8192, R, C); int pc = perm32(R & 31);
        if (KEYPERM) pc = (pc & 19) | ((pc & 4) << 1) | ((pc & 8) >> 1);
        const int Rb = (R & ~31) + pc;
        voffA[i] = (unsigned)(R * K + C) * 2u; voffB[i] = (unsigned)(Rb * K + C) * 2u; }
    const size_t kstep = (size_t)(BK * 2);
    const size_t hstep = (size_t)HALF * K * 2;
    const size_t tstep = 2 * hstep;
    const unsigned ldsw = (unsigned)wid * 1024u;
    const int aoff = lds_byte(wr * 64 + fr, fq * 8), boff = lds_byte(wc * 32 + fr, fq * 8);
#define PG8_SA(b, h) (((b) * 2 + (h)) * HTB)
#define PG8_SB(b, h) ((4 + (b) * 2 + (h)) * HTB)
#define PG8_STAGE(bufoff, gbase, voff) do { _Pragma("unroll") for (int _i = 0; _i < 2; ++_i) \
        __builtin_amdgcn_global_load_lds((const unsigned*)((const char*)(gbase) + (voff)[_i]), (PG8_LAS unsigned*)(lds + (bufoff) + ldsw + _i * 8192), 16, 0, 0); } while (0)
#define PG8_LDA(dst, b, h) do { _Pragma("unroll") for (int m = 0; m < 4; ++m) _Pragma("unroll") for (int k = 0; k < 2; ++k) dst[m][k] = *(const PG8_LAS bf16x8*)(lds + PG8_SA(b, h) + aoff + m * 2048 + k * 1024); } while (0)
#define PG8_LDB(dst, b, h) do { _Pragma("unroll") for (int n = 0; n < 2; ++n) _Pragma("unroll") for (int k = 0; k < 2; ++k) dst[n][k] = *(const PG8_LAS bf16x8*)(lds + PG8_SB(b, h) + boff + n * 2048 + k * 1024); } while (0)
#define PG8_MMA(ai, bj, At, Bt) do { __builtin_amdgcn_s_setprio(1); _Pragma("unroll") for (int m = 0; m < 4; ++m) _Pragma("unroll") for (int n = 0; n < 2; ++n) _Pragma("unroll") for (int k = 0; k < 2; ++k) \
        acc[ai][bj][m][n] = __builtin_amdgcn_mfma_f32_16x16x32_bf16(Bt[n][k], At[m][k], acc[ai][bj][m][n], 0, 0, 0); __builtin_amdgcn_s_setprio(0); } while (0)
#define PG8_WAIT_V(n) asm volatile("s_waitcnt vmcnt(" #n ")" ::: "memory")
#define PG8_WAIT_L(n) asm volatile("s_waitcnt lgkmcnt(" #n ")" ::: "memory")
#define PG8_BAR __builtin_amdgcn_s_barrier()
#define PG8_SCHED __builtin_amdgcn_sched_barrier(0)
    Unit cur, nxt; int ui = 0;
    if (!S.next(0, cur)) return;
    f32x4 acc[2][2][4][2];
#pragma unroll
    for (int a = 0; a < 2; ++a)
#pragma unroll
        for (int b = 0; b < 2; ++b)
#pragma unroll
            for (int m = 0; m < 4; ++m)
#pragma unroll
                for (int n = 0; n < 2; ++n) acc[a][b][m][n] = (f32x4){0.f, 0.f, 0.f, 0.f};
    bf16x8 At[4][2], B0[2][2], B1[2][2];
    const char* cA = (const char*)g.A + (size_t)cur.pm * tstep; const char* cB = (const char*)g.Bt + (size_t)cur.pn * tstep;
    PG8_STAGE(PG8_SB(0, 0), cB, voffB); PG8_STAGE(PG8_SA(0, 0), cA, voffA); PG8_STAGE(PG8_SB(0, 1), cB + hstep, voffB); PG8_STAGE(PG8_SA(0, 1), cA + hstep, voffA);
    if (wr == 1) PG8_BAR;
    PG8_WAIT_V(4); PG8_BAR;
    PG8_STAGE(PG8_SB(1, 0), cB + kstep, voffB); PG8_STAGE(PG8_SA(1, 0), cA + kstep, voffA); PG8_STAGE(PG8_SB(1, 1), cB + hstep + kstep, voffB);
    PG8_WAIT_V(6); PG8_BAR;
    for (;;) {
        const bool has_next = S.next(ui + 1, nxt);
        const char* nA = has_next ? (const char*)g.A + (size_t)nxt.pm * tstep : cA; const char* nB = has_next ? (const char*)g.Bt + (size_t)nxt.pn * tstep : cB;
        for (int t = 0; t < nt; t += 2) {
            const bool last = (t == nt - 2);
            const char* a1 = cA + (size_t)(t + 1) * kstep;
            const char* a2 = last ? nA : cA + (size_t)(t + 2) * kstep; const char* b2 = last ? nB : cB + (size_t)(t + 2) * kstep;
            const char* a3 = a2 + kstep; const char* b3 = b2 + kstep;
            PG8_LDB(B0, 0, 0); PG8_SCHED; PG8_LDA(At, 0, 0); PG8_STAGE(PG8_SA(1, 1), a1 + hstep, voffA);
            PG8_WAIT_L(8); PG8_BAR; PG8_WAIT_L(0); PG8_MMA(0, 0, At, B0); PG8_BAR; PG8_SCHED;
            PG8_LDB(B1, 0, 1); PG8_STAGE(PG8_SB(0, 0), b2, voffB);
            PG8_BAR; PG8_WAIT_L(0); PG8_MMA(0, 1, At, B1); PG8_BAR;
            PG8_LDA(At, 0, 1); PG8_STAGE(PG8_SA(0, 0), a2, voffA);
            PG8_BAR; PG8_WAIT_L(0); PG8_MMA(1, 0, At, B0); PG8_BAR; PG8_SCHED;
            PG8_STAGE(PG8_SB(0, 1), b2 + hstep, voffB);
            PG8_WAIT_V(6); PG8_BAR; PG8_MMA(1, 1, At, B1); PG8_BAR;
            PG8_LDB(B0, 1, 0); PG8_SCHED; PG8_LDA(At, 1, 0); PG8_STAGE(PG8_SA(0, 1), a2 + hstep, voffA);
            PG8_WAIT_L(8); PG8_BAR; PG8_WAIT_L(0); PG8_MMA(0, 0, At, B0); PG8_BAR; PG8_SCHED;
            PG8_LDB(B1, 1, 1); PG8_STAGE(PG8_SB(1, 0), b3, voffB);
            PG8_BAR; PG8_WAIT_L(0); PG8_MMA(0, 1, At, B1); PG8_BAR;
            PG8_LDA(At, 1, 1); PG8_STAGE(PG8_SA(1, 0), a3, voffA);
            PG8_BAR; PG8_WAIT_L(0); PG8_MMA(1, 0, At, B0); PG8_BAR; PG8_SCHED;
            PG8_STAGE(PG8_SB(1, 1), b3 + hstep, voffB);
            PG8_WAIT_V(6); PG8_BAR; PG8_MMA(1, 1, At, B1); PG8_BAR;
        }
        if constexpr (!AFTER) E(acc, cur, wr, wc, fr, fq);
        if (!has_next) break;
#pragma unroll
        for (int a = 0; a < 2; ++a)
#pragma unroll
            for (int b = 0; b < 2; ++b)
#pragma unroll
                for (int m = 0; m < 4; ++m)
#pragma unroll
                    for (int n = 0; n < 2; ++n) acc[a][b][m][n] = (f32x4){0.f, 0.f, 0.f, 0.f};
        cur = nxt; cA = nA; cB = nB; ++ui;
    }
    PG8_WAIT_V(0);
    if (wr == 0) PG8_BAR;
    PG8_BAR;
    if constexpr (AFTER) E.fused(acc, cur, wr, wc, fr, fq, lds, wid, lane);
#undef PG8_SA
#undef PG8_SB
#undef PG8_STAGE
#undef PG8_LDA
#undef PG8_LDB
#undef PG8_MMA
#undef PG8_WAIT_V
#undef PG8_WAIT_L
#undef PG8_BAR
#undef PG8_SCHED
}
}

#ifndef STOP_AFTER
#define STOP_AFTER 99
#endif
DEV void dump_out(const Params& p, int k) {
    const size_t n = (size_t)T_TOK * DM;
    for (size_t i = (size_t)blockIdx.x * 512 + threadIdx.x; i < n; i += (size_t)gridDim.x * 512) {
        float v = 0.f;
        if (k == 1) v = bf2f(p.hmix[i]);
        else if (k == 0) v = i < 12288 ? p.mod[i] : i < 12288 + 192 ? p.misc[i - 12288] : 0.f;
        else if (k == 2) v = (i % LD < 2072) ? bf2f(p.proj[i]) : 0.f;
        else if (k == 3) v = i < 131072 ? bf2f(p.kc[i]) : i < 262144 ? bf2f(p.vcT[i - 131072]) : i < 262144 + 12582912 ? bf2f(p.vT[i - 262144]) : 0.f;
        else if (k == 4) v = bf2f(p.ocat[i]);
        else if (k == 5) v = bf2f(p.y[i]);
        else if (k == 6) v = bf2f(p.hhi[i]) + 64.f * bf2f(p.hlo[i]);
        else if (k == 7) v = i < (size_t)T_TOK * 256 ? p.logits[i] : 0.f;
        else if (k == 8) v = i < 256 ? (float)p.ctrl[CT_CNT + i] : 0.f;
        else if (k == 9) v = bf2f(p.H[i]) + bf2f(p.H[i + n]);
        else if (k == 10) v = (float)p.yslot[i] + (float)p.yslot[i + 4 * n] + (float)p.yslot[i + 8 * n];
        p.out[i] = v;
    }
}
#define STOP_AT(k) do { if (STOP_AFTER == (k)) { dump_out(p, (k)); return; } } while (0)
__global__ void __launch_bounds__(512, 2) fwd_kernel(Params p) {
    extern __shared__ __attribute__((aligned(16))) char lds[];
    const int tid = ltid(), lane = tid & 63, w = tid >> 6;
    const int nb = gridDim.x, bid = blockIdx.x;
    char* lm = lds + L_MAIN;
    if (tid < 16) ((unsigned*)lds)[tid] = 0u;
    __syncthreads();
    XcdBarrier bar = xcd_barrier_post(p.ctrl, (volatile LAS unsigned*)lds);
    const unsigned xcc = bar.x & 7u;
    if (AMP_PH >= 0 && blockIdx.x == 0 && threadIdx.x == 0) ((volatile unsigned long long*)(p.ctrl + 15360))[0] = wall_clock64();
    int* bc = (int*)(lds + L_CTRL + 16);

    f32x4 xr[8][4]; float xrs[8];
    {
        const int tid = ltid(), lane = tid & 63, w = tid >> 6;
#pragma unroll
        for (int rr = 0; rr < 8; ++rr) { const int rq = bid * 8 + w + rr * nb * 8; const int row = rq < T_TOK ? rq : 0;
#pragma unroll
            for (int j = 0; j < 4; ++j) xr[rr][j] = *(const f32x4*)(p.x + (size_t)row * DM + lane * 4 + 256 * j); }
    }
    {
    const int tid = ltid(), lane = tid & 63, w = tid >> 6; (void)lane; (void)w;
        float* sc = (float*)lm;
        float* red = (float*)(lm + 8192);
        { float cv[4];
#pragma unroll
          for (int j = 0; j < 4; ++j) cv[j] = p.c[tid + 512 * j];
#pragma unroll
          for (int j = 0; j < 4; ++j) sc[tid + 512 * j] = cv[j] / (1.0f + __expf(-cv[j])); }
        __syncthreads();
        for (int cb = bid; cb < 256; cb += nb) {
            float* red4 = (float*)(lm + 8192);
            if (tid < 480) {
                const int j6 = tid % 6, kr = tid / 6;
                f32x4 wv[13];
#pragma unroll
                for (int it = 0; it < 13; ++it) { const int k = kr + 80 * it; wv[it] = (k < 1024) ? *(const f32x4*)(p.w_ada + (size_t)k * 6144 + cb * 24 + 4 * j6) : (f32x4){0.f, 0.f, 0.f, 0.f}; }
                f32x4 a0 = (f32x4){0.f, 0.f, 0.f, 0.f}, a1 = a0;
#pragma unroll
                for (int it = 0; it < 13; ++it) { const int k = kr + 80 * it; const float s0 = (k < 1024) ? sc[k] : 0.f, s1 = (k < 1024) ? sc[1024 + k] : 0.f; a0 += wv[it] * s0; a1 += wv[it] * s1; }
                *(f32x4*)(red4 + (kr * 6 + j6) * 8) = a0; *(f32x4*)(red4 + (kr * 6 + j6) * 8 + 4) = a1;
            }
            __syncthreads();
            if (tid < 48) {
                const int j = tid >> 1, bb = tid & 1; float s = 0.f;
                for (int kr = 0; kr < 80; ++kr) s += red4[(kr * 6 + (j >> 2)) * 8 + 4 * bb + (j & 3)];
                const int col = cb * 24 + j;
                p.mod[bb * 6144 + col] = s + p.b_ada[col];
            }
            __syncthreads();
        }
        for (int cb = bid; cb < 256; cb += nb) {
            if (tid < 64) {
                const int kv = cb >> 7, chunk = cb & 127; float a = 0.f;
#pragma unroll
                for (int kk = 0; kk < 16; ++kk) { const int k = chunk * 16 + kk; a += p.pe_cmp[kv * 2048 + k] * p.w_cmp1[((size_t)kv * 2048 + k) * 64 + tid]; }
                p.misc[1024 + cb * 64 + tid] = a;
            }
        }
        if (bid == (2 % nb) && tid == 0) {
            float s01 = 0.f, s23 = 0.f;
            for (int i = 0; i < 64; ++i) { s01 += p.diff_lambda[i] * p.diff_lambda[64 + i]; s23 += p.diff_lambda[128 + i] * p.diff_lambda[192 + i]; }
            p.misc[0] = __expf(s01) - __expf(s23) + 0.2f;
        }
        if (bid == (3 % nb)) {
            for (int i = tid; i < 4 * 64; i += 512) { const int bg = i >> 6, d = i & 63; p.kc[((size_t)bg * 512 + 511) * 64 + d] = 0; p.vcT[((size_t)bg * 64 + d) * 512 + 511] = 0; }
        }
#pragma unroll
        for (int rr = 0; rr < 8; ++rr) {
            float ss = 0.f;
#pragma unroll
            for (int j = 0; j < 4; ++j) ss += xr[rr][j][0] * xr[rr][j][0] + xr[rr][j][1] * xr[rr][j][1] + xr[rr][j][2] * xr[rr][j][2] + xr[rr][j][3] * xr[rr][j][3];
            xrs[rr] = rsqrtf(wave_sum(ss) * (1.0f / 1024.0f) + RMS_EPS);
        }
    }
    xcd_barrier(bar);
    if (AMP_PH >= 0 && blockIdx.x == 0 && threadIdx.x == 0) ((volatile unsigned long long*)(p.ctrl + 15360))[1] = wall_clock64();
    STOP_AT(0);

    for (int rep_ = 0; rep_ < REPS(1); ++rep_) {
    const int tid = ltid(), lane = tid & 63, w = tid >> 6; (void)lane; (void)w;
#pragma unroll
    for (int rr = 0; rr < 8; ++rr) {
        const int row = bid * 8 + w + rr * nb * 8;
        if (row < T_TOK) {
            const int bb = row >> 13; const float rs = xrs[rr];
#pragma unroll
            for (int j = 0; j < 4; ++j) {
                const int col = lane * 4 + 256 * j;
                const f32x4 g = *(const f32x4*)(p.norm_g + col), s1 = *(const f32x4*)(p.mod + bb * 6144 + 1024 + col), h1 = *(const f32x4*)(p.mod + bb * 6144 + col);
                float o[4];
#pragma unroll
                for (int i = 0; i < 4; ++i) o[i] = xr[rr][j][i] * rs * g[i] * (1.0f + s1[i]) + h1[i];
                u32x2 u; u.x = cvt_pk_bf16(o[0], o[1]); u.y = cvt_pk_bf16(o[2], o[3]);
                *(u32x2*)(p.hmix + (size_t)row * DM + col) = u;
            }
        }
    }
    for (int row = bid * 8 + w + 64 * nb; row < T_TOK; row += nb * 8) {
        const int bb = row >> 13; const float* xp = p.x + (size_t)row * DM;
        f32x4 v[4]; float ss = 0.f;
#pragma unroll
        for (int j = 0; j < 4; ++j) { v[j] = *(const f32x4*)(xp + lane * 4 + 256 * j); ss += v[j][0] * v[j][0] + v[j][1] * v[j][1] + v[j][2] * v[j][2] + v[j][3] * v[j][3]; }
        const float rs = rsqrtf(wave_sum(ss) * (1.0f / 1024.0f) + RMS_EPS);
#pragma unroll
        for (int j = 0; j < 4; ++j) {
            const int col = lane * 4 + 256 * j;
            const f32x4 g = *(const f32x4*)(p.norm_g + col), s1 = *(const f32x4*)(p.mod + bb * 6144 + 1024 + col), h1 = *(const f32x4*)(p.mod + bb * 6144 + col);
            float o[4];
#pragma unroll
            for (int i = 0; i < 4; ++i) o[i] = v[j][i] * rs * g[i] * (1.0f + s1[i]) + h1[i];
            u32x2 u; u.x = cvt_pk_bf16(o[0], o[1]); u.y = cvt_pk_bf16(o[2], o[3]);
            *(u32x2*)(p.hmix + (size_t)row * DM + col) = u;
        }
    }
    if (rep_ == 0) {
        float* tl = (float*)(lm + 16384);
        for (int u = bid; u < 768; u += nb) wt_tile<1>(p.w_in, 2840, p.wT, u >> 4, u & 15, tl, tid);
        for (int u = bid; u < 256; u += nb) wt_tile<0>(p.w_out, 1024, p.wT + (size_t)WO_ROW0 * 1024, u >> 4, u & 15, tl, tid);
        for (int u = bid; u < 64; u += nb) wt_tile<2>(p.w_router, 256, p.wT + (size_t)WR_ROW0 * 1024, u >> 4, u & 15, tl, tid);
        __syncthreads();
    }
    xcd_barrier(bar);
    if (AMP_PH >= 0 && blockIdx.x == 0 && threadIdx.x == 0) ((volatile unsigned long long*)(p.ctrl + 15360))[2] = wall_clock64();
    }
    STOP_AT(1);

    for (int rep_ = 0; rep_ < REPS(2); ++rep_) {
    const int tid = ltid(), lane = tid & 63, w = tid >> 6; (void)lane; (void)w;
    {
        PG8_LAS unsigned char* sl = (PG8_LAS unsigned char*)(lds + L_MAIN);
        __syncthreads();
        { pg8::Gemm g; g.A = p.hmix; g.Bt = p.wT; g.M = T_TOK; g.N = WN_ROWS; g.K = DM;
          pg8::StaticOrder S; S.init(T_TOK, WN_ROWS, nb, bid);
          pg8::EpiBf16 E; E.O = p.proj; E.ldc = LD; E.split_cols = 0; E.split_stride = 0;
          pg8::gemm_phase<false>(sl, g, S, E); }
        { pg8::Gemm g; g.A = p.wT + (size_t)WN_ROWS * 1024; g.Bt = p.hmix; g.M = WV_ROWS; g.N = T_TOK; g.K = DM;
          const int g2 = nb > 64 ? nb - 64 : nb, c2 = nb > 64 ? (bid >= 64 ? bid - 64 : (1 << 28)) : bid;
          pg8::StaticOrder S; S.init(WV_ROWS, T_TOK, g2, c2);
          pg8::EpiBf16 E; E.O = p.vT; E.ldc = SEQ; E.split_cols = SEQ; E.split_stride = (size_t)VT_ROWS * SEQ;
          pg8::gemm_phase<true>(sl, g, S, E); }
    }
    xcd_barrier(bar);
    if (AMP_PH >= 0 && blockIdx.x == 0 && threadIdx.x == 0) ((volatile unsigned long long*)(p.ctrl + 15360))[3] = wall_clock64();
    }
    STOP_AT(2);

    for (int rep_ = 0; rep_ < REPS(3); ++rep_) {
    const int tid = ltid(), lane = tid & 63, w = tid >> 6; (void)lane; (void)w;
    for (int u2 = bid; u2 < 256; u2 += nb) {
        const int tokr = u2 * 64 + (tid >> 3), part = tid & 7;
        const bf16_t* kp = p.proj + (size_t)tokr * LD + DKOFF + part * 64;
        float sq = 0.f;
#pragma unroll
        for (int c8 = 0; c8 < 8; ++c8) {
            const u32x4 v = *(const u32x4*)(kp + c8 * 8);
            const float e0 = bflo(v.x), e1 = bfhi(v.x), e2 = bflo(v.y), e3 = bfhi(v.y), e4 = bflo(v.z), e5 = bfhi(v.z), e6 = bflo(v.w), e7 = bfhi(v.w);
            sq += e0 * e0 + e1 * e1 + e2 * e2 + e3 * e3 + e4 * e4 + e5 * e5 + e6 * e6 + e7 * e7;
        }
        sq = fmaxf(sq, __shfl_xor(sq, 8)); sq = fmaxf(sq, __shfl_xor(sq, 16)); sq = fmaxf(sq, __shfl_xor(sq, 32));
        float* kred = (float*)lm;
        __syncthreads();
        if (lane < 8) kred[w * 8 + lane] = sq;
        __syncthreads();
        if (tid < 8) {
            float mx = kred[tid];
#pragma unroll
            for (int w2 = 1; w2 < 8; ++w2) mx = fmaxf(mx, kred[w2 * 8 + tid]);
            atomicMax(p.ctrl + CT_KMAX + 64 * ((u2 >> 7) * 8 + tid), __float_as_uint(mx));
        }
    }
    for (int u = bid; u < 256; u += nb) {
        const int kv = u >> 7, bb = (u >> 6) & 1, g = (u >> 5) & 1, ch = u & 31, n0 = ch * 16;
        bf16_t* raw = (bf16_t*)lm;
        float* hid = (float*)(lm + 272 * 128);
        __syncthreads();
        {
            u32x4 rv[5];
#pragma unroll
            for (int j = 0; j < 5; ++j) {
                const int i = tid + 512 * j; const int tk = i >> 3, chn = i & 7; const int tok = 16 * n0 + tk;
                const int tokc = (tok < SEQ && i < 272 * 8) ? tok : 0;
                rv[j] = *(const u32x4*)(p.proj + ((size_t)bb * SEQ + tokc) * LD + (kv ? VCOFF : KCOFF) + g * 64 + chn * 8);
            }
#pragma unroll
            for (int j = 0; j < 5; ++j) {
                const int i = tid + 512 * j; const int tk = i >> 3, chn = i & 7; const int tok = 16 * n0 + tk;
                if (i < 272 * 8) *(u32x4*)((char*)raw + tk * 128 + ((chn ^ ((tk >> 4) & 7)) << 4)) = (tok < SEQ) ? rv[j] : (u32x4){0u, 0u, 0u, 0u};
            }
        }
        __syncthreads();
        const int rr = tid >> 5, c2 = tid & 31;
        float* wl = (float*)(lm + 272 * 128 + 4096);
        float a0 = 0.f, a1 = 0.f;
        {
            const int n = tid & 63, part = tid >> 6; float sacc = 0.f;
#pragma unroll
            for (int jq = 0; jq < 16; ++jq) sacc += p.misc[1024 + (kv * 128 + part * 16 + jq) * 64 + n];
            hid[part * 64 + n] = sacc;
            __syncthreads();
#pragma unroll
            for (int pp = 0; pp < 8; ++pp) { a0 += hid[pp * 64 + 2 * c2]; a1 += hid[pp * 64 + 2 * c2 + 1]; }
        }
        const float* w1g = p.w_cmp1 + (size_t)kv * 2048 * 64;
        char* wt = (char*)wl;
        const int wn4 = 8 * (w & 1) + (lane & 7), wkq = 8 * (w >> 1) + (lane >> 3);
        const int fni = w & 3, fkk = w >> 2, fc = lane & 15, fq = lane >> 4;
        f32x4 wv[8];
#pragma unroll
        for (int hq = 0; hq < 2; ++hq)
#pragma unroll
            for (int i = 0; i < 4; ++i) wv[4 * hq + i] = *(const f32x4*)(w1g + (size_t)(4 * (wkq + 32 * hq) + i) * 64 + 4 * wn4);
        f32x4 hacc = (f32x4){0.f, 0.f, 0.f, 0.f};
#pragma unroll 1
        for (int chk = 0; chk < 8; ++chk) {
            __syncthreads();
#pragma unroll
            for (int hq = 0; hq < 2; ++hq)
#pragma unroll
                for (int cc = 0; cc < 4; ++cc) {
                    const int k0 = 4 * (wkq + 32 * hq);
                    u32x2 v; v.x = cvt_pk_bf16(wv[4 * hq][cc], wv[4 * hq + 1][cc]); v.y = cvt_pk_bf16(wv[4 * hq + 2][cc], wv[4 * hq + 3][cc]);
                    *(u32x2*)(wt + (k0 >> 6) * 8192 + swz(4 * wn4 + cc, (k0 & 63) >> 3) + ((k0 >> 2) & 1) * 8) = v;
                }
            __syncthreads();
            if (chk + 1 < 8) {
#pragma unroll
                for (int hq = 0; hq < 2; ++hq)
#pragma unroll
                    for (int i = 0; i < 4; ++i) wv[4 * hq + i] = *(const f32x4*)(w1g + (size_t)((chk + 1) * 256 + 4 * (wkq + 32 * hq) + i) * 64 + 4 * wn4);
            }
#pragma unroll
            for (int sb = 0; sb < 4; ++sb) {
                const int ipos = chk * 4 + sb, trow = 16 * fc + ipos;
                const bf16x8 af = *(const bf16x8*)((const char*)raw + trow * 128 + (((4 * fkk + fq) ^ ((trow >> 4) & 7)) << 4));
                const bf16x8 bfv = *(const bf16x8*)(wt + sb * 8192 + swz(16 * fni + fc, 4 * fkk + fq));
                hacc = __builtin_amdgcn_mfma_f32_16x16x32_bf16(bfv, af, hacc, 0, 0, 0);
            }
        }
        __syncthreads();
        {
            float* part = (float*)wt;
            *(f32x4*)(part + (fkk * 16 + fc) * 64 + 16 * fni + 4 * fq) = hacc;
            __syncthreads();
            a0 += part[rr * 64 + 2 * c2] + part[(16 + rr) * 64 + 2 * c2];
            a1 += part[rr * 64 + 2 * c2 + 1] + part[(16 + rr) * 64 + 2 * c2 + 1];
        }
        __syncthreads();
        {
            const float k0 = 0.7978845608028654f, k1 = 0.044715f;
            const float t0 = tanhf(k0 * (a0 + k1 * a0 * a0 * a0)), t1 = tanhf(k0 * (a1 + k1 * a1 * a1 * a1));
            hid[rr * 64 + 2 * c2] = 0.5f * a0 * (1.0f + t0); hid[rr * 64 + 2 * c2 + 1] = 0.5f * a1 * (1.0f + t1);
        }
        __syncthreads();
        { const f32x4 wa_ = *(const f32x4*)(p.w_cmp2 + (size_t)kv * 4096 + tid * 4), wb_ = *(const f32x4*)(p.w_cmp2 + (size_t)kv * 4096 + (tid + 512) * 4);
          *(f32x4*)(wl + tid * 4) = wa_; *(f32x4*)(wl + (tid + 512) * 4) = wb_; }
        __syncthreads();
        float o0 = 0.f, o1 = 0.f;
#pragma unroll 8
        for (int jx = 0; jx < 64; ++jx) { const float hv = hid[rr * 64 + jx]; const float2 wv = *(const float2*)(wl + jx * 64 + 2 * c2); o0 += hv * wv.x; o1 += hv * wv.y; }
        const int n = n0 + rr;
        if (n < 511) {
            if (kv == 0) { *(unsigned*)(p.kc + ((size_t)(bb * 2 + g) * 512 + n) * 64 + 2 * c2) = cvt_pk_bf16(o0, o1); }
            else { p.vcT[((size_t)(bb * 2 + g) * 64 + 2 * c2) * 512 + n] = f2bf(o0); p.vcT[((size_t)(bb * 2 + g) * 64 + 2 * c2 + 1) * 512 + n] = f2bf(o1); }
        }
    }
    xcd_barrier(bar);
    if (AMP_PH >= 0 && blockIdx.x == 0 && threadIdx.x == 0) ((volatile unsigned long long*)(p.ctrl + 15360))[4] = wall_clock64();
    }
    STOP_AT(3);

    for (int rep_ = 0; rep_ < REPS(4); ++rep_) {
    const int tid = ltid(), lane = tid & 63, w = tid >> 6; (void)lane; (void)w;
    {
        int u;
        for (;;) {
            __syncthreads();
            if (tid == 0) bc[0] = (int)atomicAdd(p.ctrl + CT_Q + 64 * rep_, 1u);
            __syncthreads();
            u = bc[0];
            if (u >= 512) break;
            const int qk = 63 - (u >> 3), bh = u & 7;
            if (!(PROBE_PH == 4 && rep_ == 0 && (PROBE_VAR == 2 || PROBE_VAR >= 20))) diff_unit(p, lm, bh >> 2, bh & 3, qk, (PROBE_PH == 4 && rep_ == 0) ? PROBE_VAR : 0);
        }
        while (u < 1024) {
            const int v = u - 512; const int qb = 127 - (v >> 2), bg = v & 3;
            if (!(PROBE_PH == 4 && rep_ == 0 && (PROBE_VAR == 1 || (PROBE_VAR >= 11 && PROBE_VAR < 20)))) nsa_unit(p, lm, bg >> 1, bg & 1, qb, (PROBE_PH == 4 && rep_ == 0) ? PROBE_VAR : 0);
            __syncthreads();
            if (tid == 0) bc[0] = (int)atomicAdd(p.ctrl + CT_Q + 64 * rep_, 1u);
            __syncthreads();
            u = bc[0];
        }
    }
    xcd_barrier(bar);
    if (AMP_PH >= 0 && blockIdx.x == 0 && threadIdx.x == 0) ((volatile unsigned long long*)(p.ctrl + 15360))[5] = wall_clock64();
    }
    STOP_AT(4);

    for (int rep_ = 0; rep_ < REPS(5); ++rep_) {
    const int tid = ltid(), lane = tid & 63, w = tid >> 6; (void)lane; (void)w;
    {
        PG8_LAS unsigned char* sl = (PG8_LAS unsigned char*)(lds + L_MAIN);
        __syncthreads();
        pg8::Gemm g; g.A = p.ocat; g.Bt = p.wT + (size_t)WO_ROW0 * 1024; g.M = T_TOK; g.N = DM; g.K = DM;
        pg8::StaticOrder S; S.init(T_TOK, DM, nb, bid);
        if (nb == 256) {
            pg8::EpiNormFfn E; E.x = p.x; E.out = p.out; E.hhi = p.hhi; E.hlo = p.hlo; E.norm_g = p.norm_g; E.mod = p.mod; E.nslot = p.nslot; E.cnt = p.ctrl + CT_NORMCNT;
            pg8::gemm_phase<false, pg8::EpiNormFfn, pg8::StaticOrder, true>(sl, g, S, E);
        } else {
            pg8::EpiBf16 E; E.O = p.y; E.ldc = DM; E.split_cols = 0; E.split_stride = 0;
            pg8::gemm_phase<false>(sl, g, S, E);
        }
    }
    xcd_barrier(bar);
    if (AMP_PH >= 0 && blockIdx.x == 0 && threadIdx.x == 0) ((volatile unsigned long long*)(p.ctrl + 15360))[6] = wall_clock64();
    }
    STOP_AT(5);

    for (int rep_ = 0; rep_ < ((nb == 256) ? 0 : REPS(6)); ++rep_) {
    const int tid = ltid(), lane = tid & 63, w = tid >> 6; (void)lane; (void)w;
    for (int row0 = bid * 8 + w; row0 < T_TOK; row0 += nb * 16) {
        const int row1r = row0 + nb * 8; const bool has1 = row1r < T_TOK; const int row1 = has1 ? row1r : row0;
        f32x4 yv[2][4], xv[2][4]; float ss[2] = {0.f, 0.f};
#pragma unroll
        for (int j = 0; j < 4; ++j) {
            { const u32x2 y0 = *(const u32x2*)(p.y + (size_t)row0 * DM + lane * 4 + 256 * j), y1 = *(const u32x2*)(p.y + (size_t)row1 * DM + lane * 4 + 256 * j);
              yv[0][j] = (f32x4){bflo(y0.x), bfhi(y0.x), bflo(y0.y), bfhi(y0.y)}; yv[1][j] = (f32x4){bflo(y1.x), bfhi(y1.x), bflo(y1.y), bfhi(y1.y)}; }
            xv[0][j] = *(const f32x4*)(p.x + (size_t)row0 * DM + lane * 4 + 256 * j); xv[1][j] = *(const f32x4*)(p.x + (size_t)row1 * DM + lane * 4 + 256 * j);
        }
#pragma unroll
        for (int rr = 0; rr < 2; ++rr)
#pragma unroll
            for (int j = 0; j < 4; ++j) ss[rr] += yv[rr][j][0] * yv[rr][j][0] + yv[rr][j][1] * yv[rr][j][1] + yv[rr][j][2] * yv[rr][j][2] + yv[rr][j][3] * yv[rr][j][3];
        ss[0] = wave_sum(ss[0]); ss[1] = wave_sum(ss[1]);
        float ss2[2] = {0.f, 0.f};
#pragma unroll
        for (int rr = 0; rr < 2; ++rr) {
            const int row = rr ? row1 : row0; const float* md = p.mod + (row >> 13) * 6144;
            const float rs = rsqrtf(ss[rr] * (1.0f / 1024.0f) + RMS_EPS);
#pragma unroll
            for (int j = 0; j < 4; ++j) {
                const int col = lane * 4 + 256 * j;
                const f32x4 g = *(const f32x4*)(p.norm_g + 1024 + col), g1 = *(const f32x4*)(md + 2048 + col);
#pragma unroll
                for (int i = 0; i < 4; ++i) { xv[rr][j][i] = xv[rr][j][i] + g1[i] * (yv[rr][j][i] * rs * g[i]); ss2[rr] += xv[rr][j][i] * xv[rr][j][i]; }
                if (rr == 0 || has1) *(f32x4*)(p.out + (size_t)row * DM + col) = xv[rr][j];
            }
        }
        ss2[0] = wave_sum(ss2[0]); ss2[1] = wave_sum(ss2[1]);
#pragma unroll
        for (int rr = 0; rr < 2; ++rr) {
            const int row = rr ? row1 : row0; const float* md = p.mod + (row >> 13) * 6144;
            const float rs2 = rsqrtf(ss2[rr] * (1.0f / 1024.0f) + RMS_EPS);
            if (rr == 0 || has1) {
#pragma unroll
                for (int j = 0; j < 4; ++j) {
                    const int col = lane * 4 + 256 * j;
                    const f32x4 g = *(const f32x4*)(p.norm_g + 2048 + col), s2 = *(const f32x4*)(md + 4096 + col), h2 = *(const f32x4*)(md + 3072 + col);
                    float hv[4], lo[4];
#pragma unroll
                    for (int i = 0; i < 4; ++i) { hv[i] = xv[rr][j][i] * rs2 * g[i] * (1.0f + s2[i]) + h2[i]; lo[i] = hv[i] - bf2f(f2bf(hv[i])); }
                    u32x2 uh, ul; uh.x = cvt_pk_bf16(hv[0], hv[1]); uh.y = cvt_pk_bf16(hv[2], hv[3]); ul.x = cvt_pk_bf16(lo[0], lo[1]); ul.y = cvt_pk_bf16(lo[2], lo[3]);
                    *(u32x2*)(p.hhi + (size_t)row * DM + col) = uh; *(u32x2*)(p.hlo + (size_t)row * DM + col) = ul;
                }
            }
        }
    }
    xcd_barrier(bar);
    if (AMP_PH >= 0 && blockIdx.x == 0 && threadIdx.x == 0) ((volatile unsigned long long*)(p.ctrl + 15360))[7] = wall_clock64();
    }
    STOP_AT(6);

    for (int rep_ = 0; rep_ < REPS(7); ++rep_) {
    const int tid = ltid(), lane = tid & 63, w = tid >> 6; (void)lane; (void)w;
    for (int u = bid; u < 256; u += nb) {
        const int nt = u / 128, mt = u % 128;
        __syncthreads();
        if (tid < 128) ((int*)(lm + G_ROWOFF))[tid] = (mt * 128 + tid) * DM;
        __syncthreads();
        ASrcRouter as; as.hi = p.hhi; as.lo = p.hlo;
        BLqRouter bl; bl.wt = p.wT + (size_t)(WR_ROW0 + nt * 128) * 1024;
        EpiF32<2> ep; ep.o = p.logits; ep.ldo = 256; ep.row0 = mt * 128; ep.col0 = nt * 128;
        gemm_big<1, true, 4, ASrcRouter, BLqRouter, EpiF32<2>, 4, true>(lm, 48, 1, as, bl, ep);
    }
    xcd_barrier(bar);
    if (AMP_PH >= 0 && blockIdx.x == 0 && threadIdx.x == 0) ((volatile unsigned long long*)(p.ctrl + 15360))[8] = wall_clock64();
    }
    STOP_AT(7);

    {
    const int tid = ltid(), lane = tid & 63, w = tid >> 6; (void)lane; (void)w;
    int* lhist = (int*)lm;
    __syncthreads();
    if (tid < 256) lhist[tid] = 0;
    __syncthreads();
    f32x4 lgs[8];
#pragma unroll
    for (int it8 = 0; it8 < 8; ++it8) { const int tk = bid * 8 + w + it8 * nb * 8; lgs[it8] = *(const f32x4*)(p.logits + (size_t)(tk < T_TOK ? tk : 0) * 256 + lane * 4); }
    const f32x4 rb = *(const f32x4*)(p.router_bias + lane * 4);
#pragma unroll
    for (int it8 = 0; it8 < 8; ++it8) {
        const int tok = bid * 8 + w + it8 * nb * 8;
        if (tok >= T_TOK) break;
        const f32x4 lg = lgs[it8];
        float aff[4], ch[4];
#pragma unroll
        for (int i = 0; i < 4; ++i) { aff[i] = __builtin_amdgcn_rcpf(1.0f + __expf(-lg[i])); ch[i] = aff[i] + rb[i]; }
        float m1 = fmaxf(ch[0], ch[1]), m2 = fminf(ch[0], ch[1]);
#pragma unroll
        for (int i = 2; i < 4; ++i) { const float v = ch[i]; if (v > m1) { m2 = m1; m1 = v; } else if (v > m2) m2 = v; }
        { float o1 = dppf<0xB1>(m1), o2 = dppf<0xB1>(m2); float n1 = fmaxf(m1, o1), n2 = fmaxf(fminf(m1, o1), fmaxf(m2, o2)); m1 = n1; m2 = n2;
          o1 = dppf<0x4E>(m1); o2 = dppf<0x4E>(m2); n1 = fmaxf(m1, o1); n2 = fmaxf(fminf(m1, o1), fmaxf(m2, o2)); m1 = n1; m2 = n2;
          o1 = dppf<0x141>(m1); o2 = dppf<0x141>(m2); n1 = fmaxf(m1, o1); n2 = fmaxf(fminf(m1, o1), fmaxf(m2, o2)); m1 = n1; m2 = n2; }
        const float gs = m1 + m2; const int grp = lane >> 3;
        int rank = 0;
#pragma unroll
        for (int g2 = 0; g2 < 8; ++g2) { const float og = __builtin_bit_cast(float, __builtin_amdgcn_readlane(__builtin_bit_cast(int, gs), g2 * 8)); if (og > gs || (og == gs && g2 < grp)) ++rank; }
        const bool gsel = rank < 4;
#pragma unroll
        for (int i = 0; i < 4; ++i) if (!gsel) ch[i] = -INFINITY;
        int myidx = 0; float myaff = 0.f, asum = 0.f;
        for (int it = 0; it < 8; ++it) {
            float bv = ch[0]; int bi = lane * 4;
#pragma unroll
            for (int i = 1; i < 4; ++i) if (ch[i] > bv) { bv = ch[i]; bi = lane * 4 + i; }
            const float M = wave_max_dpp(bv);
            const unsigned long long bal = __ballot(bv == M);
            const int L = (int)__builtin_ctzll(bal);
            bi = __builtin_amdgcn_readlane(bi, L);
            float av = 0.f;
            if (L == lane) {
#pragma unroll
                for (int i = 0; i < 4; ++i) if ((bi & 3) == i) { av = aff[i]; ch[i] = -INFINITY; }
            }
            av = __builtin_bit_cast(float, __builtin_amdgcn_readlane(__builtin_bit_cast(int, av), L));
            asum += av;
            if (lane == it) { myidx = bi; myaff = av; }
        }
        if (lane < 8) {
            const float wt = myaff / asum * 2.5f;
            const int rk = atomicAdd(&lhist[myidx], 1);
            uint2 en; en.x = (unsigned)myidx | ((unsigned)rk << 16); en.y = __float_as_uint(wt);
            p.asg[(size_t)tok * 8 + lane] = en;
        }
    }
    __syncthreads();
    if (tid < 256) { p.bh[tid * 256 + (bid & 255)] = lhist[tid]; for (int b2 = bid + nb; b2 < 256; b2 += nb) p.bh[tid * 256 + b2] = 0; }
    }
    xcd_barrier(bar);
    {
    const int tid = ltid(), lane = tid & 63, w = tid >> 6; (void)lane; (void)w;
    int* loff = (int*)lm;
    __syncthreads();
    {
        int4 c4s[32];
#pragma unroll
        for (int i = 0; i < 32; ++i) c4s[i] = *(const int4*)(p.bh + (w + 8 * i) * 256 + lane * 4);
#pragma unroll
        for (int i = 0; i < 32; ++i) {
            const int e = w + 8 * i; const int4 c4 = c4s[i];
            const int b0 = lane * 4;
            int below = (b0 < bid ? c4.x : 0) + (b0 + 1 < bid ? c4.y : 0) + (b0 + 2 < bid ? c4.z : 0) + (b0 + 3 < bid ? c4.w : 0);
            int tot = c4.x + c4.y + c4.z + c4.w;
            below = wave_sum_i(below); tot = wave_sum_i(tot);
            if (lane == 0) { loff[e] = below; if (bid == 0) p.ctrl[CT_CNT + e] = (unsigned)tot; }
        }
    }
    __syncthreads();
    {
        const int tok = bid * 8 + w + (lane >> 3) * nb * 8, kq = lane & 7;
        if (tok < T_TOK) {
            const uint2 en = p.asg[(size_t)tok * 8 + kq];
            const int e = (int)(en.x & 0xffffu), rk = (int)(en.x >> 16);
            uint2 o; o.x = (unsigned)(tok * 9 + kq); o.y = en.y;
            p.bucket[(size_t)e * CAP + loff[e] + rk] = o;
        }
    }
    }
    xcd_barrier(bar);
    if (AMP_PH >= 0 && blockIdx.x == 0 && threadIdx.x == 0) ((volatile unsigned long long*)(p.ctrl + 15360))[9] = wall_clock64();
    STOP_AT(8);

    for (int rep_ = 0; rep_ < REPS(9); ++rep_) {
    const int tid = ltid(), lane = tid & 63, w = tid >> 6; (void)lane; (void)w;
    moe_phase<1>(p, lds, xcc, rep_);
    xcd_barrier(bar);
    if (AMP_PH >= 0 && blockIdx.x == 0 && threadIdx.x == 0) ((volatile unsigned long long*)(p.ctrl + 15360))[10] = wall_clock64();
    }
    STOP_AT(9);
    for (int rep_ = 0; rep_ < REPS(10); ++rep_) {
    moe_down_phase(p, lds, xcc, rep_);
    xcd_barrier(bar);
    if (AMP_PH >= 0 && blockIdx.x == 0 && threadIdx.x == 0) ((volatile unsigned long long*)(p.ctrl + 15360))[11] = wall_clock64();
    }
    STOP_AT(10);

    {
    const int tid = ltid(), lane = tid & 63, w = tid >> 6; (void)lane; (void)w;
    {
        f32x4 gq[4], g2q[2][4];
#pragma unroll
        for (int j = 0; j < 4; ++j) { const int col = lane * 16 + 4 * j; gq[j] = *(const f32x4*)(p.norm_g + 3072 + col);
            g2q[0][j] = *(const f32x4*)(p.mod + 5120 + col); g2q[1][j] = *(const f32x4*)(p.mod + 6144 + 5120 + col); }
#define P11_LOAD(row_, sv_, xv_) do { const unsigned char* sp_ = p.yslot + (size_t)(row_) * 9 * 1024 + lane * 16; \
        _Pragma("unroll") for (int k = 0; k < 9; ++k) sv_[k] = *(const u32x4*)(sp_ + (size_t)k * 1024); \
        _Pragma("unroll") for (int j = 0; j < 4; ++j) xv_[j] = *(const f32x4*)(p.out + (size_t)(row_) * DM + lane * 16 + 4 * j); } while (0)
#define P11_DO(row_, sv_, xv_) do { float acc[16]; \
        _Pragma("unroll") for (int i = 0; i < 16; ++i) acc[i] = 0.f; \
        _Pragma("unroll") for (int k = 0; k < 9; ++k) { float f[4]; \
            unpack_fp8x4(sv_[k].x, f); acc[0] += f[0]; acc[1] += f[1]; acc[2] += f[2]; acc[3] += f[3]; \
            unpack_fp8x4(sv_[k].y, f); acc[4] += f[0]; acc[5] += f[1]; acc[6] += f[2]; acc[7] += f[3]; \
            unpack_fp8x4(sv_[k].z, f); acc[8] += f[0]; acc[9] += f[1]; acc[10] += f[2]; acc[11] += f[3]; \
            unpack_fp8x4(sv_[k].w, f); acc[12] += f[0]; acc[13] += f[1]; acc[14] += f[2]; acc[15] += f[3]; } \
        float ss = 0.f; \
        _Pragma("unroll") for (int i = 0; i < 16; ++i) { acc[i] *= (1.0f / YS_SCALE); ss += acc[i] * acc[i]; } \
        ss = wave_sum(ss); \
        const float rs = rsqrtf(ss * (1.0f / 1024.0f) + RMS_EPS); const int bb_ = (row_) >> 13; \
        _Pragma("unroll") for (int j = 0; j < 4; ++j) { f32x4 x1 = xv_[j]; \
            const f32x4 g2v_ = bb_ ? g2q[1][j] : g2q[0][j]; \
            _Pragma("unroll") for (int i = 0; i < 4; ++i) x1[i] += g2v_[i] * (acc[4 * j + i] * rs * gq[j][i]); \
            *(f32x4*)(p.out + (size_t)(row_) * DM + lane * 16 + 4 * j) = x1; } } while (0)
        u32x4 svA[9]; f32x4 xvA[4];
        for (int row = bid * 8 + w; row < T_TOK; row += nb * 8) { P11_LOAD(row, svA, xvA); P11_DO(row, svA, xvA); }
#undef P11_LOAD
#undef P11_DO
    }
    }
    if (AMP_PH >= 0 && blockIdx.x == 0 && threadIdx.x == 0) {
        volatile unsigned long long* ts = (volatile unsigned long long*)(p.ctrl + 15360);
        const unsigned long long tend = wall_clock64();
        const unsigned long long a = ts[AMP_PH], b = (AMP_PH + 1 <= 11) ? ts[AMP_PH + 1] : tend;
        const unsigned long long dt = (b - a) * AMP_MUL, t0 = wall_clock64();
        while (wall_clock64() - t0 < dt) __builtin_amdgcn_s_sleep(8);
    }
}

static inline size_t al256(size_t v) { return (v + 255) & ~(size_t)255; }

extern "C" void kernel_launch(void* const* d_in, const int* in_sizes, int n_in, void* d_out, int out_size, void* d_ws, size_t ws_size, hipStream_t stream) {
    (void)in_sizes; (void)n_in; (void)out_size;
    Params p{};
    p.x = (const float*)d_in[0]; p.c = (const float*)d_in[1]; p.w_ada = (const float*)d_in[2]; p.b_ada = (const float*)d_in[3];
    p.norm_g = (const float*)d_in[4]; p.w_in = (const float*)d_in[5]; p.w_cmp1 = (const float*)d_in[6]; p.w_cmp2 = (const float*)d_in[7];
    p.pe_cmp = (const float*)d_in[8]; p.diff_lambda = (const float*)d_in[9]; p.diff_subln = (const float*)d_in[10]; p.w_out = (const float*)d_in[11];
    p.w_router = (const float*)d_in[12]; p.router_bias = (const float*)d_in[13]; p.w_gate_up = (const float*)d_in[14]; p.w_down = (const float*)d_in[15];
    p.ws_gate_up = (const float*)d_in[16]; p.ws_down = (const float*)d_in[17];
    p.out = (float*)d_out;
    char* ws = (char*)d_ws; size_t off = 0;
    auto take = [&](size_t bytes) { char* r = ws + off; off = al256(off + bytes); return r; };
    p.ctrl = (unsigned*)take((size_t)CT_WORDS * 4);
    p.mod = (float*)take(2 * 6144 * 4);
    p.misc = (float*)take((1024 + 256 * 64) * 4);
    p.wT = (bf16_t*)take((size_t)WT_ROWS * 1024 * 2);
    p.hmix = (bf16_t*)take((size_t)T_TOK * DM * 2);
    p.proj = (bf16_t*)take((size_t)T_TOK * LD * 2);
    p.vT = (bf16_t*)take((size_t)2 * VT_ROWS * SEQ * 2);
    p.kc = (bf16_t*)take((size_t)4 * 512 * 64 * 2);
    p.vcT = (bf16_t*)take((size_t)4 * 64 * 512 * 2);
    p.ocat = (bf16_t*)take((size_t)T_TOK * DM * 2);
    p.y = (bf16_t*)take((size_t)T_TOK * DM * 2);
    p.hhi = (bf16_t*)take((size_t)T_TOK * DM * 2);
    p.hlo = (bf16_t*)take((size_t)T_TOK * DM * 2);
    p.logits = (float*)take((size_t)T_TOK * 256 * 4);
    p.bucket = (uint2*)take((size_t)NEXP * CAP * 8);
    p.asg = (uint2*)take((size_t)T_TOK * 8 * 8);
    p.bh = (int*)take((size_t)256 * 256 * 4);
    p.H = (bf16_t*)take((size_t)T_TOK * 9 * 256 * 2);
    p.yslot = (unsigned char*)take((size_t)T_TOK * 9 * 1024);
    p.nslot = (float*)take((size_t)2 * T_TOK * 4 * 4);

    if (ws_size < off) { fprintf(stderr, "workspace too small: %zu < %zu\n", ws_size, off); return; }
    static int grid = 0;
    if (!grid) {
        int dev = 0, cus = 0, per_cu = 0;
        hipGetDevice(&dev);
        hipDeviceGetAttribute(&cus, hipDeviceAttributeMultiprocessorCount, dev);
        hipFuncSetAttribute((const void*)fwd_kernel, hipFuncAttributeMaxDynamicSharedMemorySize, LDS_BYTES);
        hipOccupancyMaxActiveBlocksPerMultiprocessor(&per_cu, fwd_kernel, 512, LDS_BYTES);
        if (per_cu < 1) fprintf(stderr, "occupancy query says the kernel does not fit\n");
        grid = cus > 0 ? (cus < 256 ? cus : 256) : 256;
    }
    hipMemsetAsync(p.ctrl, 0, (size_t)CT_WORDS * 4, stream);
    hipLaunchKernelGGL(fwd_kernel, dim3(grid), dim3(512), LDS_BYTES, stream, p);
}
```
